# Optimizing an MI355X kernel written in HIP

```python
import math
import jax, jax.numpy as jnp
from jax import lax
import numpy as np

D_MODEL = 4096
BATCH = 1
SEQ = 8192
DEPTH = 1

HEAD_DIM = 128
N_HEADS_FOX = 16
N_HEADS_DIL = 16
FOX_WIDTH = N_HEADS_FOX * HEAD_DIM
DIL_WIDTH = N_HEADS_DIL * HEAD_DIM
MIX_WIDTH = FOX_WIDTH + DIL_WIDTH
IN_PROJ_WIDTH = 3 * FOX_WIDTH + N_HEADS_FOX + 3 * DIL_WIDTH
DILATED_PATTERNS = ((128, 1), (512, 4), (2048, 16))
N_BUCKETS = 32
MAX_DISTANCE = 2048
D_FF = 11008
CONV_WIDTH = 3
Q_BLOCK = 128
RMS_EPS = 1e-6

kernel_name = "hymba_fox_dilated_convffn"


def _branch_offsets():
    offs = [np.arange(w // d + 1, dtype=np.int32) * d for (w, d) in DILATED_PATTERNS]
    lens = tuple(int(o.shape[0]) for o in offs)
    return np.concatenate(offs), lens


DIL_OFFSETS, DIL_BRANCH_LENS = _branch_offsets()


def rms_norm(x, g):
    xf = x.astype(jnp.float32)
    y = xf * lax.rsqrt(jnp.mean(xf * xf, axis=-1, keepdims=True) + RMS_EPS)
    return (y * g.astype(jnp.float32)).astype(x.dtype)


def t5_causal_bucket(dist):
    max_exact = N_BUCKETS // 2
    d_f = jnp.maximum(dist, 1).astype(jnp.float32)
    large = max_exact + (jnp.log(d_f / max_exact) / math.log(MAX_DISTANCE / max_exact)
                         * (N_BUCKETS - max_exact)).astype(jnp.int32)
    large = jnp.minimum(large, N_BUCKETS - 1)
    return jnp.where(dist < max_exact, dist, large)


def to_heads(t, n_heads):
    b, s, _ = t.shape
    return t.reshape(b, s, n_heads, HEAD_DIM).transpose(0, 2, 1, 3)


def to_blocks(t):
    b, h, s = t.shape[:3]
    t = t.reshape((b, h, s // Q_BLOCK, Q_BLOCK) + t.shape[3:])
    return jnp.moveaxis(t, 2, 0)


def from_blocks(t):
    nb, b, h, q, hd = t.shape
    t = jnp.moveaxis(t, 0, 2).reshape(b, h, nb * q, hd)
    return t.transpose(0, 2, 1, 3).reshape(b, nb * q, h * hd)


def forgetting_attention(q, k, v, log_f):
    s_len = q.shape[2]
    scale = HEAD_DIM ** -0.5
    c = jnp.cumsum(log_f, axis=-1)
    key_pos = jnp.arange(s_len, dtype=jnp.int32)
    starts = jnp.arange(s_len // Q_BLOCK, dtype=jnp.int32) * Q_BLOCK

    def block(args):
        qb, cb, t0 = args
        logits = jnp.einsum('bhqd,bhkd->bhqk', qb, k).astype(jnp.float32) * scale
        logits = logits + cb[..., None] - c[:, :, None, :]
        q_pos = t0 + jnp.arange(Q_BLOCK, dtype=jnp.int32)
        mask = key_pos[None, :] <= q_pos[:, None]
        logits = jnp.where(mask, logits, -jnp.inf)
        p = jax.nn.softmax(logits, axis=-1)
        return jnp.einsum('bhqk,bhkd->bhqd', p.astype(v.dtype), v)

    out = lax.map(block, (to_blocks(q), to_blocks(c), starts))
    return from_blocks(out)


def dilated_attention(q, k, v, rel_bias_table):
    s_len = q.shape[2]
    scale = HEAD_DIM ** -0.5
    offsets = jnp.asarray(DIL_OFFSETS)
    bias = rel_bias_table[t5_causal_bucket(offsets)].astype(jnp.float32).T
    starts = jnp.arange(s_len // Q_BLOCK, dtype=jnp.int32) * Q_BLOCK

    def block(args):
        qb, t0 = args
        q_pos = t0 + jnp.arange(Q_BLOCK, dtype=jnp.int32)
        k_pos = q_pos[:, None] - offsets[None, :]
        valid = k_pos >= 0
        k_idx = jnp.maximum(k_pos, 0)
        kg = k[:, :, k_idx]
        vg = v[:, :, k_idx]
        logits = jnp.einsum('bhqd,bhqjd->bhqj', qb, kg).astype(jnp.float32) * scale
        logits = logits + bias[None, :, None, :]
        logits = jnp.where(valid, logits, -jnp.inf)
        outs, lses = [], []
        start = 0
        for n in DIL_BRANCH_LENS:
            l = logits[..., start:start + n]
            m = jnp.max(l, axis=-1, keepdims=True)
            p = jnp.exp(l - m)
            den = jnp.sum(p, axis=-1, keepdims=True)
            o = jnp.einsum('bhqj,bhqjd->bhqd', (p / den).astype(vg.dtype), vg[..., start:start + n, :])
            outs.append(o.astype(jnp.float32))
            lses.append(m + jnp.log(den))
            start += n
        w = jax.nn.softmax(jnp.concatenate(lses, axis=-1), axis=-1)
        o = sum(w[..., i:i + 1] * outs[i] for i in range(len(outs)))
        return o.astype(qb.dtype)

    out = lax.map(block, (to_blocks(q), starts))
    return from_blocks(out)


def causal_dwconv(h, w, b):
    s_len = h.shape[1]
    hp = jnp.pad(h, ((0, 0), (CONV_WIDTH - 1, 0), (0, 0)))
    out = sum(hp[:, i:i + s_len, :] * w[i] for i in range(CONV_WIDTH))
    return out + b


def setup_inputs(seed: int = 0) -> dict:
    key = jax.random.key(seed)
    ks = jax.random.split(key, 16)
    f32 = jnp.float32
    nrm = lambda k, shape, s: jax.random.normal(k, shape, f32) * s
    return {
        "x": nrm(ks[0], (BATCH, SEQ, D_MODEL), 1.0),
        "attn_norm_g": 1.0 + nrm(ks[1], (DEPTH, D_MODEL), 0.02),
        "w_in": nrm(ks[2], (DEPTH, D_MODEL, IN_PROJ_WIDTH), D_MODEL ** -0.5),
        "fox_forget_b": 2.0 + nrm(ks[3], (DEPTH, N_HEADS_FOX), 0.1),
        "rel_bias_table": nrm(ks[4], (N_BUCKETS, N_HEADS_DIL), 0.1),
        "fox_out_norm_g": 1.0 + nrm(ks[5], (DEPTH, FOX_WIDTH), 0.02),
        "dil_out_norm_g": 1.0 + nrm(ks[6], (DEPTH, DIL_WIDTH), 0.02),
        "w_out": nrm(ks[7], (DEPTH, MIX_WIDTH, D_MODEL), MIX_WIDTH ** -0.5),
        "ffn_norm_g": 1.0 + nrm(ks[8], (DEPTH, D_MODEL), 0.02),
        "w_up": nrm(ks[9], (DEPTH, D_MODEL, 2 * D_FF), D_MODEL ** -0.5),
        "conv_w": nrm(ks[10], (DEPTH, CONV_WIDTH, D_FF), CONV_WIDTH ** -0.5),
        "conv_b": nrm(ks[11], (DEPTH, D_FF), 0.02),
        "w_down": nrm(ks[12], (DEPTH, D_FF, D_MODEL), D_FF ** -0.5),
        "final_norm_g": 1.0 + nrm(ks[13], (D_MODEL,), 0.02),
    }


def reference(x, attn_norm_g, w_in, fox_forget_b, rel_bias_table, fox_out_norm_g, dil_out_norm_g,
              w_out, ffn_norm_g, w_up, conv_w, conv_b, w_down, final_norm_g):
    c0 = 3 * FOX_WIDTH
    c1 = c0 + N_HEADS_FOX
    for l in range(DEPTH):
        h = rms_norm(x, attn_norm_g[l])
        proj = jnp.einsum('bsd,de->bse', h, w_in[l])
        q_a, k_a, v_a = (to_heads(t, N_HEADS_FOX) for t in jnp.split(proj[..., :c0], 3, axis=-1))
        f_logit = proj[..., c0:c1].astype(jnp.float32) + fox_forget_b[l].astype(jnp.float32)
        log_f = jax.nn.log_sigmoid(f_logit).transpose(0, 2, 1)
        q_b, k_b, v_b = (to_heads(t, N_HEADS_DIL) for t in jnp.split(proj[..., c1:], 3, axis=-1))

        out_a = forgetting_attention(q_a, k_a, v_a, log_f)
        out_b = dilated_attention(q_b, k_b, v_b, rel_bias_table)
        mixed = jnp.concatenate([rms_norm(out_a, fox_out_norm_g[l]),
                                 rms_norm(out_b, dil_out_norm_g[l])], axis=-1)
        x = x + jnp.einsum('bse,ed->bsd', mixed, w_out[l])

        hn = rms_norm(x, ffn_norm_g[l])
        up = jnp.einsum('bsd,df->bsf', hn, w_up[l])
        gate, val = up[..., :D_FF], up[..., D_FF:]
        gate = causal_dwconv(gate, conv_w[l], conv_b[l])
        x = x + jnp.einsum('bsf,fd->bsd', jax.nn.silu(gate) * val, w_down[l])
    return rms_norm(x, final_norm_g)
```

```cpp
#include <hip/hip_runtime.h>
#include <hip/hip_bf16.h>
#include <hip/hip_cooperative_groups.h>
#include <cstdio>
#include <cstdint>
namespace cg = cooperative_groups;
namespace pg8 {
#define PG8_LAS __attribute__((address_space(3)))
typedef unsigned short bf16_t;
typedef short bf16x8 __attribute__((ext_vector_type(8)));
typedef float f32x4 __attribute__((ext_vector_type(4)));
typedef unsigned u32x4 __attribute__((ext_vector_type(4)));
constexpr int BM = 256, BK = 64, HALF = 128, HTB = HALF * BK * 2  , STAGE_BYTES = 8 * HTB, NXCD = 8, WGM = 8;

__host__ __device__ __forceinline__ int lds_byte(int r, int c) { const int st = (r >> 4) * 2 + (c >> 5), rr = r & 15, cc = c & 31, ob = rr * 64 + cc * 2; return st * 1024 + (ob ^ (((ob >> 9) & 1) << 5)); }
__host__ __device__ __forceinline__ void stage_rc(int b, int& R, int& C) { const int st = b / 1024, sb = b % 1024, swz = sb ^ (((sb >> 9) & 1) << 5); R = (st >> 1) * 16 + swz / 64; C = (st & 1) * 32 + (swz % 64) / 2; }
__host__ __device__ __forceinline__ int perm32(int rho) { const int n = rho >> 4, i = rho & 15; return 8 * (i >> 2) + 4 * n + (i & 3); }

struct Unit { int pm, pn; };
struct Gemm { const bf16_t* A; const bf16_t* Bt; int M, N, K; };

struct StaticOrder {
    int nM, nN, nwg, G, c, wgm;
    __host__ __device__ void init(int M, int N, int G_, int c_, int wgm_ = WGM) { nM = M / BM; nN = N / BM; nwg = nM * nN; G = G_; c = c_; wgm = wgm_; }
    __host__ __device__ bool next(int i, Unit& u) const {
        const long L = (long)i * G + c; if (L >= nwg) return false;
        int wgid = (int)L; { const int q = nwg / NXCD, r = nwg % NXCD, xcd = wgid % NXCD, off = wgid / NXCD; wgid = (xcd < r ? xcd * (q + 1) : r * (q + 1) + (xcd - r) * q) + off; }
        const int nig = wgm * nN, gid = wgid / nig, fm = gid * wgm, gsz = (nM - fm) < wgm ? (nM - fm) : wgm;
        u.pm = fm + ((wgid % nig) % gsz); u.pn = (wgid % nig) / gsz; return true;
    }
    __device__ __forceinline__ void a_ready(const Unit&) const {}
    __device__ __forceinline__ void done(const Unit&) const {}
};

__device__ __forceinline__ unsigned cvt_pk_bf16(float lo, float hi) { unsigned r; asm volatile("v_cvt_pk_bf16_f32 %0, %1, %2" : "=v"(r) : "v"(lo), "v"(hi)); return r; }
typedef float f32x2 __attribute__((ext_vector_type(2)));
typedef unsigned u32x2 __attribute__((ext_vector_type(2)));
struct EpiQKV {
    static constexpr bool PERM = true, AFTER_DRAIN = false;
    bf16_t* O; int S; unsigned* norm4;
    __device__ __forceinline__ void operator()(const f32x4 (&acc)[2][2][4][2], const Unit& u, int wr, int wc, int fr, int fq) const {
        const int row0 = u.pm * BM + wr * 64 + fr, d0 = wc * 32 + 8 * fq;
#pragma unroll
        for (int bj = 0; bj < 2; ++bj) { bf16_t* hb = O + (size_t)(2 * u.pn + bj) * S * 128 + d0;
#pragma unroll
            for (int ai = 0; ai < 2; ++ai)
#pragma unroll
                for (int m = 0; m < 4; ++m) { const f32x4 v0 = acc[ai][bj][m][0], v1 = acc[ai][bj][m][1];
                    u32x4 w; w.x = cvt_pk_bf16(v0[0], v0[1]); w.y = cvt_pk_bf16(v0[2], v0[3]); w.z = cvt_pk_bf16(v1[0], v1[1]); w.w = cvt_pk_bf16(v1[2], v1[3]);
                    *(u32x4*)(hb + (size_t)(row0 + ai * HALF + m * 16) * 128) = w; } }
        if (u.pn < 16) {
#pragma unroll
            for (int bj = 0; bj < 2; ++bj) { float mx = 0.f;
#pragma unroll
                for (int ai = 0; ai < 2; ++ai)
#pragma unroll
                    for (int m = 0; m < 4; ++m) { const f32x4 v0 = acc[ai][bj][m][0], v1 = acc[ai][bj][m][1];
                        float ss = (v0[0] * v0[0] + v0[1] * v0[1]) + (v0[2] * v0[2] + v0[3] * v0[3]) + (v1[0] * v1[0] + v1[1] * v1[1]) + (v1[2] * v1[2] + v1[3] * v1[3]);
                        ss += __shfl_xor(ss, 16); ss += __shfl_xor(ss, 32); mx = fmaxf(mx, ss); }
                mx = fmaxf(mx, __shfl_xor(mx, 1)); mx = fmaxf(mx, __shfl_xor(mx, 2)); mx = fmaxf(mx, __shfl_xor(mx, 4)); mx = fmaxf(mx, __shfl_xor(mx, 8));
                if (fr == 0 && fq == 0) atomicMax(norm4 + (2 * u.pn + bj) * 4 + wc, __float_as_uint(mx)); }
        }
    }
};
struct EpiRes {
    static constexpr bool PERM = false, AFTER_DRAIN = false;
    const float* base; float* out; int ldc;
    __device__ __forceinline__ void operator()(const f32x4 (&acc)[2][2][4][2], const Unit& u, int wr, int wc, int fr, int fq) const {
        const int col0 = u.pn * BM + wc * 32 + 4 * fq;
#pragma unroll
        for (int ai = 0; ai < 2; ++ai)
#pragma unroll
            for (int m = 0; m < 4; ++m) { const size_t off = (size_t)(u.pm * BM + ai * HALF + wr * 64 + m * 16 + fr) * ldc + col0;
#pragma unroll
                for (int bj = 0; bj < 2; ++bj)
#pragma unroll
                    for (int n = 0; n < 2; ++n) { const f32x4 bs = *(const f32x4*)(base + off + bj * HALF + n * 16); *(f32x4*)(out + off + bj * HALF + n * 16) = bs + acc[ai][bj][m][n]; }
                if (m & 1) asm volatile("" ::: "memory"); }
    }
};
struct EpiX1 {
    static constexpr bool PERM = false, AFTER_DRAIN = false;
    const float* base; bf16_t* xb; float* ssq; int ldc;
    __device__ __forceinline__ void operator()(const f32x4 (&acc)[2][2][4][2], const Unit& u, int wr, int wc, int fr, int fq) const {
        const int col0 = u.pn * BM + wc * 32 + 4 * fq;
#pragma unroll
        for (int ai = 0; ai < 2; ++ai) {
#pragma unroll
            for (int m = 0; m < 4; ++m) { const int row = u.pm * BM + ai * HALF + wr * 64 + m * 16 + fr; const size_t off = (size_t)row * ldc + col0; float s = 0.f;
#pragma unroll
                for (int bj = 0; bj < 2; ++bj)
#pragma unroll
                    for (int n = 0; n < 2; ++n) { const f32x4 v = *(const f32x4*)(base + off + bj * HALF + n * 16) + acc[ai][bj][m][n];
                        u32x2 w; w.x = cvt_pk_bf16(v[0], v[1]); w.y = cvt_pk_bf16(v[2], v[3]); *(u32x2*)(xb + off + bj * HALF + n * 16) = w; s += (v[0] * v[0] + v[1] * v[1]) + (v[2] * v[2] + v[3] * v[3]); }
                s += __shfl_xor(s, 16); s += __shfl_xor(s, 32);
                if (fq == 0) atomicAdd(ssq + row, s); }
            asm volatile("" ::: "memory"); }
    }
};
struct EpiX2 {
    static constexpr bool PERM = false, AFTER_DRAIN = false;
    bf16_t* xb; float* ssq; int ldc;
    __device__ __forceinline__ void operator()(const f32x4 (&acc)[2][2][4][2], const Unit& u, int wr, int wc, int fr, int fq) const {
        const int col0 = u.pn * BM + wc * 32 + 4 * fq;
#pragma unroll
        for (int ai = 0; ai < 2; ++ai) {
#pragma unroll
            for (int m = 0; m < 4; ++m) { const int row = u.pm * BM + ai * HALF + wr * 64 + m * 16 + fr; const size_t off = (size_t)row * ldc + col0; float s = 0.f;
#pragma unroll
                for (int bj = 0; bj < 2; ++bj)
#pragma unroll
                    for (int n = 0; n < 2; ++n) { bf16_t* p = xb + off + bj * HALF + n * 16; const u32x2 r = *(const u32x2*)p; f32x4 v;
                        v[0] = __uint_as_float(r.x << 16); v[1] = __uint_as_float(r.x & 0xffff0000u); v[2] = __uint_as_float(r.y << 16); v[3] = __uint_as_float(r.y & 0xffff0000u); v += acc[ai][bj][m][n];
                        u32x2 w; w.x = cvt_pk_bf16(v[0], v[1]); w.y = cvt_pk_bf16(v[2], v[3]); *(u32x2*)p = w; s += (v[0] * v[0] + v[1] * v[1]) + (v[2] * v[2] + v[3] * v[3]); }
                s += __shfl_xor(s, 16); s += __shfl_xor(s, 32);
                if (fq == 0) atomicAdd(ssq + row, s); }
            asm volatile("" ::: "memory"); }
    }
};
__device__ __forceinline__ float dpp_shr1(float cur, float prev) {
    const int o = __builtin_amdgcn_update_dpp(0, __builtin_bit_cast(int, prev), 0x121, 0xf, 0xf, false);
    return __builtin_bit_cast(float, __builtin_amdgcn_update_dpp(o, __builtin_bit_cast(int, cur), 0x111, 0xf, 0xf, false));
}
__device__ __forceinline__ float dpp_shr2(float cur, float prev) {
    const int o = __builtin_amdgcn_update_dpp(0, __builtin_bit_cast(int, prev), 0x122, 0xf, 0xf, false);
    return __builtin_bit_cast(float, __builtin_amdgcn_update_dpp(o, __builtin_bit_cast(int, cur), 0x112, 0xf, 0xf, false));
}
__device__ __forceinline__ float silu_f(float g) { return g * __builtin_amdgcn_rcpf(1.0f + __builtin_amdgcn_exp2f(-1.4426950408889634f * g)); }
struct EpiGate {
    static constexpr bool PERM = true, AFTER_DRAIN = false;
    bf16_t* ACT; int ldc;
    const float* cw; const float* cb;
    float* GB; float* GF; float* VF;
    const float* ssq;
    __device__ __forceinline__ void operator()(const f32x4 (&acc)[2][2][4][2], const Unit& u, int wr, int wc, int fr, int fq) const {
        const int c0 = u.pn * HALF + wc * 32 + 8 * fq;
        f32x4 w0[2], w1[2], w2[2], bb[2];
#pragma unroll
        for (int n = 0; n < 2; ++n) { w0[n] = *(const f32x4*)(cw + c0 + 4 * n); w1[n] = *(const f32x4*)(cw + ldc + c0 + 4 * n); w2[n] = *(const f32x4*)(cw + 2 * ldc + c0 + 4 * n); bb[n] = *(const f32x4*)(cb + c0 + 4 * n); }
#pragma unroll
        for (int ai = 0; ai < 2; ++ai) {
            const int g64 = u.pm * 4 + ai * 2 + wr;
            float rs[4];
#pragma unroll
            for (int m = 0; m < 4; ++m) rs[m] = rsqrtf(ssq[u.pm * BM + ai * HALF + wr * 64 + m * 16 + fr] * (1.0f / 4096.0f) + 1e-6f);
#pragma unroll
            for (int m = 0; m < 4; ++m) {
                const int row = u.pm * BM + ai * HALF + wr * 64 + m * 16 + fr;
                f32x4 a[2];
#pragma unroll
                for (int n = 0; n < 2; ++n)
#pragma unroll
                    for (int j = 0; j < 4; ++j) {
                        const float cur = acc[ai][0][m][n][j] * rs[m], prev = acc[ai][0][m > 0 ? m - 1 : 0][n][j] * rs[m > 0 ? m - 1 : 0];
                        const float s1 = dpp_shr1(cur, prev), s2 = dpp_shr2(cur, prev);
                        const float g = w2[n][j] * cur + w1[n][j] * s1 + w0[n][j] * s2 + bb[n][j];
                        a[n][j] = silu_f(g) * (acc[ai][1][m][n][j] * rs[m]);
                    }
                if (m == 0 && fr < 2) {
                    float* gf = GF + ((size_t)g64 * 2 + fr) * ldc + c0; float* vf = VF + ((size_t)g64 * 2 + fr) * ldc + c0;
                    *(f32x4*)gf = acc[ai][0][0][0] * rs[0]; *(f32x4*)(gf + 4) = acc[ai][0][0][1] * rs[0]; *(f32x4*)vf = acc[ai][1][0][0] * rs[0]; *(f32x4*)(vf + 4) = acc[ai][1][0][1] * rs[0];
                } else {
                    u32x4 w; w.x = cvt_pk_bf16(a[0][0], a[0][1]); w.y = cvt_pk_bf16(a[0][2], a[0][3]); w.z = cvt_pk_bf16(a[1][0], a[1][1]); w.w = cvt_pk_bf16(a[1][2], a[1][3]);
                    *(u32x4*)(ACT + (size_t)row * ldc + c0) = w;
                }
                if (m == 3 && fr >= 14) { float* gb = GB + ((size_t)g64 * 2 + (fr - 14)) * ldc + c0; *(f32x4*)gb = acc[ai][0][3][0] * rs[3]; *(f32x4*)(gb + 4) = acc[ai][0][3][1] * rs[3]; }
            }
        }
    }
};
template <class Epi, class Sched, bool ALIGN_EPI = false, bool SP2 = false>
__device__ __forceinline__ void gemm_phase(PG8_LAS unsigned char* lds, const Gemm g, const Sched& S, const Epi& E, const int tid) {
    const int wid = __builtin_amdgcn_readfirstlane(tid >> 6), lane = tid & 63, wr = wid >> 2, wc = wid & 3, fr = lane & 15, fq = lane >> 4;
    const int K = g.K, nt = K / BK;
    unsigned voffA[2], voffB[2];
#pragma unroll
    for (int i = 0; i < 2; ++i) { int R, C; stage_rc(tid * 16 + i * 8192, R, C); const int Rb = Epi::PERM ? ((R & ~31) + perm32(R & 31)) : R;
        voffA[i] = (unsigned)(R * K + C) * 2u; voffB[i] = (unsigned)(Rb * K + C) * 2u; }
    const size_t kstep = (size_t)(BK * 2);
    const size_t hstep = (size_t)HALF * K * 2;
    const size_t tstep = 2 * hstep;
    const unsigned ldsw = (unsigned)wid * 1024u;
    const int aoff = lds_byte(wr * 64 + fr, fq * 8), boff = lds_byte(wc * 32 + fr, fq * 8);
#define PG8_SA(b, h) (((b) * 2 + (h)) * HTB)
#define PG8_SB(b, h) ((4 + (b) * 2 + (h)) * HTB)
#define PG8_STAGE(bufoff, gbase, voff) do { _Pragma("unroll") for (int _i = 0; _i < 2; ++_i) \
        __builtin_amdgcn_global_load_lds((const unsigned*)((const char*)(gbase) + (voff)[_i]), (PG8_LAS unsigned*)(lds + (bufoff) + ldsw + _i * 8192), 16, 0, 0); } while (0)
#define PG8_LDA(dst, b, h) do { _Pragma("unroll") for (int m = 0; m < 4; ++m) _Pragma("unroll") for (int k = 0; k < 2; ++k) dst[m][k] = *(const PG8_LAS bf16x8*)(lds + PG8_SA(b, h) + aoff + m * 2048 + k * 1024); } while (0)
#define PG8_LDB(dst, b, h) do { _Pragma("unroll") for (int n = 0; n < 2; ++n) _Pragma("unroll") for (int k = 0; k < 2; ++k) dst[n][k] = *(const PG8_LAS bf16x8*)(lds + PG8_SB(b, h) + boff + n * 2048 + k * 1024); } while (0)
#define PG8_MMA(ai, bj, At, Bt) do { __builtin_amdgcn_s_setprio(1); _Pragma("unroll") for (int m = 0; m < 4; ++m) _Pragma("unroll") for (int n = 0; n < 2; ++n) _Pragma("unroll") for (int k = 0; k < 2; ++k) \
        acc[ai][bj][m][n] = __builtin_amdgcn_mfma_f32_16x16x32_bf16(Bt[n][k], At[m][k], acc[ai][bj][m][n], 0, 0, 0); __builtin_amdgcn_s_setprio(0); } while (0)
#define PG8_WAIT_V(n) asm volatile("s_waitcnt vmcnt(" #n ")" ::: "memory")
#define PG8_WAIT_L(n) asm volatile("s_waitcnt lgkmcnt(" #n ")" ::: "memory")
#define PG8_BAR __builtin_amdgcn_s_barrier()
#define PG8_SCHED __builtin_amdgcn_sched_barrier(0)
    Unit cur, nxt; int ui = 0;
    if (!S.next(0, cur)) return;
    f32x4 acc[2][2][4][2];
#pragma unroll
    for (int a = 0; a < 2; ++a)
#pragma unroll
        for (int b = 0; b < 2; ++b)
#pragma unroll
            for (int m = 0; m < 4; ++m)
#pragma unroll
                for (int n = 0; n < 2; ++n) acc[a][b][m][n] = (f32x4){0.f, 0.f, 0.f, 0.f};
    bf16x8 At[4][2], B0[2][2], B1[2][2];
    const char* cA = (const char*)g.A + (size_t)cur.pm * tstep; const char* cB = (const char*)g.Bt + (size_t)cur.pn * tstep;
    S.a_ready(cur);
    if constexpr (SP2) {
        PG8_STAGE(PG8_SB(0, 0), cB, voffB); PG8_STAGE(PG8_SB(0, 1), cB + hstep, voffB); PG8_STAGE(PG8_SA(0, 0), cA, voffA); PG8_STAGE(PG8_SA(0, 1), cA + hstep, voffA);
        if (wr == 1) PG8_BAR;
        PG8_WAIT_V(2); PG8_BAR;
        PG8_STAGE(PG8_SB(1, 0), cB + kstep, voffB); PG8_STAGE(PG8_SA(1, 0), cA + kstep, voffA); PG8_STAGE(PG8_SB(1, 1), cB + hstep + kstep, voffB);
        PG8_WAIT_V(6); PG8_BAR;
    } else {
        PG8_STAGE(PG8_SB(0, 0), cB, voffB); PG8_STAGE(PG8_SA(0, 0), cA, voffA); PG8_STAGE(PG8_SB(0, 1), cB + hstep, voffB); PG8_STAGE(PG8_SA(0, 1), cA + hstep, voffA);
        if (wr == 1) PG8_BAR;
        PG8_WAIT_V(4); PG8_BAR;
        PG8_STAGE(PG8_SB(1, 0), cB + kstep, voffB); PG8_STAGE(PG8_SA(1, 0), cA + kstep, voffA); PG8_STAGE(PG8_SB(1, 1), cB + hstep + kstep, voffB);
        PG8_WAIT_V(6); PG8_BAR;
    }
    for (;;) {
        const bool has_next = S.next(ui + 1, nxt);
        const char* nA = has_next ? (const char*)g.A + (size_t)nxt.pm * tstep : cA; const char* nB = has_next ? (const char*)g.Bt + (size_t)nxt.pn * tstep : cB;
        for (int t = 0; t < nt; t += 2) {
            const bool last = (t == nt - 2);
            const char* a1 = cA + (size_t)(t + 1) * kstep;
            const char* a2 = last ? nA : cA + (size_t)(t + 2) * kstep; const char* b2 = last ? nB : cB + (size_t)(t + 2) * kstep;
            const char* a3 = a2 + kstep; const char* b3 = b2 + kstep;
            if (last && has_next) S.a_ready(nxt);
            if constexpr (SP2) {
            PG8_LDB(B0, 0, 0); PG8_LDB(B1, 0, 1); PG8_SCHED; PG8_LDA(At, 0, 0); PG8_STAGE(PG8_SA(1, 1), a1 + hstep, voffA);
            PG8_WAIT_V(8); PG8_WAIT_L(0); PG8_BAR; PG8_MMA(0, 0, At, B0); PG8_MMA(0, 1, At, B1); PG8_BAR; PG8_SCHED;
            PG8_LDA(At, 0, 1); PG8_STAGE(PG8_SB(0, 0), b2, voffB); PG8_STAGE(PG8_SB(0, 1), b2 + hstep, voffB); PG8_STAGE(PG8_SA(0, 0), a2, voffA);
            PG8_WAIT_V(8); PG8_WAIT_L(0); PG8_BAR; PG8_MMA(1, 0, At, B0); PG8_MMA(1, 1, At, B1); PG8_BAR; PG8_SCHED;
            PG8_LDB(B0, 1, 0); PG8_LDB(B1, 1, 1); PG8_SCHED; PG8_LDA(At, 1, 0); PG8_STAGE(PG8_SA(0, 1), a2 + hstep, voffA);
            PG8_WAIT_V(8); PG8_WAIT_L(0); PG8_BAR; PG8_MMA(0, 0, At, B0); PG8_MMA(0, 1, At, B1); PG8_BAR; PG8_SCHED;
            PG8_LDA(At, 1, 1); PG8_STAGE(PG8_SB(1, 0), b3, voffB); PG8_STAGE(PG8_SB(1, 1), b3 + hstep, voffB); PG8_STAGE(PG8_SA(1, 0), a3, voffA);
            PG8_WAIT_V(8); PG8_WAIT_L(0); PG8_BAR; PG8_MMA(1, 0, At, B0); PG8_MMA(1, 1, At, B1); PG8_BAR; PG8_SCHED;
            } else {
            PG8_LDB(B0, 0, 0); PG8_SCHED; PG8_LDA(At, 0, 0); PG8_STAGE(PG8_SA(1, 1), a1 + hstep, voffA);
            PG8_WAIT_L(8); PG8_BAR; PG8_WAIT_L(0); PG8_MMA(0, 0, At, B0); PG8_BAR; PG8_SCHED;
            PG8_LDB(B1, 0, 1); PG8_STAGE(PG8_SB(0, 0), b2, voffB);
            PG8_BAR; PG8_WAIT_L(0); PG8_MMA(0, 1, At, B1); PG8_BAR;
            PG8_LDA(At, 0, 1); PG8_STAGE(PG8_SA(0, 0), a2, voffA);
            PG8_BAR; PG8_WAIT_L(0); PG8_MMA(1, 0, At, B0); PG8_BAR; PG8_SCHED;
            PG8_STAGE(PG8_SB(0, 1), b2 + hstep, voffB);
            PG8_WAIT_V(6); PG8_BAR; PG8_MMA(1, 1, At, B1); PG8_BAR;
            PG8_LDB(B0, 1, 0); PG8_SCHED; PG8_LDA(At, 1, 0); PG8_STAGE(PG8_SA(0, 1), a2 + hstep, voffA);
            PG8_WAIT_L(8); PG8_BAR; PG8_WAIT_L(0); PG8_MMA(0, 0, At, B0); PG8_BAR; PG8_SCHED;
            PG8_LDB(B1, 1, 1); PG8_STAGE(PG8_SB(1, 0), b3, voffB);
            PG8_BAR; PG8_WAIT_L(0); PG8_MMA(0, 1, At, B1); PG8_BAR;
            PG8_LDA(At, 1, 1); PG8_STAGE(PG8_SA(1, 0), a3, voffA);
            PG8_BAR; PG8_WAIT_L(0); PG8_MMA(1, 0, At, B0); PG8_BAR; PG8_SCHED;
            PG8_STAGE(PG8_SB(1, 1), b3 + hstep, voffB);
            PG8_WAIT_V(6); PG8_BAR; PG8_MMA(1, 1, At, B1); PG8_BAR;
            }
        }
        if constexpr (ALIGN_EPI) { if (wr == 0) PG8_BAR; }
        if constexpr (!Epi::AFTER_DRAIN) { E(acc, cur, wr, wc, fr, fq); S.done(cur); }
        if (!has_next) break;
#pragma unroll
        for (int a = 0; a < 2; ++a)
#pragma unroll
            for (int b = 0; b < 2; ++b)
#pragma unroll
                for (int m = 0; m < 4; ++m)
#pragma unroll
                    for (int n = 0; n < 2; ++n) acc[a][b][m][n] = (f32x4){0.f, 0.f, 0.f, 0.f};
        cur = nxt; cA = nA; cB = nB; ++ui;
        if constexpr (ALIGN_EPI) { if (wr == 1) PG8_BAR; }
    }
    PG8_WAIT_V(0);
    if constexpr (!ALIGN_EPI) { if (wr == 0) PG8_BAR; }
    PG8_BAR;
    if constexpr (Epi::AFTER_DRAIN) { E.fused(acc, cur, wr, wc, fr, fq, lds, wid, lane); S.done(cur); }
#undef PG8_SA
#undef PG8_SB
#undef PG8_STAGE
#undef PG8_LDA
#undef PG8_LDB
#undef PG8_MMA
#undef PG8_WAIT_V
#undef PG8_WAIT_L
#undef PG8_BAR
#undef PG8_SCHED
}
}
namespace att {
typedef unsigned short bf16_t;
typedef short bf16x8 __attribute__((ext_vector_type(8)));
typedef short s16x4 __attribute__((ext_vector_type(4)));
typedef float f32x16 __attribute__((ext_vector_type(16)));
typedef float f32x4 __attribute__((ext_vector_type(4)));
typedef unsigned u32x4 __attribute__((ext_vector_type(4)));
constexpr int D = 128;
constexpr float SCALE = 0.08838834764831845f;
constexpr float THR = 8.f;
constexpr int NW = 8, QBLK = 32, KVBLK = 64, QB = NW * QBLK;
constexpr int SHM_V = KVBLK * D * 2, SHM_K = KVBLK * D * 2;
constexpr int LDS_TILES = 2 * SHM_V + 2 * SHM_K + NW * 64 * 4;
constexpr int LDS_BIAS = LDS_TILES;
constexpr int LDS_DTAB = LDS_BIAS + 32768 + 2048;
constexpr int DTAB_STRIDE = 132 * 4, DTAB_BYTES = 48 * DTAB_STRIDE;
constexpr int LDS_END = LDS_DTAB + DTAB_BYTES + 2048;
constexpr int DILW = 129;

#define KSWZ(row, colB) ((row) * 256 + ((colB) ^ (((row) & 7) << 4)))
#define SBAR() __builtin_amdgcn_sched_barrier(0)
__device__ __forceinline__ int v_st(int k, int c) { const int kk = (k & ~0xC) | ((k & 4) << 1) | ((k & 8) >> 1); return ((kk >> 3) * 4 + (c >> 5)) * 512 + ((kk & 7) * 32 + (c & 31)) * 2; }
__device__ __forceinline__ int v_rd_base(int lane) { return ((lane & 3) << 3) | (((lane >> 2) & 3) << 6) | (((lane >> 4) & 1) << 5) | (((lane >> 5) & 1) << 8); }
constexpr int v_rd_off(int d0, int ks, int half) { return d0 * 512 + ks * 4096 + half * 2048; }
__device__ __forceinline__ int crow(int r, int hi) { return (r & 3) + 8 * (r >> 2) + 4 * hi; }
__device__ __forceinline__ unsigned cvtpk(float lo, float hi) { unsigned r; asm volatile("v_cvt_pk_bf16_f32 %0, %1, %2" : "=v"(r) : "v"(lo), "v"(hi)); return r; }
__device__ __forceinline__ bf16x8 gld8(const void* ubase, unsigned voff) { return *reinterpret_cast<const bf16x8*>((const char*)ubase + voff); }
__device__ __forceinline__ void mask_tile(f32x16& p0, f32x16& p1, int dq, unsigned W) {
    const float NEG = -__builtin_inff();
#pragma unroll
    for (int r = 0; r < 16; ++r) {
        const int c = (r & 3) + 8 * (r >> 2);
        if ((unsigned)(dq - c) >= W) p0[r] = NEG;
        if ((unsigned)(dq - c - 32) >= W) p1[r] = NEG;
    }
}
__device__ __forceinline__ void partialSM(f32x16& p0, f32x16& p1, float& m_reg, float& mn, float& alpha) {
    float pmax = p0[0]; for (int r = 1; r < 16; ++r) pmax = fmaxf(pmax, p0[r]); for (int r = 0; r < 16; ++r) pmax = fmaxf(pmax, p1[r]);
    { auto rr = __builtin_amdgcn_permlane32_swap(__float_as_uint(pmax), __float_as_uint(pmax), false, false);
      pmax = fmaxf(__uint_as_float(rr[0]), __uint_as_float(rr[1])); }
    constexpr float C2 = 1.4426950408889634f * SCALE;
    if (__builtin_expect(__all((pmax - m_reg) * SCALE <= THR), 1)) { mn = m_reg; alpha = 1.f; }
    else { mn = fmaxf(m_reg, pmax); alpha = __builtin_amdgcn_exp2f((m_reg - mn) * C2); m_reg = mn; }
    const float mnL = -mn * C2;
    for (int r = 0; r < 16; ++r) p0[r] = fmaf(p0[r], C2, mnL); for (int r = 0; r < 16; ++r) p1[r] = fmaf(p1[r], C2, mnL);
    for (int r = 0; r < 16; ++r) p0[r] = __builtin_amdgcn_exp2f(p0[r]);
}
__device__ __forceinline__ void finishSM(f32x16& p0, f32x16& p1, float alpha, float& l_reg, bf16x8& pa0, bf16x8& pa1, bf16x8& pa2, bf16x8& pa3) {
    for (int r = 0; r < 16; ++r) p1[r] = __builtin_amdgcn_exp2f(p1[r]);
    float ps = 0; for (int r = 0; r < 16; ++r) ps += p0[r]; for (int r = 0; r < 16; ++r) ps += p1[r];
    { auto rr = __builtin_amdgcn_permlane32_swap(__float_as_uint(ps), __float_as_uint(ps), false, false);
      ps = __uint_as_float(rr[0]) + __uint_as_float(rr[1]); }
    l_reg = l_reg * alpha + ps;
#define PK4(P, B_, OUT) do { unsigned a0 = cvtpk(P[B_+0], P[B_+1]), a1 = cvtpk(P[B_+2], P[B_+3]);                          \
        unsigned b0 = cvtpk(P[B_+4], P[B_+5]), b1 = cvtpk(P[B_+6], P[B_+7]);                                             \
        auto r0 = __builtin_amdgcn_permlane32_swap(a0, b0, false, false); auto r1 = __builtin_amdgcn_permlane32_swap(a1, b1, false, false); \
        u32x4 w = {r0[0], r1[0], r0[1], r1[1]}; OUT = *reinterpret_cast<bf16x8*>(&w); } while (0)
    PK4(p0, 0, pa0); PK4(p0, 8, pa1); PK4(p1, 0, pa2); PK4(p1, 8, pa3);
#undef PK4
}
template <int KB, int MODE>
__device__ __forceinline__ void qkt(f32x16& p0, f32x16& p1, const char* K_lds, int r32, int hi, const bf16x8* qr, bool act, const char* bptr, int dq) {
    constexpr bool SK = MODE == 1;
    const float NEG = -__builtin_inff();
    if (SK && !act) {
#pragma unroll
        for (int r = 0; r < 16; ++r) { p0[r] = NEG; p1[r] = NEG; } return; }
    if (MODE == 0) {
#pragma unroll
        for (int g = 0; g < 4; ++g) { const f32x4 v0 = *(const f32x4*)(bptr + 32 * g), v1 = *(const f32x4*)(bptr + 128 + 32 * g);
#pragma unroll
            for (int j = 0; j < 4; ++j) { p0[4 * g + j] = v0[j]; p1[4 * g + j] = v1[j]; } }
    } else {
#pragma unroll
        for (int r = 0; r < 16; ++r) { const int c = (r & 3) + 8 * (r >> 2);
            const float b0 = *(const float*)(bptr + 4 * c), b1 = *(const float*)(bptr + 4 * c + 128);
            p0[r] = ((unsigned)(dq - c) < (unsigned)DILW) ? b0 : NEG; p1[r] = ((unsigned)(dq - c - 32) < (unsigned)DILW) ? b1 : NEG; }
    }
    const char* kb[4];
#pragma unroll
    for (int dd = 0; dd < 4; ++dd) kb[dd] = K_lds + KB * SHM_K + KSWZ(r32, (dd * 16 + hi * 8) * 2);
#pragma unroll
    for (int d0 = 0; d0 < 8; ++d0) { const char* a = kb[d0 & 3] + (d0 >> 2) * 128;
        bf16x8 b0 = *reinterpret_cast<const bf16x8*>(a);
        bf16x8 b1 = *reinterpret_cast<const bf16x8*>(a + 32 * 256);
        p0 = __builtin_amdgcn_mfma_f32_32x32x16_bf16(b0, qr[d0], p0, 0, 0, 0);
        p1 = __builtin_amdgcn_mfma_f32_32x32x16_bf16(b1, qr[d0], p1, 0, 0, 0); }
}
template <int VB, bool SK>
__device__ __forceinline__ void pv_tile(f32x16* o, int vb0, bf16x8 pa0, bf16x8 pa1, bf16x8 pa2, bf16x8 pa3, bool act) {
    if (SK && !act) return;
#define TRRD(dst, off) asm volatile("ds_read_b64_tr_b16 %0, %1 offset:%2" : "=&v"(dst) : "v"(vb0), "i"(off) : "memory")
#define PV_D0(d0) do { s16x4 l0, l1, l2, l3, h0, h1, h2, h3; constexpr int b_ = VB * SHM_V + v_rd_off(d0, 0, 0);  \
        TRRD(l0, b_); TRRD(h0, b_ + 2048); TRRD(l1, b_ + 4096); TRRD(h1, b_ + 6144); TRRD(l2, b_ + 8192); TRRD(h2, b_ + 10240); TRRD(l3, b_ + 12288); TRRD(h3, b_ + 14336); \
        asm volatile("s_waitcnt lgkmcnt(0)" ::: "memory"); SBAR();   \
        o[d0] = __builtin_amdgcn_mfma_f32_32x32x16_bf16(pa0, (bf16x8){l0[0], l0[1], l0[2], l0[3], h0[0], h0[1], h0[2], h0[3]}, o[d0], 0, 0, 0);   \
        o[d0] = __builtin_amdgcn_mfma_f32_32x32x16_bf16(pa1, (bf16x8){l1[0], l1[1], l1[2], l1[3], h1[0], h1[1], h1[2], h1[3]}, o[d0], 0, 0, 0);   \
        o[d0] = __builtin_amdgcn_mfma_f32_32x32x16_bf16(pa2, (bf16x8){l2[0], l2[1], l2[2], l2[3], h2[0], h2[1], h2[2], h2[3]}, o[d0], 0, 0, 0);   \
        o[d0] = __builtin_amdgcn_mfma_f32_32x32x16_bf16(pa3, (bf16x8){l3[0], l3[1], l3[2], l3[3], h3[0], h3[1], h3[2], h3[3]}, o[d0], 0, 0, 0); } while (0)
    PV_D0(0); PV_D0(1); PV_D0(2); PV_D0(3);
#undef PV_D0
#undef TRRD
}

struct BlockRef { const bf16_t* Q; const bf16_t* K; const bf16_t* V; bf16_t* O; float* lse; const float* gb; int P0, rs, os, ls, jlo, tab; };
struct Seam { bf16x8 qr[8]; bf16x8 st_v0, st_v1, st_k0, st_k1; };
#define ROWP(p, rs_, k0, rr) ((p) + (size_t)((k0) + (rr)) * (rs_) + sc)
#define VMW() asm volatile("s_waitcnt vmcnt(0)" ::: "memory")
#define VMWN(n) asm volatile("s_waitcnt vmcnt(%0)" :: "i"(n) : "memory")
#define SLOAD_H(Kp, Vp, rs_, k0, vo) do { const char* kb_ = (const char*)((Kp) + (size_t)(k0) * (rs_)); const char* vb_ = (const char*)((Vp) + (size_t)(k0) * (rs_)); const size_t h_ = (size_t)64 * (rs_); \
                         S.st_v0 = gld8(vb_, vo); S.st_v1 = gld8(vb_ + h_, vo); S.st_k0 = gld8(kb_, vo); S.st_k1 = gld8(kb_ + h_, vo); } while (0)
#define SWRITE_HK(bf) do { *(bf16x8*)(K_lds + (bf) * SHM_K + kws) = S.st_k0; *(bf16x8*)(K_lds + (bf) * SHM_K + kws + 32 * 256) = S.st_k1; } while (0)
#define SWRITE_HV(bf) do { *(bf16x8*)(V_lds + (bf) * SHM_V + vst0) = S.st_v0; *(bf16x8*)(V_lds + (bf) * SHM_V + vst1) = S.st_v1; } while (0)
#define SWRITE_H(bf) do { SWRITE_HV(bf); SWRITE_HK(bf); } while (0)
__device__ __forceinline__ void attn_prime(const BlockRef& cur, char* lds, Seam& S, const int tid) {
    const int wid = __builtin_amdgcn_readfirstlane(tid >> 6), lane = tid & 63, r32 = lane & 31, hi = lane >> 5;
    const int sr = tid >> 4, sc = (tid & 15) * 8, kws = KSWZ(sr, sc * 2); char* K_lds = lds + 2 * SHM_V;
    const int kb0 = cur.jlo * KVBLK;
    { const char* qb_ = (const char*)(cur.Q + (size_t)(wid * QBLK) * cur.rs); const unsigned qv_ = (unsigned)(r32 * cur.rs + hi * 8) * 2u;
      for (int d0 = 0; d0 < 8; ++d0) S.qr[d0] = gld8(qb_ + d0 * 32, qv_); }
    { const unsigned vo_ = (unsigned)(sr * cur.rs + sc) * 2u; SLOAD_H(cur.K, cur.V, cur.rs, kb0, vo_); } VMW(); SWRITE_HK(0);
    __syncthreads();
}
template <int MODE>
__device__ __forceinline__ void attn_block(const BlockRef& cur, const BlockRef& nxt, char* lds, Seam& S, const int tid) {
    constexpr bool SK = MODE == 1;
    constexpr int W = MODE == 1 ? DILW : (1 << 30);
    const int wid = __builtin_amdgcn_readfirstlane(tid >> 6), lane = tid & 63, r32 = lane & 31, hi = lane >> 5;
    const int j_lo = cur.jlo;
    const int j_hi = (cur.P0 + QB - 1) / KVBLK + 1;
    const int NT = j_hi - j_lo;
    const int kbn = nxt.jlo * KVBLK;
    const int qlo = cur.P0 + wid * QBLK, qm = qlo + r32 - 4 * hi;
    char* V_lds = lds; char* K_lds = lds + 2 * SHM_V;
    float* ws = (float*)(lds + 2 * SHM_V + 2 * SHM_K) + wid * 64; float* li_l = ws, * al_l = ws + 32;
    float m_reg = -1e30f, l_reg = 0; f32x16 o[4] = {};
    const int sr = tid >> 4, sc = (tid & 15) * 8, vst0 = v_st(sr, sc), vst1 = v_st(32 + sr, sc), kws = KSWZ(sr, sc * 2);
    const int vb0 = (int)(uintptr_t)V_lds + v_rd_base(lane);
    const bf16_t* Kh = cur.K; const bf16_t* Vh = cur.V; const int rs = cur.rs; const unsigned kvo = (unsigned)(sr * rs + sc) * 2u;
    const char* bb0 = (MODE == 0) ? (lds + LDS_BIAS + hi * 16) : (lds + cur.tab + (128 - qm) * 4);
#define RESC(a) do { if (__any((a) < 1.f)) { if (hi == 0) al_l[r32] = (a); asm volatile("s_waitcnt lgkmcnt(0)" ::: "memory");              \
                     for (int d_ = 0; d_ < 4; ++d_) for (int r = 0; r < 16; ++r) o[d_][r] *= al_l[crow(r, hi)]; } } while (0)
#define KBASE(t) ((j_lo + (t)) * KVBLK)
#define ACT(t) (KBASE(t) <= qlo + QBLK - 1 && KBASE(t) + KVBLK - 1 >= qlo - W + 1)
#define MASKT(P0_, P1_, t) do { if (MODE == 0) { const int kb_ = KBASE(t); if (kb_ + KVBLK - 1 > qlo) mask_tile(P0_, P1_, qm - kb_, (unsigned)W); } } while (0)
#define QKT(KB, PX0, PX1, t) qkt<KB, MODE>(PX0, PX1, K_lds, r32, hi, S.qr, ACT(t), bb0 + KBASE(t) * 4, qm - KBASE(t))
#define PSM(PX0, PX1, mnX, alX, t) do { if (!SK || ACT(t)) partialSM(PX0, PX1, m_reg, mnX, alX); else { mnX = m_reg; alX = 1.f; } } while (0)
#define FSM(PY0, PY1, alY, t) do { if (!SK || ACT(t)) finishSM(PY0, PY1, alY, l_reg, pa0, pa1, pa2, pa3); } while (0)
    constexpr int NQL = 8;
#define SEAM_K0() do { VMWN(NQL); SWRITE_HK(0); SBAR(); } while (0)
    f32x16 pA0, pA1, pB0, pB1; float mnA, mnB, alA, alB; bf16x8 pa0, pa1, pa2, pa3;
    SWRITE_HV(0); SBAR();
    if (NT > 1) { SLOAD_H(Kh, Vh, rs, KBASE(1), kvo); }
    SBAR(); QKT(0, pA0, pA1, 0);
    MASKT(pA0, pA1, 0); PSM(pA0, pA1, mnA, alA, 0);
    if (NT > 1) { VMW(); SWRITE_H(1); }
    __syncthreads();
#define HALF_STEP(PX0, PX1, mnX, alX, PY0, PY1, alY, t, KB, VB, SB) do {                                                      \
        SBAR(); QKT(KB, PX0, PX1, t);                                             \
        SBAR(); if ((t) + 1 < NT) { SLOAD_H(Kh, Vh, rs, KBASE((t) + 1), kvo); SBAR(); }     \
        FSM(PY0, PY1, alY, (t) - 1); SBAR();                                                           \
        pv_tile<VB, SK>(o, vb0, pa0, pa1, pa2, pa3, ACT((t) - 1)); MASKT(PX0, PX1, (t)); PSM(PX0, PX1, mnX, alX, (t));                                        \
        __syncthreads();                                                                                                      \
        if ((t) + 1 < NT) { VMW(); SWRITE_H(SB); }                                                                          \
        RESC(alX); __syncthreads(); } while (0)
    for (int t = 1; t + 1 < NT; t += 2) {
        HALF_STEP(pB0, pB1, mnB, alB, pA0, pA1, alA, t, 1, 0, 0);
        HALF_STEP(pA0, pA1, mnA, alA, pB0, pB1, alB, t + 1, 0, 1, 1);
    }
    const bool even = (NT & 1) == 0;
    if (even) { SBAR(); QKT(1, pB0, pB1, NT - 1); SBAR(); }
    { const unsigned vo_ = (unsigned)(sr * nxt.rs + sc) * 2u; SLOAD_H(nxt.K, nxt.V, nxt.rs, kbn, vo_); } SBAR();
    { const char* qb_ = (const char*)(nxt.Q + (size_t)(wid * QBLK) * nxt.rs); const unsigned qv_ = (unsigned)(r32 * nxt.rs + hi * 8) * 2u;
#pragma unroll
      for (int d0 = 0; d0 < 8; ++d0) S.qr[d0] = gld8(qb_ + d0 * 32, qv_); }
    SBAR();
    FSM(pA0, pA1, alA, (even ? NT - 2 : NT - 1)); SBAR();
    pv_tile<0, SK>(o, vb0, pa0, pa1, pa2, pa3, ACT(even ? NT - 2 : NT - 1));
    if (even) { MASKT(pB0, pB1, NT - 1); PSM(pB0, pB1, mnB, alB, NT - 1); __syncthreads(); RESC(alB);
        FSM(pB0, pB1, alB, NT - 1); SBAR(); pv_tile<1, SK>(o, vb0, pa0, pa1, pa2, pa3, ACT(NT - 1)); }
    SBAR(); SEAM_K0();
    if (hi == 0) li_l[r32] = l_reg; asm volatile("s_waitcnt lgkmcnt(0)" ::: "memory");
    float rli[16];
#pragma unroll
    for (int r = 0; r < 16; ++r) rli[r] = __builtin_amdgcn_rcpf(li_l[crow(r, hi)]);
    int os_ = __builtin_amdgcn_readfirstlane(cur.os); asm volatile("" : "+s"(os_));
    bf16_t* Ow = cur.O + (size_t)(wid * QBLK) * os_; const unsigned ovo = (unsigned)(4 * hi * os_ + r32) * 2u;
#pragma unroll
    for (int r = 0; r < 16; ++r) { char* ob_ = (char*)(Ow + (size_t)((r & 3) + 8 * (r >> 2)) * os_);
#pragma unroll
        for (int d0 = 0; d0 < 4; ++d0) { const float v = o[d0][r] * rli[r];
            const float vn = __shfl_xor(v, 1);
            if ((r32 & 1) == 0) *(unsigned*)(ob_ + d0 * 64 + ovo) = cvtpk(v, vn); } }
    if (MODE == 1) { constexpr float C2 = 1.4426950408889634f * SCALE;
        if (hi == 0) cur.lse[(size_t)(wid * QBLK + r32) * cur.ls] = m_reg * C2 + __builtin_amdgcn_logf(l_reg); }
    __syncthreads();
#undef RESC
#undef KBASE
#undef ACT
#undef MASKT
#undef QKT
#undef PSM
#undef FSM
#undef SEAM_K0
#undef HALF_STEP
}
#undef ROWP
#undef VMW
#undef VMWN
#undef SLOAD_H
#undef SWRITE_HK
#undef SWRITE_HV
#undef SWRITE_H
#undef KSWZ
#undef SBAR
}
constexpr int SEQ = 8192, DM = 4096, NH = 16, HD = 128, FW = 2048, NQKV = 12288, INW = 12304, DFF = 11008, NUP = 22016;
constexpr float RMS_EPS = 1e-6f;
constexpr float INV_SCALE = 11.313708498984761f;
constexpr int NWAVES = 8;
constexpr size_t MiB = 1u << 20;
constexpr size_t WS_WIN = 0, WS_WF = 96 * MiB, WS_WOUT = 97 * MiB, WS_WUP = 129 * MiB, WS_WDN = 301 * MiB, WS_XN = 387 * MiB, WS_X1 = 453 * MiB, WS_ACT = 581 * MiB;
constexpr size_t WS_MISC = 753 * MiB, WS_CTL = WS_MISC + 3 * MiB, CTL_NORM = 64, CTL_SSQ = 4096, CTL_SSQ2 = 4096 + 32768, CTL_BAR = 4096 + 2 * 32768, CTL_BYTES = CTL_BAR + 16384;
constexpr size_t WS_LOGF = WS_MISC, WS_CNEG = WS_MISC + 1 * MiB, WS_TAB = WS_MISC + 2 * MiB, WS_GB = WS_MISC + 4 * MiB, WS_GF = WS_MISC + 16 * MiB, WS_VF = WS_MISC + 28 * MiB;
constexpr size_t WS_QKV = 817 * MiB, WS_OA = WS_QKV + 192 * MiB, WS_OB = WS_OA + 32 * MiB, WS_LSE = WS_OB + 96 * MiB, WS_MIX = WS_LSE + 2 * MiB, WS_END = WS_MIX + 64 * MiB;
static_assert((size_t)(SEQ / 64) * 2 * DFF * 4 <= 12 * MiB, "side buffers");
constexpr int LDS_BYTES = 147456;
static_assert(att::LDS_END <= 131072 + 8192, "attention LDS");
static_assert(8 * 16640 <= LDS_BYTES, "P0 transpose scratch");

#define LAS __attribute__((address_space(3)))
typedef unsigned short bf16;
typedef unsigned v4u __attribute__((ext_vector_type(4)));
typedef unsigned v2u __attribute__((ext_vector_type(2)));
typedef float f32x4 __attribute__((ext_vector_type(4)));
typedef short bf16x8 __attribute__((ext_vector_type(8)));
#define LDS_WAIT() asm volatile("s_waitcnt lgkmcnt(0)" ::: "memory")
__device__ __forceinline__ unsigned pk2(float lo, float hi) { unsigned r; asm volatile("v_cvt_pk_bf16_f32 %0, %1, %2" : "=v"(r) : "v"(lo), "v"(hi)); return r; }
__device__ __forceinline__ float bflo(unsigned u) { return __uint_as_float(u << 16); }
__device__ __forceinline__ float bfhi(unsigned u) { return __uint_as_float(u & 0xffff0000u); }
__device__ __forceinline__ float wave_sum(float v) {
#pragma unroll
    for (int o = 1; o < 64; o <<= 1) v += __shfl_xor(v, o);
    return v;
}
typedef float f32x2 __attribute__((ext_vector_type(2)));
__device__ __forceinline__ void tr_item(const float* W, size_t ldw, int Kdim, bf16* WT, LAS float* scr, int k0, int lane, const float* gk = nullptr) {
    const float* wp = W + (size_t)(k0 + (lane >> 5)) * ldw + 2 * (lane & 31); f32x2 v[32];
#pragma unroll
    for (int i = 0; i < 32; ++i) v[i] = *(const f32x2*)(wp + (size_t)(2 * i) * ldw);
#pragma unroll
    for (int i = 0; i < 32; ++i) { LAS float* d = scr + (2 * i + (lane >> 5)) * 65 + 2 * (lane & 31); d[0] = v[i].x; d[1] = v[i].y; }
    const int c = lane & 7;
    f32x4 g0 = {1.f, 1.f, 1.f, 1.f}, g1 = g0; if (gk) { g0 = *(const f32x4*)(gk + k0 + 8 * c); g1 = *(const f32x4*)(gk + k0 + 8 * c + 4); }
    LDS_WAIT(); asm volatile("" ::: "memory");
#pragma unroll
    for (int j = 0; j < 8; ++j) { const int n = (lane >> 3) + 8 * j; const LAS float* s = scr + (8 * c) * 65 + n;
        v4u o; o.x = pk2(s[0 * 65] * g0.x, s[1 * 65] * g0.y); o.y = pk2(s[2 * 65] * g0.z, s[3 * 65] * g0.w); o.z = pk2(s[4 * 65] * g1.x, s[5 * 65] * g1.y); o.w = pk2(s[6 * 65] * g1.z, s[7 * 65] * g1.w);
        *(v4u*)(WT + (size_t)n * Kdim + k0 + 8 * c) = o; }
    LDS_WAIT(); asm volatile("" ::: "memory");
}
__device__ __forceinline__ void rms_row_bf16(const float* xrow, const float* g, bf16* orow, int lane) {
    const f32x4* xr = (const f32x4*)xrow + lane; f32x4 v[16]; float s = 0.f;
#pragma unroll
    for (int j = 0; j < 16; ++j) { v[j] = xr[64 * j]; s += (v[j].x * v[j].x + v[j].y * v[j].y) + (v[j].z * v[j].z + v[j].w * v[j].w); }
    const float r = rsqrtf(wave_sum(s) * (1.f / DM) + RMS_EPS);
    const f32x4* gr = (const f32x4*)g + lane; v2u* o8 = (v2u*)orow + lane;
#pragma unroll
    for (int j = 0; j < 16; ++j) { const f32x4 gg = gr[64 * j]; v2u w; w.x = pk2(v[j].x * r * gg.x, v[j].y * r * gg.y); w.y = pk2(v[j].z * r * gg.z, v[j].w * r * gg.w); o8[64 * j] = w; }
}
__device__ __forceinline__ void rms_row_f32(const float* xrow, const float* g, float* orow, int lane) {
    const f32x4* xr = (const f32x4*)xrow + lane; f32x4 v[16]; float s = 0.f;
#pragma unroll
    for (int j = 0; j < 16; ++j) { v[j] = xr[64 * j]; s += (v[j].x * v[j].x + v[j].y * v[j].y) + (v[j].z * v[j].z + v[j].w * v[j].w); }
    const float r = rsqrtf(wave_sum(s) * (1.f / DM) + RMS_EPS);
    const f32x4* gr = (const f32x4*)g + lane; f32x4* o = (f32x4*)orow + lane;
#pragma unroll
    for (int j = 0; j < 16; ++j) { const f32x4 gg = gr[64 * j]; o[64 * j] = v[j] * r * gg; }
}
__device__ __forceinline__ int t5_bucket(int dist) {
    if (dist < 16) return dist;
    const float df = (float)dist;
    int large = 16 + (int)(logf(df / 16.0f) / 4.852030263919617f * 16.0f);
    return large < 31 ? large : 31;
}

__device__ __forceinline__ int lane_id_v() { int l; asm volatile("v_mbcnt_lo_u32_b32 %0, -1, 0\n\tv_mbcnt_hi_u32_b32 %0, -1, %0" : "=v"(l)); return l; }
#define XB_CEN(j)  (64 * (j))
#define XB_ARR(j)  (64 * (16 + (j)))
#define XB_REL(j)  (64 * (32 + (j)))
#define XB_TOP     (64 * 48)
#define XB_TOPGEN  (64 * 49)
#define XB_WORDS   (64 * 50)
__device__ __forceinline__ unsigned xb_ld(unsigned* p) { return __hip_atomic_load(p, __ATOMIC_RELAXED, __HIP_MEMORY_SCOPE_AGENT); }
__device__ __forceinline__ unsigned xb_add(unsigned* p, unsigned v) { return __hip_atomic_fetch_add(p, v, __ATOMIC_RELAXED, __HIP_MEMORY_SCOPE_AGENT); }
__device__ __forceinline__ void xb_st(unsigned* p, unsigned v) { __hip_atomic_store(p, v, __ATOMIC_RELAXED, __HIP_MEMORY_SCOPE_AGENT); }
__device__ __forceinline__ unsigned xcc_id() { return (unsigned)__builtin_amdgcn_s_getreg((3 << 11) | 20) & 0xFu; }
__device__ __forceinline__ void grid_barrier(unsigned* bar, unsigned r, unsigned x, unsigned nloc, unsigned nx, int tid) {
    asm volatile("s_waitcnt vmcnt(0) lgkmcnt(0)" ::: "memory");
    __syncthreads();
    if (tid == 0) {
        const unsigned old = xb_add(bar + XB_ARR(x), 1u);
        if (old + 1u == nloc * r) {
            __builtin_amdgcn_fence(__ATOMIC_RELEASE, "agent");
            asm volatile("s_waitcnt vmcnt(0)" ::: "memory");
            const unsigned o2 = xb_add(bar + XB_TOP, 1u);
            if (o2 + 1u == nx * r) xb_st(bar + XB_TOPGEN, r);
            else while (xb_ld(bar + XB_TOPGEN) < r) __builtin_amdgcn_s_sleep(1);
            xb_st(bar + XB_REL(x), r);
        } else { while (xb_ld(bar + XB_REL(x)) < r) __builtin_amdgcn_s_sleep(1); }
        __builtin_amdgcn_fence(__ATOMIC_ACQUIRE, "agent");
        asm volatile("s_waitcnt vmcnt(0)" ::: "memory");
    }
    __syncthreads();
}
struct Args { const float* in[14]; float* out; unsigned char* ws; int ph_lo, ph_hi; };
enum { I_X = 0, I_ANG, I_WIN, I_FB, I_RBT, I_FOG, I_DOG, I_WOUT, I_FNG, I_WUP, I_CW, I_CB, I_WDN, I_FING };
constexpr int N_PHASES = 11;
constexpr int DN_KB_SPLIT = 129;
#define PROBE_FOX 1
#define PROBE_DIL 1
#ifndef PROBE_PH
#define PROBE_PH -1
#endif

__global__ void __launch_bounds__(NWAVES * 64, 2) hymba_fwd(Args args) {
    extern __shared__ __attribute__((aligned(16))) unsigned char lds[];
    cg::grid_group grid = cg::this_grid();
    const int wave = __builtin_amdgcn_readfirstlane((int)threadIdx.x >> 6);
    const int G = gridDim.x; const int bx = blockIdx.x; const int vcu = (G % 8 == 0) ? (bx % 8) * (G / 8) + bx / 8 : bx;
    const int gw = vcu * NWAVES + wave, NGW = G * NWAVES;
    unsigned char* ws = args.ws;
    bf16* WinT = (bf16*)(ws + WS_WIN); bf16* WfT = (bf16*)(ws + WS_WF); bf16* WoutT = (bf16*)(ws + WS_WOUT); bf16* WupT = (bf16*)(ws + WS_WUP); bf16* WdnT = (bf16*)(ws + WS_WDN);
    bf16* XN = (bf16*)(ws + WS_XN); float* X1 = (float*)(ws + WS_X1); bf16* ACT = (bf16*)(ws + WS_ACT);
    int* JLO = (int*)(ws + WS_TAB + 65536); float* LOGF = (float*)(ws + WS_LOGF); float* CNEG = (float*)(ws + WS_CNEG); float* TAB = (float*)(ws + WS_TAB);
    float* GB = (float*)(ws + WS_GB); float* GF = (float*)(ws + WS_GF); float* VF = (float*)(ws + WS_VF);
    bf16* QKV = (bf16*)(ws + WS_QKV); bf16* OA = (bf16*)(ws + WS_OA); bf16* OB = (bf16*)(ws + WS_OB); float* LSE = (float*)(ws + WS_LSE); bf16* MIX = (bf16*)(ws + WS_MIX);
    const int lo = args.ph_lo, hi_ph = args.ph_hi;
#define IN(k) (lo <= (k) && (k) < hi_ph)
#define REP(k) ((PROBE_PH == (k)) ? 2 : 1)
    unsigned* gbar = (unsigned*)(ws + WS_CTL + CTL_BAR);
    const unsigned xid = xcc_id(); if (threadIdx.x == 0) (void)xb_add(gbar + XB_CEN(xid), 1u);
    unsigned xb_nloc = 1u, xb_nx = 1u; unsigned* NORM = (unsigned*)(ws + WS_CTL + CTL_NORM); float* SSQ = (float*)(ws + WS_CTL + CTL_SSQ); float* SSQ2 = (float*)(ws + WS_CTL + CTL_SSQ2);
    unsigned nbar = 0;
#define SEAM(k) do { if (IN(k) && IN((k) + 1)) { if ((k) == 0) { asm volatile("s_waitcnt vmcnt(0) lgkmcnt(0)" ::: "memory");     \
        grid.sync(); xb_nx = 0u; for (unsigned j_ = 0; j_ < 16u; ++j_) { const unsigned c_ = xb_ld(gbar + XB_CEN(j_)); xb_nx += c_ ? 1u : 0u; if (j_ == xid) xb_nloc = c_; } \
        xb_nloc = (unsigned)__builtin_amdgcn_readfirstlane((int)xb_nloc); xb_nx = (unsigned)__builtin_amdgcn_readfirstlane((int)xb_nx); \
        ++nbar; grid_barrier(gbar, nbar, xid, xb_nloc, xb_nx, (int)threadIdx.x); }   \
      else if ((k) != 2 && (k) != 5) { ++nbar; grid_barrier(gbar, nbar, xid, xb_nloc, xb_nx, wave * 64 + lane_id_v()); } } } while (0)

    if (IN(0)) for (int rep_ = 0; rep_ < REP(0); ++rep_) {
        const int tid = threadIdx.x, lane = tid & 63;
        LAS float* scr = (LAS float*)((LAS unsigned char*)lds + wave * 16640);
        constexpr int KB4 = DM / 64;
        constexpr int I_IN = KB4 * (NQKV / 64), I_OUT = KB4 * (DM / 64);
        constexpr int I_DNB = ((DFF / 64) - DN_KB_SPLIT) * (DM / 64); constexpr int NITEMS = I_IN + I_OUT + I_DNB;
        for (int it = gw; it < NITEMS; it += NGW) {
            int r = it;
            if (r < I_IN) { const int nblk = NQKV / 64, kb = r / nblk, nb = r % nblk; const int n0 = nb * 64; const int src = n0 < 6144 ? n0 : n0 + 16;
                tr_item(args.in[I_WIN] + src, INW, DM, WinT + (size_t)n0 * DM, scr, kb * 64, lane); continue; } r -= I_IN;
            if (r < I_OUT) { const int nblk = DM / 64, kb = r / nblk, nb = r % nblk;
                tr_item(args.in[I_WOUT] + nb * 64, DM, DM, WoutT + (size_t)(nb * 64) * DM, scr, kb * 64, lane); continue; } r -= I_OUT;
            { const int nblk = DM / 64, kb = DN_KB_SPLIT + r / nblk, nb = r % nblk;
                tr_item(args.in[I_WDN] + nb * 64, DM, DFF, WdnT + (size_t)(nb * 64) * DFF, scr, kb * 64, lane); }
        }
        for (int m = gw; m < SEQ; m += NGW) rms_row_bf16(args.in[I_X] + (size_t)m * DM, args.in[I_ANG], XN + (size_t)m * DM, lane);
        for (int item = gw; item < 16 * (DM / 64); item += NGW) { const int j = item & 15, k = (item >> 4) * 64 + lane;
            const float v = args.in[I_WIN][(size_t)k * INW + 6144 + j]; WfT[(size_t)j * DM + k] = (bf16)(pk2(v, v) & 0xffffu); }
        for (int idx = bx * (NWAVES * 64) + tid; idx < 48 * 132; idx += G * NWAVES * 64) { const int t = idx / 132, i = idx % 132, br = t / 16, h = t % 16;
            float v = 0.f; if (i <= 128) { const int dil = br == 0 ? 1 : (br == 1 ? 4 : 16); v = args.in[I_RBT][t5_bucket((128 - i) * dil) * 16 + h] * INV_SCALE; }
            TAB[idx] = v; }
    }
    SEAM(0);
    if (IN(1)) for (int rep_ = 0; rep_ < REP(1); ++rep_) {
        pg8::Gemm g{XN, WinT, SEQ, NQKV, DM}; pg8::StaticOrder S; S.init(SEQ, NQKV, G, bx);
        pg8::EpiQKV E{QKV, SEQ, NORM};
        const int lane = lane_id_v(), tid = wave * 64 + lane;
        pg8::gemm_phase<pg8::EpiQKV, pg8::StaticOrder, true, true>((LAS unsigned char*)lds, g, S, E, tid);
        for (int task = bx; task < SEQ / 32; task += G) {
            const int t0 = task * 32, row = lane & 15, quad = lane >> 4;
            const bf16* ap = XN + (size_t)(t0 + row) * DM + wave * 512 + quad * 8; const bf16* bp = WfT + (size_t)row * DM + wave * 512 + quad * 8;
            f32x4 acc0 = {0.f, 0.f, 0.f, 0.f}, acc1 = acc0;
#pragma unroll
            for (int k0 = 0; k0 < 512; k0 += 32) { const bf16x8 a0 = *(const bf16x8*)(ap + k0), a1 = *(const bf16x8*)(ap + (size_t)16 * DM + k0), b = *(const bf16x8*)(bp + k0);
                acc0 = __builtin_amdgcn_mfma_f32_16x16x32_bf16(a0, b, acc0, 0, 0, 0); acc1 = __builtin_amdgcn_mfma_f32_16x16x32_bf16(a1, b, acc1, 0, 0, 0); }
            LAS f32x4* red = (LAS f32x4*)lds;
            red[wave * 128 + lane] = acc0; red[wave * 128 + 64 + lane] = acc1;
            __syncthreads();
            if (wave == 0) {
#pragma unroll
                for (int w = 1; w < 8; ++w) { acc0 += red[w * 128 + lane]; acc1 += red[w * 128 + 64 + lane]; }
                const int h = lane & 15; const float fb = args.in[I_FB][h];
#pragma unroll
                for (int j = 0; j < 4; ++j) { const float x0 = acc0[j] + fb, x1 = acc1[j] + fb;
                    LOGF[(size_t)h * SEQ + t0 + quad * 4 + j] = fminf(x0, 0.f) - log1pf(expf(-fabsf(x0)));
                    LOGF[(size_t)h * SEQ + t0 + 16 + quad * 4 + j] = fminf(x1, 0.f) - log1pf(expf(-fabsf(x1))); }
            }
            __syncthreads();
        }
    }
    SEAM(1);
    SEAM(2);
    if (IN(3)) for (int rep_ = 0; rep_ < REP(3); ++rep_) {
        char* al = (char*)lds; const int tid = wave * 64 + lane_id_v();
        for (int i = tid; i < 48 * 132; i += NWAVES * 64) ((float*)(al + att::LDS_DTAB))[i] = TAB[i];
        __syncthreads();
        att::Seam S;
        if (vcu < 256) {
            const int L_ = vcu; const int h_ = L_ >> 4, pr_ = L_ & 15, lane_ = tid & 63;
            float* cbl = (float*)(al + att::LDS_BIAS); float* wsum = (float*)(al + 2 * att::SHM_V + 2 * att::SHM_K);
            { const f32x4* lf = (const f32x4*)(LOGF + (size_t)h_ * SEQ + tid * 16); f32x4 v[4]; float p[16]; float run = 0.f;
#pragma unroll
              for (int i = 0; i < 4; ++i) v[i] = lf[i];
#pragma unroll
              for (int i = 0; i < 4; ++i) { run += v[i].x; p[4 * i] = run; run += v[i].y; p[4 * i + 1] = run; run += v[i].z; p[4 * i + 2] = run; run += v[i].w; p[4 * i + 3] = run; }
              float inc = run;
#pragma unroll
              for (int o = 1; o < 64; o <<= 1) { const float t_ = __shfl_up(inc, o); if (lane_ >= o) inc += t_; }
              if (lane_ == 63) wsum[wave] = inc;
              __syncthreads();
              float off = inc - run;
              for (int w = 0; w < wave; ++w) off += wsum[w];
#pragma unroll
              for (int i = 0; i < 4; ++i) { f32x4 o; o.x = -(off + p[4 * i]) * INV_SCALE; o.y = -(off + p[4 * i + 1]) * INV_SCALE; o.z = -(off + p[4 * i + 2]) * INV_SCALE; o.w = -(off + p[4 * i + 3]) * INV_SCALE; ((f32x4*)cbl)[tid * 4 + i] = o; }
              __syncthreads(); }
            float qn2 = 0.f, kn2 = 0.f;
#pragma unroll
            for (int w = 0; w < 4; ++w) { qn2 += __uint_as_float(NORM[h_ * 4 + w]); kn2 += __uint_as_float(NORM[(16 + h_) * 4 + w]); }
            const float thr = (34.f + 2.02f * sqrtf(qn2 * kn2) * att::SCALE) * INV_SCALE;
#define FOX_REF(R, pass) do { const int qb_ = (pass) ? 31 - pr_ : pr_; \
            R.Q = QKV + ((size_t)(0 * 16 + h_) * SEQ + (size_t)qb_ * 256) * 128; R.K = QKV + (size_t)(1 * 16 + h_) * SEQ * 128; R.V = QKV + (size_t)(2 * 16 + h_) * SEQ * 128; \
            R.O = OA + (size_t)qb_ * 256 * FW + h_ * 128; R.lse = nullptr; R.gb = nullptr; R.P0 = qb_ * 256; R.rs = 128; R.os = FW; R.ls = 0; R.tab = 0; \
            { const float lim_ = cbl[R.P0] - thr; const int nt_ = R.P0 >> 6; int cnt_ = 0; \
              for (int b_ = 0; b_ < nt_; b_ += 64) { const int j_ = b_ + lane_; const bool sk_ = (j_ < nt_) && (cbl[64 * (j_ < nt_ ? j_ : 0) + 63] <= lim_); cnt_ += __popcll(__ballot(sk_)); } R.jlo = cnt_; } } while (0)
            att::BlockRef cur, nxt; FOX_REF(cur, 0); att::attn_prime(cur, al, S, tid);
            FOX_REF(nxt, 1); att::attn_block<0>(cur, nxt, al, S, tid); cur = nxt;
            att::attn_block<0>(cur, cur, al, S, tid);
#undef FOX_REF
        }
        { const int per = (1536 + G - 1) / G; const int L0 = vcu * per; const int L1 = (L0 + per < 1536) ? L0 + per : 1536;
#define DIL_REF(R, L) do { const int h_ = (L) / 96, rem_ = (L) % 96, br_ = rem_ >> 5, idx_ = rem_ & 31; const int dil_ = br_ == 0 ? 1 : (br_ == 1 ? 4 : 16); const int nq_ = 32 / dil_; \
            const int cls_ = idx_ / nq_, qb_ = idx_ % nq_; const size_t tok0_ = (size_t)cls_ + (size_t)qb_ * 256 * dil_; \
            R.Q = QKV + ((size_t)(3 * 16 + h_) * SEQ + tok0_) * 128; R.K = QKV + ((size_t)(4 * 16 + h_) * SEQ + cls_) * 128; R.V = QKV + ((size_t)(5 * 16 + h_) * SEQ + cls_) * 128; \
            R.O = OB + ((size_t)br_ * SEQ + tok0_) * FW + h_ * 128; R.lse = LSE + (size_t)(br_ * 16 + h_) * SEQ + (size_t)cls_ * (SEQ / dil_) + (size_t)qb_ * 256; R.gb = nullptr; R.P0 = qb_ * 256; R.rs = 128 * dil_; R.os = FW * dil_; R.ls = 1;     \
            { const int lowk_ = qb_ * 256 - 128; R.jlo = lowk_ > 0 ? lowk_ / 64 : 0; } R.tab = att::LDS_DTAB + (br_ * 16 + h_) * att::DTAB_STRIDE; } while (0)
          if (L0 < L1) { att::BlockRef cur, nxt; DIL_REF(cur, L0); att::attn_prime(cur, al, S, tid);
            const int nd = (L1 - L0) * PROBE_DIL;
            for (int i = 0; i < nd; ++i) { if (i + 1 < nd) DIL_REF(nxt, L0 + (i + 1) % (L1 - L0)); else nxt = cur; att::attn_block<1>(cur, nxt, al, S, tid); cur = nxt; } }
#undef DIL_REF
        }
    }
    SEAM(3);
    if (IN(4)) for (int rep_ = 0; rep_ < REP(4); ++rep_) {
        const float* ga = args.in[I_FOG]; const float* gd = args.in[I_DOG]; const int lane = lane_id_v();
        for (int t = gw; t < SEQ; t += NGW) {
            { const v4u* oa = (const v4u*)(OA + (size_t)t * FW) + lane; v4u raw[4]; float ss = 0.f;
#pragma unroll
              for (int j = 0; j < 4; ++j) { raw[j] = oa[64 * j];
#pragma unroll
                  for (int e = 0; e < 4; ++e) { const float a = bflo(raw[j][e]), b = bfhi(raw[j][e]); ss += a * a + b * b; } }
              const float r = rsqrtf(wave_sum(ss) * (1.f / FW) + RMS_EPS);
#pragma unroll
              for (int j = 0; j < 4; ++j) { const int col = 8 * (lane + 64 * j); const f32x4 g0 = *(const f32x4*)(ga + col), g1 = *(const f32x4*)(ga + col + 4); v4u w;
                  w.x = pk2(bflo(raw[j].x) * r * g0.x, bfhi(raw[j].x) * r * g0.y); w.y = pk2(bflo(raw[j].y) * r * g0.z, bfhi(raw[j].y) * r * g0.w);
                  w.z = pk2(bflo(raw[j].z) * r * g1.x, bfhi(raw[j].z) * r * g1.y); w.w = pk2(bflo(raw[j].w) * r * g1.z, bfhi(raw[j].w) * r * g1.w);
                  *(v4u*)(MIX + (size_t)t * DM + col) = w; } }
            { float v[4][8]; float ss = 0.f;
#pragma unroll
              for (int j = 0; j < 4; ++j) { const int col = 8 * (lane + 64 * j), h = col >> 7;
                  const float l0 = LSE[(size_t)(0 * 16 + h) * SEQ + t], l1 = LSE[(size_t)(1 * 16 + h) * SEQ + (size_t)(t & 3) * (SEQ / 4) + (t >> 2)], l2 = LSE[(size_t)(2 * 16 + h) * SEQ + (size_t)(t & 15) * (SEQ / 16) + (t >> 4)];
                  const float mx = fmaxf(l0, fmaxf(l1, l2)); float w0 = __builtin_amdgcn_exp2f(l0 - mx), w1 = __builtin_amdgcn_exp2f(l1 - mx), w2 = __builtin_amdgcn_exp2f(l2 - mx);
                  const float inv = 1.f / (w0 + w1 + w2); w0 *= inv; w1 *= inv; w2 *= inv;
                  const v4u a = *(const v4u*)(OB + ((size_t)0 * SEQ + t) * FW + col), b = *(const v4u*)(OB + ((size_t)1 * SEQ + t) * FW + col), c = *(const v4u*)(OB + ((size_t)2 * SEQ + t) * FW + col);
#pragma unroll
                  for (int e = 0; e < 4; ++e) { v[j][2 * e] = w0 * bflo(a[e]) + w1 * bflo(b[e]) + w2 * bflo(c[e]); v[j][2 * e + 1] = w0 * bfhi(a[e]) + w1 * bfhi(b[e]) + w2 * bfhi(c[e]);
                      ss += v[j][2 * e] * v[j][2 * e] + v[j][2 * e + 1] * v[j][2 * e + 1]; } }
              const float r = rsqrtf(wave_sum(ss) * (1.f / FW) + RMS_EPS);
#pragma unroll
              for (int j = 0; j < 4; ++j) { const int col = 8 * (lane + 64 * j); const f32x4 g0 = *(const f32x4*)(gd + col), g1 = *(const f32x4*)(gd + col + 4); v4u w;
                  w.x = pk2(v[j][0] * r * g0.x, v[j][1] * r * g0.y); w.y = pk2(v[j][2] * r * g0.z, v[j][3] * r * g0.w); w.z = pk2(v[j][4] * r * g1.x, v[j][5] * r * g1.y); w.w = pk2(v[j][6] * r * g1.z, v[j][7] * r * g1.w);
                  *(v4u*)(MIX + (size_t)t * DM + FW + col) = w; } }
        }
    }
    SEAM(4);
    if (IN(5)) for (int rep_ = 0; rep_ < REP(5); ++rep_) {
        pg8::Gemm g{MIX, WoutT, SEQ, DM, DM}; pg8::StaticOrder S; S.init(SEQ, DM, G, bx);
        pg8::EpiX1 E{args.in[I_X], XN, SSQ, DM};
        pg8::gemm_phase<pg8::EpiX1, pg8::StaticOrder, true, true>((LAS unsigned char*)lds, g, S, E, wave * 64 + lane_id_v());
    }
    SEAM(5);
    if (IN(6)) for (int rep_ = 0; rep_ < REP(6); ++rep_) {
        const int lane = lane_id_v(); LAS float* scr = (LAS float*)((LAS unsigned char*)lds + wave * 16640);
        constexpr int I_UP = (DM / 64) * (NUP / 64);
        for (int r = gw; r < I_UP; r += NGW) { const int nblk = NUP / 64, kb = r / nblk, nb = r % nblk; const int n0 = nb * 64;
            const int f = n0 < DFF ? n0 : n0 - DFF; const int drow = 256 * (f >> 7) + (f & 127) + (n0 < DFF ? 0 : 128);
            tr_item(args.in[I_WUP] + n0, NUP, DM, WupT + (size_t)drow * DM, scr, kb * 64, lane, args.in[I_FNG]); }
    }
    SEAM(6);
    if (IN(7)) for (int rep_ = 0; rep_ < REP(7); ++rep_) {
        pg8::Gemm g{XN, WupT, SEQ, NUP, DM}; pg8::StaticOrder S; S.init(SEQ, NUP, G, bx);
        pg8::EpiGate E{ACT, DFF, args.in[I_CW], args.in[I_CB], GB, GF, VF, SSQ};
        pg8::gemm_phase<pg8::EpiGate, pg8::StaticOrder, true, true>((LAS unsigned char*)lds, g, S, E, wave * 64 + lane_id_v());
        { const int nwg = (SEQ / 256) * (NUP / 256), rem = nwg % G, first = rem ? rem : 0, nconv = rem ? G - rem : G;
          if (bx >= first) { const int lane = lane_id_v(); LAS float* scr = (LAS float*)((LAS unsigned char*)lds + wave * 16640);
            constexpr int I_DN = DN_KB_SPLIT * (DM / 64);
            for (int r = (bx - first) * NWAVES + wave; r < I_DN; r += nconv * NWAVES) { const int nblk = DM / 64, kb = r / nblk, nb = r % nblk;
                tr_item(args.in[I_WDN] + nb * 64, DM, DFF, WdnT + (size_t)(nb * 64) * DFF, scr, kb * 64, lane); } } }
    }
    SEAM(7);
    if (IN(8)) for (int rep_ = 0; rep_ < REP(8); ++rep_) {
        const float* cw = args.in[I_CW]; const float* cb = args.in[I_CB];
        const int total = (SEQ / 64) * 2 * (DFF / 4); const int tid = wave * 64 + lane_id_v();
        for (int idx = bx * (NWAVES * 64) + tid; idx < total; idx += G * NWAVES * 64) {
            const int c4 = idx % (DFF / 4), rk = idx / (DFF / 4), g64 = rk >> 1, k = rk & 1, c = c4 * 4;
            const f32x4 cur = *(const f32x4*)(GF + ((size_t)g64 * 2 + k) * DFF + c), val = *(const f32x4*)(VF + ((size_t)g64 * 2 + k) * DFF + c);
            f32x4 p1 = {0.f, 0.f, 0.f, 0.f}, p2 = {0.f, 0.f, 0.f, 0.f};
            if (k == 1) { p1 = *(const f32x4*)(GF + ((size_t)g64 * 2) * DFF + c); if (g64 > 0) p2 = *(const f32x4*)(GB + ((size_t)(g64 - 1) * 2 + 1) * DFF + c); }
            else if (g64 > 0) { p1 = *(const f32x4*)(GB + ((size_t)(g64 - 1) * 2 + 1) * DFF + c); p2 = *(const f32x4*)(GB + ((size_t)(g64 - 1) * 2) * DFF + c); }
            const f32x4 w0 = *(const f32x4*)(cw + c), w1 = *(const f32x4*)(cw + DFF + c), w2 = *(const f32x4*)(cw + 2 * DFF + c), b = *(const f32x4*)(cb + c);
            float a[4];
#pragma unroll
            for (int j = 0; j < 4; ++j) { const float gg = w2[j] * cur[j] + w1[j] * p1[j] + w0[j] * p2[j] + b[j]; a[j] = pg8::silu_f(gg) * val[j]; }
            v2u w; w.x = pk2(a[0], a[1]); w.y = pk2(a[2], a[3]);
            *(v2u*)(ACT + (size_t)(g64 * 64 + k) * DFF + c) = w;
        }
    }
    SEAM(8);
    if (IN(9)) for (int rep_ = 0; rep_ < REP(9); ++rep_) {
        pg8::Gemm g{ACT, WdnT, SEQ, DM, DFF}; pg8::StaticOrder S; S.init(SEQ, DM, G, bx);
        pg8::EpiX2 E{XN, SSQ2, DM};
        pg8::gemm_phase<pg8::EpiX2, pg8::StaticOrder, true, true>((LAS unsigned char*)lds, g, S, E, wave * 64 + lane_id_v());
    }
    SEAM(9);
    if (IN(10)) for (int rep_ = 0; rep_ < REP(10); ++rep_) { const int lane = lane_id_v(); const float* gf = args.in[I_FING];
        for (int m = gw; m < SEQ; m += NGW) { const float r = rsqrtf(SSQ2[m] * (1.f / DM) + RMS_EPS); const v4u* xr = (const v4u*)(XN + (size_t)m * DM) + lane; float* orow = args.out + (size_t)m * DM;
            v4u raw[8];
#pragma unroll
            for (int j = 0; j < 8; ++j) raw[j] = xr[64 * j];
#pragma unroll
            for (int j = 0; j < 8; ++j) { const int col = 8 * (lane + 64 * j); const f32x4 g0 = *(const f32x4*)(gf + col), g1 = *(const f32x4*)(gf + col + 4);
                f32x4 o0, o1; o0.x = bflo(raw[j].x) * r * g0.x; o0.y = bfhi(raw[j].x) * r * g0.y; o0.z = bflo(raw[j].y) * r * g0.z; o0.w = bfhi(raw[j].y) * r * g0.w;
                o1.x = bflo(raw[j].z) * r * g1.x; o1.y = bfhi(raw[j].z) * r * g1.y; o1.z = bflo(raw[j].w) * r * g1.z; o1.w = bfhi(raw[j].w) * r * g1.w;
                *(f32x4*)(orow + col) = o0; *(f32x4*)(orow + col + 4) = o1; } }
    }
#undef IN
#undef SEAM
}

#ifndef MK_N_LAUNCHES
#define MK_N_LAUNCHES 1
#endif
extern "C" void kernel_launch(void* const* d_in, const int* in_sizes, int n_in, void* d_out, int out_size, void* d_ws, size_t ws_size, hipStream_t stream) {
    static int grid = 0;
    if (grid == 0) {
        if (n_in != 14 || in_sizes[0] != SEQ * DM || out_size != SEQ * DM || ws_size < WS_END) { fprintf(stderr, "kernel_launch: unexpected shapes (n_in %d, ws %zu < %zu)\n", n_in, ws_size, (size_t)WS_END); grid = -1; return; }
        int dev = 0, cus = 0, per_cu = 0;
        (void)hipGetDevice(&dev); (void)hipDeviceGetAttribute(&cus, hipDeviceAttributeMultiprocessorCount, dev);
        if (hipFuncSetAttribute((const void*)hymba_fwd, hipFuncAttributeMaxDynamicSharedMemorySize, LDS_BYTES) != hipSuccess) { fprintf(stderr, "kernel_launch: hipFuncSetAttribute failed\n"); grid = -1; return; }
        if (hipOccupancyMaxActiveBlocksPerMultiprocessor(&per_cu, (const void*)hymba_fwd, NWAVES * 64, LDS_BYTES) != hipSuccess || per_cu < 1) { fprintf(stderr, "kernel_launch: occupancy query says %d\n", per_cu); per_cu = 1; }
        (void)hipGetLastError();
        grid = cus * 1;
        if (grid <= 0) grid = 256;
        if (grid < 256) { fprintf(stderr, "kernel_launch: needs >= 256 workgroups (one FoX item each), device has %d CUs\n", grid); grid = -1; return; }
    }
    if (grid < 0) return;
    if (hipMemsetAsync((char*)d_ws + WS_CTL, 0, CTL_BYTES, stream) != hipSuccess) { fprintf(stderr, "kernel_launch: memset failed\n"); return; }
    Args a{};
    for (int i = 0; i < 14; ++i) a.in[i] = (const float*)d_in[i];
    a.out = (float*)d_out; a.ws = (unsigned char*)d_ws;
#if MK_N_LAUNCHES == 1
    a.ph_lo = 0; a.ph_hi = N_PHASES;
    { void* kargs[] = {&a}; hipError_t e = hipLaunchCooperativeKernel((const void*)hymba_fwd, dim3(grid), dim3(NWAVES * 64), kargs, LDS_BYTES, stream);
      if (e != hipSuccess) fprintf(stderr, "kernel_launch: cooperative launch failed: %s (grid %d)\n", hipGetErrorString(e), grid); }
#else
    for (int p = 0; p < N_PHASES; ++p) { a.ph_lo = p; a.ph_hi = p + 1; void* kargs[] = {&a};
        hipError_t e = hipLaunchCooperativeKernel((const void*)hymba_fwd, dim3(grid), dim3(NWAVES * 64), kargs, LDS_BYTES, stream);
        if (e != hipSuccess) { fprintf(stderr, "kernel_launch: launch %d failed: %s\n", p, hipGetErrorString(e)); break; } }
#endif
}
```

```cpp
#include <hip/hip_runtime.h>
#include <hip/hip_bf16.h>
#include <hip/hip_cooperative_groups.h>
#include <cstdio>
#include <cstdint>
namespace cg = cooperative_groups;
namespace pg8 {
#define PG8_LAS __attribute__((address_space(3)))
typedef unsigned short bf16_t;
typedef short bf16x8 __attribute__((ext_vector_type(8)));
typedef float f32x4 __attribute__((ext_vector_type(4)));
typedef unsigned u32x4 __attribute__((ext_vector_type(4)));
constexpr int BM = 256, BK = 64, HALF = 128, HTB = HALF * BK * 2  , STAGE_BYTES = 8 * HTB, NXCD = 8, WGM = 8;

__host__ __device__ __forceinline__ int lds_byte(int r, int c) { const int st = (r >> 4) * 2 + (c >> 5), rr = r & 15, cc = c & 31, ob = rr * 64 + cc * 2; return st * 1024 + (ob ^ (((ob >> 9) & 1) << 5)); }
__host__ __device__ __forceinline__ void stage_rc(int b, int& R, int& C) { const int st = b / 1024, sb = b % 1024, swz = sb ^ (((sb >> 9) & 1) << 5); R = (st >> 1) * 16 + swz / 64; C = (st & 1) * 32 + (swz % 64) / 2; }
__host__ __device__ __forceinline__ int perm32(int rho) { const int n = rho >> 4, i = rho & 15; return 8 * (i >> 2) + 4 * n + (i & 3); }

struct Unit { int pm, pn; };
struct Gemm { const bf16_t* A; const bf16_t* Bt; int M, N, K; };

struct StaticOrder {
    int nM, nN, nwg, G, c, wgm;
    __host__ __device__ void init(int M, int N, int G_, int c_, int wgm_ = WGM) { nM = M / BM; nN = N / BM; nwg = nM * nN; G = G_; c = c_; wgm = wgm_; }
    __host__ __device__ bool next(int i, Unit& u) const {
        const long L = (long)i * G + c; if (L >= nwg) return false;
        int wgid = (int)L; { const int q = nwg / NXCD, r = nwg % NXCD, xcd = wgid % NXCD, off = wgid / NXCD; wgid = (xcd < r ? xcd * (q + 1) : r * (q + 1) + (xcd - r) * q) + off; }
        const int nig = wgm * nN, gid = wgid / nig, fm = gid * wgm, gsz = (nM - fm) < wgm ? (nM - fm) : wgm;
        u.pm = fm + ((wgid % nig) % gsz); u.pn = (wgid % nig) / gsz; return true;
    }
    __device__ __forceinline__ void a_ready(const Unit&) const {}
    __device__ __forceinline__ void done(const Unit&) const {}
};

__device__ __forceinline__ unsigned cvt_pk_bf16(float lo, float hi) { unsigned r; asm volatile("v_cvt_pk_bf16_f32 %0, %1, %2" : "=v"(r) : "v"(lo), "v"(hi)); return r; }
typedef float f32x2 __attribute__((ext_vector_type(2)));
typedef unsigned u32x2 __attribute__((ext_vector_type(2)));
struct EpiQKV {
    static constexpr bool PERM = true, AFTER_DRAIN = false;
    bf16_t* O; int S; unsigned* norm4;
    __device__ __forceinline__ void operator()(const f32x4 (&acc)[2][2][4][2], const Unit& u, int wr, int wc, int fr, int fq) const {
        const int row0 = u.pm * BM + wr * 64 + fr, d0 = wc * 32 + 8 * fq;
#pragma unroll
        for (int bj = 0; bj < 2; ++bj) { bf16_t* hb = O + (size_t)(2 * u.pn + bj) * S * 128 + d0;
#pragma unroll
            for (int ai = 0; ai < 2; ++ai)
#pragma unroll
                for (int m = 0; m < 4; ++m) { const f32x4 v0 = acc[ai][bj][m][0], v1 = acc[ai][bj][m][1];
                    u32x4 w; w.x = cvt_pk_bf16(v0[0], v0[1]); w.y = cvt_pk_bf16(v0[2], v0[3]); w.z = cvt_pk_bf16(v1[0], v1[1]); w.w = cvt_pk_bf16(v1[2], v1[3]);
                    *(u32x4*)(hb + (size_t)(row0 + ai * HALF + m * 16) * 128) = w; } }
        if (u.pn < 16) {
#pragma unroll
            for (int bj = 0; bj < 2; ++bj) { float mx = 0.f;
#pragma unroll
                for (int ai = 0; ai < 2; ++ai)
#pragma unroll
                    for (int m = 0; m < 4; ++m) { const f32x4 v0 = acc[ai][bj][m][0], v1 = acc[ai][bj][m][1];
                        float ss = (v0[0] * v0[0] + v0[1] * v0[1]) + (v0[2] * v0[2] + v0[3] * v0[3]) + (v1[0] * v1[0] + v1[1] * v1[1]) + (v1[2] * v1[2] + v1[3] * v1[3]);
                        ss += __shfl_xor(ss, 16); ss += __shfl_xor(ss, 32); mx = fmaxf(mx, ss); }
                mx = fmaxf(mx, __shfl_xor(mx, 1)); mx = fmaxf(mx, __shfl_xor(mx, 2)); mx = fmaxf(mx, __shfl_xor(mx, 4)); mx = fmaxf(mx, __shfl_xor(mx, 8));
                if (fr == 0 && fq == 0) atomicMax(norm4 + (2 * u.pn + bj) * 4 + wc, __float_as_uint(mx)); }
        }
    }
};
struct EpiRes {
    static constexpr bool PERM = false, AFTER_DRAIN = false;
    const float* base; float* out; int ldc;
    __device__ __forceinline__ void operator()(const f32x4 (&acc)[2][2][4][2], const Unit& u, int wr, int wc, int fr, int fq) const {
        const int col0 = u.pn * BM + wc * 32 + 4 * fq;
#pragma unroll
        for (int ai = 0; ai < 2; ++ai)
#pragma unroll
            for (int m = 0; m < 4; ++m) { const size_t off = (size_t)(u.pm * BM + ai * HALF + wr * 64 + m * 16 + fr) * ldc + col0;
#pragma unroll
                for (int bj = 0; bj < 2; ++bj)
#pragma unroll
                    for (int n = 0; n < 2; ++n) { const f32x4 bs = *(const f32x4*)(base + off + bj * HALF + n * 16); *(f32x4*)(out + off + bj * HALF + n * 16) = bs + acc[ai][bj][m][n]; }
                if (m & 1) asm volatile("" ::: "memory"); }
    }
};
struct EpiX1 {
    static constexpr bool PERM = false, AFTER_DRAIN = false;
    const float* base; bf16_t* xb; float* ssq; int ldc;
    __device__ __forceinline__ void operator()(const f32x4 (&acc)[2][2][4][2], const Unit& u, int wr, int wc, int fr, int fq) const {
        const int col0 = u.pn * BM + wc * 32 + 4 * fq;
#pragma unroll
        for (int ai = 0; ai < 2; ++ai) {
#pragma unroll
            for (int m = 0; m < 4; ++m) { const int row = u.pm * BM + ai * HALF + wr * 64 + m * 16 + fr; const size_t off = (size_t)row * ldc + col0; float s = 0.f;
#pragma unroll
                for (int bj = 0; bj < 2; ++bj)
#pragma unroll
                    for (int n = 0; n < 2; ++n) { const f32x4 v = *(const f32x4*)(base + off + bj * HALF + n * 16) + acc[ai][bj][m][n];
                        u32x2 w; w.x = cvt_pk_bf16(v[0], v[1]); w.y = cvt_pk_bf16(v[2], v[3]); *(u32x2*)(xb + off + bj * HALF + n * 16) = w; s += (v[0] * v[0] + v[1] * v[1]) + (v[2] * v[2] + v[3] * v[3]); }
                s += __shfl_xor(s, 16); s += __shfl_xor(s, 32);
                if (fq == 0) atomicAdd(ssq + row, s); }
            asm volatile("" ::: "memory"); }
    }
};
struct EpiX2 {
    static constexpr bool PERM = false, AFTER_DRAIN = false;
    bf16_t* xb; float* ssq; int ldc;
    __device__ __forceinline__ void operator()(const f32x4 (&acc)[2][2][4][2], const Unit& u, int wr, int wc, int fr, int fq) const {
        const int col0 = u.pn * BM + wc * 32 + 4 * fq;
#pragma unroll
        for (int ai = 0; ai < 2; ++ai) {
#pragma unroll
            for (int m = 0; m < 4; ++m) { const int row = u.pm * BM + ai * HALF + wr * 64 + m * 16 + fr; const size_t off = (size_t)row * ldc + col0; float s = 0.f;
#pragma unroll
                for (int bj = 0; bj < 2; ++bj)
#pragma unroll
                    for (int n = 0; n < 2; ++n) { bf16_t* p = xb + off + bj * HALF + n * 16; const u32x2 r = *(const u32x2*)p; f32x4 v;
                        v[0] = __uint_as_float(r.x << 16); v[1] = __uint_as_float(r.x & 0xffff0000u); v[2] = __uint_as_float(r.y << 16); v[3] = __uint_as_float(r.y & 0xffff0000u); v += acc[ai][bj][m][n];
                        u32x2 w; w.x = cvt_pk_bf16(v[0], v[1]); w.y = cvt_pk_bf16(v[2], v[3]); *(u32x2*)p = w; s += (v[0] * v[0] + v[1] * v[1]) + (v[2] * v[2] + v[3] * v[3]); }
                s += __shfl_xor(s, 16); s += __shfl_xor(s, 32);
                if (fq == 0) atomicAdd(ssq + row, s); }
            asm volatile("" ::: "memory"); }
    }
};
__device__ __forceinline__ float dpp_shr1(float cur, float prev) {
    const int o = __builtin_amdgcn_update_dpp(0, __builtin_bit_cast(int, prev), 0x121, 0xf, 0xf, false);
    return __builtin_bit_cast(float, __builtin_amdgcn_update_dpp(o, __builtin_bit_cast(int, cur), 0x111, 0xf, 0xf, false));
}
__device__ __forceinline__ float dpp_shr2(float cur, float prev) {
    const int o = __builtin_amdgcn_update_dpp(0, __builtin_bit_cast(int, prev), 0x122, 0xf, 0xf, false);
    return __builtin_bit_cast(float, __builtin_amdgcn_update_dpp(o, __builtin_bit_cast(int, cur), 0x112, 0xf, 0xf, false));
}
__device__ __forceinline__ float silu_f(float g) { return g * __builtin_amdgcn_rcpf(1.0f + __builtin_amdgcn_exp2f(-1.4426950408889634f * g)); }
struct EpiGate {
    static constexpr bool PERM = true, AFTER_DRAIN = false;
    bf16_t* ACT; int ldc;
    const float* cw; const float* cb;
    float* GB; float* GF; float* VF;
    const float* ssq;
    const PG8_LAS float* rsL; const PG8_LAS float* cwL; int pm0, pn0, nslot;
    __device__ __forceinline__ void operator()(const f32x4 (&acc)[2][2][4][2], const Unit& u, int wr, int wc, int fr, int fq) const {
        const int c0 = u.pn * HALF + wc * 32 + 8 * fq;
        const int dpn = u.pn - pn0; const bool fast = (u.pm == pm0) && dpn >= 0 && (dpn & 3) == 0 && (dpn >> 2) < nslot;
        f32x4 w0[2], w1[2], w2[2], bb[2];
        if (fast) { const PG8_LAS float* cp = cwL + (dpn >> 2) * 512 + wc * 32 + 8 * fq;
#pragma unroll
            for (int n = 0; n < 2; ++n) { w0[n] = *(const PG8_LAS f32x4*)(cp + 4 * n); w1[n] = *(const PG8_LAS f32x4*)(cp + 128 + 4 * n); w2[n] = *(const PG8_LAS f32x4*)(cp + 256 + 4 * n); bb[n] = *(const PG8_LAS f32x4*)(cp + 384 + 4 * n); }
        } else {
#pragma unroll
            for (int n = 0; n < 2; ++n) { w0[n] = *(const f32x4*)(cw + c0 + 4 * n); w1[n] = *(const f32x4*)(cw + ldc + c0 + 4 * n); w2[n] = *(const f32x4*)(cw + 2 * ldc + c0 + 4 * n); bb[n] = *(const f32x4*)(cb + c0 + 4 * n); }
        }
#pragma unroll
        for (int ai = 0; ai < 2; ++ai) {
            const int g64 = u.pm * 4 + ai * 2 + wr;
            float rs[4];
            if (fast) {
#pragma unroll
                for (int m = 0; m < 4; ++m) rs[m] = rsL[ai * HALF + wr * 64 + m * 16 + fr];
            } else {
#pragma unroll
                for (int m = 0; m < 4; ++m) rs[m] = rsqrtf(ssq[u.pm * BM + ai * HALF + wr * 64 + m * 16 + fr] * (1.0f / 4096.0f) + 1e-6f);
            }
#pragma unroll
            for (int m = 0; m < 4; ++m) {
                const int row = u.pm * BM + ai * HALF + wr * 64 + m * 16 + fr;
                f32x4 a[2];
#pragma unroll
                for (int n = 0; n < 2; ++n)
#pragma unroll
                    for (int j = 0; j < 4; ++j) {
                        const float cur = acc[ai][0][m][n][j] * rs[m], prev = acc[ai][0][m > 0 ? m - 1 : 0][n][j] * rs[m > 0 ? m - 1 : 0];
                        const float s1 = dpp_shr1(cur, prev), s2 = dpp_shr2(cur, prev);
                        const float g = w2[n][j] * cur + w1[n][j] * s1 + w0[n][j] * s2 + bb[n][j];
                        a[n][j] = silu_f(g) * (acc[ai][1][m][n][j] * rs[m]);
                    }
                if (m == 0 && fr < 2) {
                    float* gf = GF + ((size_t)g64 * 2 + fr) * ldc + c0; float* vf = VF + ((size_t)g64 * 2 + fr) * ldc + c0;
                    *(f32x4*)gf = acc[ai][0][0][0] * rs[0]; *(f32x4*)(gf + 4) = acc[ai][0][0][1] * rs[0]; *(f32x4*)vf = acc[ai][1][0][0] * rs[0]; *(f32x4*)(vf + 4) = acc[ai][1][0][1] * rs[0];
                } else {
                    u32x4 w; w.x = cvt_pk_bf16(a[0][0], a[0][1]); w.y = cvt_pk_bf16(a[0][2], a[0][3]); w.z = cvt_pk_bf16(a[1][0], a[1][1]); w.w = cvt_pk_bf16(a[1][2], a[1][3]);
                    *(u32x4*)(ACT + (size_t)row * ldc + c0) = w;
                }
                if (m == 3 && fr >= 14) { float* gb = GB + ((size_t)g64 * 2 + (fr - 14)) * ldc + c0; *(f32x4*)gb = acc[ai][0][3][0] * rs[3]; *(f32x4*)(gb + 4) = acc[ai][0][3][1] * rs[3]; }
            }
        }
    }
};
template <class Epi, class Sched, bool ALIGN_EPI = false, bool SP2 = false>
__device__ __forceinline__ void gemm_phase(PG8_LAS unsigned char* lds, const Gemm g, const Sched& S, const Epi& E, const int tid) {
    const int wid = __builtin_amdgcn_readfirstlane(tid >> 6), lane = tid & 63, wr = wid >> 2, wc = wid & 3, fr = lane & 15, fq = lane >> 4;
    const int K = g.K, nt = K / BK;
    unsigned voffA[2], voffB[2];
#pragma unroll
    for (int i = 0; i < 2; ++i) { int R, C; stage_rc(tid * 16 + i * 8192, R, C); const int Rb = Epi::PERM ? ((R & ~31) + perm32(R & 31)) : R;
        voffA[i] = (unsigned)(R * K + C) * 2u; voffB[i] = (unsigned)(Rb * K + C) * 2u; }
    const size_t kstep = (size_t)(BK * 2);
    const size_t hstep = (size_t)HALF * K * 2;
    const size_t tstep = 2 * hstep;
    const unsigned ldsw = (unsigned)wid * 1024u;
    const int aoff = lds_byte(wr * 64 + fr, fq * 8), boff = lds_byte(wc * 32 + fr, fq * 8);
#define PG8_SA(b, h) (((b) * 2 + (h)) * HTB)
#define PG8_SB(b, h) ((4 + (b) * 2 + (h)) * HTB)
#define PG8_STAGE(bufoff, gbase, voff) do { _Pragma("unroll") for (int _i = 0; _i < 2; ++_i) \
        __builtin_amdgcn_global_load_lds((const unsigned*)((const char*)(gbase) + (voff)[_i]), (PG8_LAS unsigned*)(lds + (bufoff) + ldsw + _i * 8192), 16, 0, 0); } while (0)
#define PG8_LDA(dst, b, h) do { _Pragma("unroll") for (int m = 0; m < 4; ++m) _Pragma("unroll") for (int k = 0; k < 2; ++k) dst[m][k] = *(const PG8_LAS bf16x8*)(lds + PG8_SA(b, h) + aoff + m * 2048 + k * 1024); } while (0)
#define PG8_LDB(dst, b, h) do { _Pragma("unroll") for (int n = 0; n < 2; ++n) _Pragma("unroll") for (int k = 0; k < 2; ++k) dst[n][k] = *(const PG8_LAS bf16x8*)(lds + PG8_SB(b, h) + boff + n * 2048 + k * 1024); } while (0)
#define PG8_MMA(ai, bj, At, Bt) do { __builtin_amdgcn_s_setprio(1); _Pragma("unroll") for (int m = 0; m < 4; ++m) _Pragma("unroll") for (int n = 0; n < 2; ++n) _Pragma("unroll") for (int k = 0; k < 2; ++k) \
        acc[ai][bj][m][n] = __builtin_amdgcn_mfma_f32_16x16x32_bf16(Bt[n][k], At[m][k], acc[ai][bj][m][n], 0, 0, 0); __builtin_amdgcn_s_setprio(0); } while (0)
#define PG8_WAIT_V(n) asm volatile("s_waitcnt vmcnt(" #n ")" ::: "memory")
#define PG8_WAIT_L(n) asm volatile("s_waitcnt lgkmcnt(" #n ")" ::: "memory")
#define PG8_BAR __builtin_amdgcn_s_barrier()
#define PG8_SCHED __builtin_amdgcn_sched_barrier(0)
    Unit cur, nxt; int ui = 0;
    if (!S.next(0, cur)) return;
    f32x4 acc[2][2][4][2];
#pragma unroll
    for (int a = 0; a < 2; ++a)
#pragma unroll
        for (int b = 0; b < 2; ++b)
#pragma unroll
            for (int m = 0; m < 4; ++m)
#pragma unroll
                for (int n = 0; n < 2; ++n) acc[a][b][m][n] = (f32x4){0.f, 0.f, 0.f, 0.f};
    bf16x8 At[4][2], B0[2][2], B1[2][2];
    const char* cA = (const char*)g.A + (size_t)cur.pm * tstep; const char* cB = (const char*)g.Bt + (size_t)cur.pn * tstep;
    S.a_ready(cur);
    if constexpr (SP2) {
        PG8_STAGE(PG8_SB(0, 0), cB, voffB); PG8_STAGE(PG8_SB(0, 1), cB + hstep, voffB); PG8_STAGE(PG8_SA(0, 0), cA, voffA); PG8_STAGE(PG8_SA(0, 1), cA + hstep, voffA);
        if (wr == 1) PG8_BAR;
        PG8_WAIT_V(2); PG8_BAR;
        PG8_STAGE(PG8_SB(1, 0), cB + kstep, voffB); PG8_STAGE(PG8_SA(1, 0), cA + kstep, voffA); PG8_STAGE(PG8_SB(1, 1), cB + hstep + kstep, voffB);
        PG8_WAIT_V(6); PG8_BAR;
    } else {
        PG8_STAGE(PG8_SB(0, 0), cB, voffB); PG8_STAGE(PG8_SA(0, 0), cA, voffA); PG8_STAGE(PG8_SB(0, 1), cB + hstep, voffB); PG8_STAGE(PG8_SA(0, 1), cA + hstep, voffA);
        if (wr == 1) PG8_BAR;
        PG8_WAIT_V(4); PG8_BAR;
        PG8_STAGE(PG8_SB(1, 0), cB + kstep, voffB); PG8_STAGE(PG8_SA(1, 0), cA + kstep, voffA); PG8_STAGE(PG8_SB(1, 1), cB + hstep + kstep, voffB);
        PG8_WAIT_V(6); PG8_BAR;
    }
    for (;;) {
        const bool has_next = S.next(ui + 1, nxt);
        const char* nA = has_next ? (const char*)g.A + (size_t)nxt.pm * tstep : cA; const char* nB = has_next ? (const char*)g.Bt + (size_t)nxt.pn * tstep : cB;
        for (int t = 0; t < nt; t += 2) {
            const bool last = (t == nt - 2);
            const char* a1 = cA + (size_t)(t + 1) * kstep;
            const char* a2 = last ? nA : cA + (size_t)(t + 2) * kstep; const char* b2 = last ? nB : cB + (size_t)(t + 2) * kstep;
            const char* a3 = a2 + kstep; const char* b3 = b2 + kstep;
            if (last && has_next) S.a_ready(nxt);
            if constexpr (SP2) {
            PG8_LDB(B0, 0, 0); PG8_LDB(B1, 0, 1); PG8_SCHED; PG8_LDA(At, 0, 0); PG8_STAGE(PG8_SA(1, 1), a1 + hstep, voffA);
            PG8_WAIT_V(8); PG8_WAIT_L(0); PG8_BAR; PG8_MMA(0, 0, At, B0); PG8_MMA(0, 1, At, B1); PG8_BAR; PG8_SCHED;
            PG8_LDA(At, 0, 1); PG8_STAGE(PG8_SB(0, 0), b2, voffB); PG8_STAGE(PG8_SB(0, 1), b2 + hstep, voffB); PG8_STAGE(PG8_SA(0, 0), a2, voffA);
            PG8_WAIT_V(8); PG8_WAIT_L(0); PG8_BAR; PG8_MMA(1, 0, At, B0); PG8_MMA(1, 1, At, B1); PG8_BAR; PG8_SCHED;
            PG8_LDB(B0, 1, 0); PG8_LDB(B1, 1, 1); PG8_SCHED; PG8_LDA(At, 1, 0); PG8_STAGE(PG8_SA(0, 1), a2 + hstep, voffA);
            PG8_WAIT_V(8); PG8_WAIT_L(0); PG8_BAR; PG8_MMA(0, 0, At, B0); PG8_MMA(0, 1, At, B1); PG8_BAR; PG8_SCHED;
            PG8_LDA(At, 1, 1); PG8_STAGE(PG8_SB(1, 0), b3, voffB); PG8_STAGE(PG8_SB(1, 1), b3 + hstep, voffB); PG8_STAGE(PG8_SA(1, 0), a3, voffA);
            PG8_WAIT_V(8); PG8_WAIT_L(0); PG8_BAR; PG8_MMA(1, 0, At, B0); PG8_MMA(1, 1, At, B1); PG8_BAR; PG8_SCHED;
            } else {
            PG8_LDB(B0, 0, 0); PG8_SCHED; PG8_LDA(At, 0, 0); PG8_STAGE(PG8_SA(1, 1), a1 + hstep, voffA);
            PG8_WAIT_L(8); PG8_BAR; PG8_WAIT_L(0); PG8_MMA(0, 0, At, B0); PG8_BAR; PG8_SCHED;
            PG8_LDB(B1, 0, 1); PG8_STAGE(PG8_SB(0, 0), b2, voffB);
            PG8_BAR; PG8_WAIT_L(0); PG8_MMA(0, 1, At, B1); PG8_BAR;
            PG8_LDA(At, 0, 1); PG8_STAGE(PG8_SA(0, 0), a2, voffA);
            PG8_BAR; PG8_WAIT_L(0); PG8_MMA(1, 0, At, B0); PG8_BAR; PG8_SCHED;
            PG8_STAGE(PG8_SB(0, 1), b2 + hstep, voffB);
            PG8_WAIT_V(6); PG8_BAR; PG8_MMA(1, 1, At, B1); PG8_BAR;
            PG8_LDB(B0, 1, 0); PG8_SCHED; PG8_LDA(At, 1, 0); PG8_STAGE(PG8_SA(0, 1), a2 + hstep, voffA);
            PG8_WAIT_L(8); PG8_BAR; PG8_WAIT_L(0); PG8_MMA(0, 0, At, B0); PG8_BAR; PG8_SCHED;
            PG8_LDB(B1, 1, 1); PG8_STAGE(PG8_SB(1, 0), b3, voffB);
            PG8_BAR; PG8_WAIT_L(0); PG8_MMA(0, 1, At, B1); PG8_BAR;
            PG8_LDA(At, 1, 1); PG8_STAGE(PG8_SA(1, 0), a3, voffA);
            PG8_BAR; PG8_WAIT_L(0); PG8_MMA(1, 0, At, B0); PG8_BAR; PG8_SCHED;
            PG8_STAGE(PG8_SB(1, 1), b3 + hstep, voffB);
            PG8_WAIT_V(6); PG8_BAR; PG8_MMA(1, 1, At, B1); PG8_BAR;
            }
        }
        if constexpr (ALIGN_EPI) { if (wr == 0) PG8_BAR; }
        if constexpr (!Epi::AFTER_DRAIN) { E(acc, cur, wr, wc, fr, fq); S.done(cur); }
        if (!has_next) break;
#pragma unroll
        for (int a = 0; a < 2; ++a)
#pragma unroll
            for (int b = 0; b < 2; ++b)
#pragma unroll
                for (int m = 0; m < 4; ++m)
#pragma unroll
                    for (int n = 0; n < 2; ++n) acc[a][b][m][n] = (f32x4){0.f, 0.f, 0.f, 0.f};
        cur = nxt; cA = nA; cB = nB; ++ui;
        if constexpr (ALIGN_EPI) { if (wr == 1) PG8_BAR; }
    }
    PG8_WAIT_V(0);
    if constexpr (!ALIGN_EPI) { if (wr == 0) PG8_BAR; }
    PG8_BAR;
    if constexpr (Epi::AFTER_DRAIN) { E.fused(acc, cur, wr, wc, fr, fq, lds, wid, lane); S.done(cur); }
#undef PG8_SA
#undef PG8_SB
#undef PG8_STAGE
#undef PG8_LDA
#undef PG8_LDB
#undef PG8_MMA
#undef PG8_WAIT_V
#undef PG8_WAIT_L
#undef PG8_BAR
#undef PG8_SCHED
}
}
namespace att {
typedef unsigned short bf16_t;
typedef short bf16x8 __attribute__((ext_vector_type(8)));
typedef short s16x4 __attribute__((ext_vector_type(4)));
typedef float f32x16 __attribute__((ext_vector_type(16)));
typedef float f32x4 __attribute__((ext_vector_type(4)));
typedef unsigned u32x4 __attribute__((ext_vector_type(4)));
constexpr int D = 128;
constexpr float SCALE = 0.08838834764831845f;
constexpr float THR = 8.f;
constexpr int NW = 8, QBLK = 32, KVBLK = 64, QB = NW * QBLK;
constexpr int SHM_V = KVBLK * D * 2, SHM_K = KVBLK * D * 2;
constexpr int LDS_TILES = 2 * SHM_V + 2 * SHM_K + NW * 64 * 4;
constexpr int LDS_BIAS = LDS_TILES;
constexpr int LDS_DTAB = LDS_BIAS + 32768 + 2048;
constexpr int DTAB_STRIDE = 132 * 4, DTAB_BYTES = 48 * DTAB_STRIDE;
constexpr int LDS_END = LDS_DTAB + DTAB_BYTES + 2048;
constexpr int DILW = 129;

#define KSWZ(row, colB) ((row) * 256 + ((colB) ^ (((row) & 7) << 4)))
#define SBAR() __builtin_amdgcn_sched_barrier(0)
__device__ __forceinline__ int v_st(int k, int c) { const int kk = (k & ~0xC) | ((k & 4) << 1) | ((k & 8) >> 1); return ((kk >> 3) * 4 + (c >> 5)) * 512 + ((kk & 7) * 32 + (c & 31)) * 2; }
__device__ __forceinline__ int v_rd_base(int lane) { return ((lane & 3) << 3) | (((lane >> 2) & 3) << 6) | (((lane >> 4) & 1) << 5) | (((lane >> 5) & 1) << 8); }
constexpr int v_rd_off(int d0, int ks, int half) { return d0 * 512 + ks * 4096 + half * 2048; }
__device__ __forceinline__ int crow(int r, int hi) { return (r & 3) + 8 * (r >> 2) + 4 * hi; }
__device__ __forceinline__ unsigned cvtpk(float lo, float hi) { unsigned r; asm volatile("v_cvt_pk_bf16_f32 %0, %1, %2" : "=v"(r) : "v"(lo), "v"(hi)); return r; }
__device__ __forceinline__ bf16x8 gld8(const void* ubase, unsigned voff) { return *reinterpret_cast<const bf16x8*>((const char*)ubase + voff); }
__device__ __forceinline__ void mask_tile(f32x16& p0, f32x16& p1, int dq, unsigned W) {
    const float NEG = -__builtin_inff();
#pragma unroll
    for (int r = 0; r < 16; ++r) {
        const int c = (r & 3) + 8 * (r >> 2);
        if ((unsigned)(dq - c) >= W) p0[r] = NEG;
        if ((unsigned)(dq - c - 32) >= W) p1[r] = NEG;
    }
}
__device__ __forceinline__ void partialSM(f32x16& p0, f32x16& p1, float& m_reg, float& mn, float& alpha) {
    float pmax = p0[0]; for (int r = 1; r < 16; ++r) pmax = fmaxf(pmax, p0[r]); for (int r = 0; r < 16; ++r) pmax = fmaxf(pmax, p1[r]);
    { auto rr = __builtin_amdgcn_permlane32_swap(__float_as_uint(pmax), __float_as_uint(pmax), false, false);
      pmax = fmaxf(__uint_as_float(rr[0]), __uint_as_float(rr[1])); }
    constexpr float C2 = 1.4426950408889634f * SCALE;
    if (__builtin_expect(__all((pmax - m_reg) * SCALE <= THR), 1)) { mn = m_reg; alpha = 1.f; }
    else { mn = fmaxf(m_reg, pmax); alpha = __builtin_amdgcn_exp2f((m_reg - mn) * C2); m_reg = mn; }
    const float mnL = -mn * C2;
    for (int r = 0; r < 16; ++r) p0[r] = fmaf(p0[r], C2, mnL); for (int r = 0; r < 16; ++r) p1[r] = fmaf(p1[r], C2, mnL);
    for (int r = 0; r < 16; ++r) p0[r] = __builtin_amdgcn_exp2f(p0[r]);
}
__device__ __forceinline__ void finishSM(f32x16& p0, f32x16& p1, float alpha, float& l_reg, bf16x8& pa0, bf16x8& pa1, bf16x8& pa2, bf16x8& pa3) {
    for (int r = 0; r < 16; ++r) p1[r] = __builtin_amdgcn_exp2f(p1[r]);
    float ps = 0; for (int r = 0; r < 16; ++r) ps += p0[r]; for (int r = 0; r < 16; ++r) ps += p1[r];
    { auto rr = __builtin_amdgcn_permlane32_swap(__float_as_uint(ps), __float_as_uint(ps), false, false);
      ps = __uint_as_float(rr[0]) + __uint_as_float(rr[1]); }
    l_reg = l_reg * alpha + ps;
#define PK4(P, B_, OUT) do { unsigned a0 = cvtpk(P[B_+0], P[B_+1]), a1 = cvtpk(P[B_+2], P[B_+3]);                          \
        unsigned b0 = cvtpk(P[B_+4], P[B_+5]), b1 = cvtpk(P[B_+6], P[B_+7]);                                             \
        auto r0 = __builtin_amdgcn_permlane32_swap(a0, b0, false, false); auto r1 = __builtin_amdgcn_permlane32_swap(a1, b1, false, false); \
        u32x4 w = {r0[0], r1[0], r0[1], r1[1]}; OUT = *reinterpret_cast<bf16x8*>(&w); } while (0)
    PK4(p0, 0, pa0); PK4(p0, 8, pa1); PK4(p1, 0, pa2); PK4(p1, 8, pa3);
#undef PK4
}
template <int KB, int MODE>
__device__ __forceinline__ void qkt(f32x16& p0, f32x16& p1, const char* K_lds, int r32, int hi, const bf16x8* qr, bool act, const char* bptr, int dq) {
    constexpr bool SK = MODE == 1;
    const float NEG = -__builtin_inff();
    if (SK && !act) {
#pragma unroll
        for (int r = 0; r < 16; ++r) { p0[r] = NEG; p1[r] = NEG; } return; }
    if (MODE == 0) {
#pragma unroll
        for (int g = 0; g < 4; ++g) { const f32x4 v0 = *(const f32x4*)(bptr + 32 * g), v1 = *(const f32x4*)(bptr + 128 + 32 * g);
#pragma unroll
            for (int j = 0; j < 4; ++j) { p0[4 * g + j] = v0[j]; p1[4 * g + j] = v1[j]; } }
    } else {
#pragma unroll
        for (int r = 0; r < 16; ++r) { const int c = (r & 3) + 8 * (r >> 2);
            const float b0 = *(const float*)(bptr + 4 * c), b1 = *(const float*)(bptr + 4 * c + 128);
            p0[r] = ((unsigned)(dq - c) < (unsigned)DILW) ? b0 : NEG; p1[r] = ((unsigned)(dq - c - 32) < (unsigned)DILW) ? b1 : NEG; }
    }
    const char* kb[4];
#pragma unroll
    for (int dd = 0; dd < 4; ++dd) kb[dd] = K_lds + KB * SHM_K + KSWZ(r32, (dd * 16 + hi * 8) * 2);
#pragma unroll
    for (int d0 = 0; d0 < 8; ++d0) { const char* a = kb[d0 & 3] + (d0 >> 2) * 128;
        bf16x8 b0 = *reinterpret_cast<const bf16x8*>(a);
        bf16x8 b1 = *reinterpret_cast<const bf16x8*>(a + 32 * 256);
        p0 = __builtin_amdgcn_mfma_f32_32x32x16_bf16(b0, qr[d0], p0, 0, 0, 0);
        p1 = __builtin_amdgcn_mfma_f32_32x32x16_bf16(b1, qr[d0], p1, 0, 0, 0); }
}
template <int VB, bool SK>
__device__ __forceinline__ void pv_tile(f32x16* o, int vb0, bf16x8 pa0, bf16x8 pa1, bf16x8 pa2, bf16x8 pa3, bool act) {
    if (SK && !act) return;
#define TRRD(dst, off) asm volatile("ds_read_b64_tr_b16 %0, %1 offset:%2" : "=&v"(dst) : "v"(vb0), "i"(off) : "memory")
#define PV_D0(d0) do { s16x4 l0, l1, l2, l3, h0, h1, h2, h3; constexpr int b_ = VB * SHM_V + v_rd_off(d0, 0, 0);  \
        TRRD(l0, b_); TRRD(h0, b_ + 2048); TRRD(l1, b_ + 4096); TRRD(h1, b_ + 6144); TRRD(l2, b_ + 8192); TRRD(h2, b_ + 10240); TRRD(l3, b_ + 12288); TRRD(h3, b_ + 14336); \
        asm volatile("s_waitcnt lgkmcnt(0)" ::: "memory"); SBAR();   \
        o[d0] = __builtin_amdgcn_mfma_f32_32x32x16_bf16(pa0, (bf16x8){l0[0], l0[1], l0[2], l0[3], h0[0], h0[1], h0[2], h0[3]}, o[d0], 0, 0, 0);   \
        o[d0] = __builtin_amdgcn_mfma_f32_32x32x16_bf16(pa1, (bf16x8){l1[0], l1[1], l1[2], l1[3], h1[0], h1[1], h1[2], h1[3]}, o[d0], 0, 0, 0);   \
        o[d0] = __builtin_amdgcn_mfma_f32_32x32x16_bf16(pa2, (bf16x8){l2[0], l2[1], l2[2], l2[3], h2[0], h2[1], h2[2], h2[3]}, o[d0], 0, 0, 0);   \
        o[d0] = __builtin_amdgcn_mfma_f32_32x32x16_bf16(pa3, (bf16x8){l3[0], l3[1], l3[2], l3[3], h3[0], h3[1], h3[2], h3[3]}, o[d0], 0, 0, 0); } while (0)
    PV_D0(0); PV_D0(1); PV_D0(2); PV_D0(3);
#undef PV_D0
#undef TRRD
}

struct BlockRef { const bf16_t* Q; const bf16_t* K; const bf16_t* V; bf16_t* O; float* lse; const float* gb; int P0, rs, os, ls, jlo, tab; };
struct Seam { bf16x8 qr[8]; bf16x8 st_v0, st_v1, st_k0, st_k1; };
#define ROWP(p, rs_, k0, rr) ((p) + (size_t)((k0) + (rr)) * (rs_) + sc)
#define VMW() asm volatile("s_waitcnt vmcnt(0)" ::: "memory")
#define VMWN(n) asm volatile("s_waitcnt vmcnt(%0)" :: "i"(n) : "memory")
#define SLOAD_H(Kp, Vp, rs_, k0, vo) do { const char* kb_ = (const char*)((Kp) + (size_t)(k0) * (rs_)); const char* vb_ = (const char*)((Vp) + (size_t)(k0) * (rs_)); const size_t h_ = (size_t)64 * (rs_); \
                         S.st_v0 = gld8(vb_, vo); S.st_v1 = gld8(vb_ + h_, vo); S.st_k0 = gld8(kb_, vo); S.st_k1 = gld8(kb_ + h_, vo); } while (0)
#define SWRITE_HK(bf) do { *(bf16x8*)(K_lds + (bf) * SHM_K + kws) = S.st_k0; *(bf16x8*)(K_lds + (bf) * SHM_K + kws + 32 * 256) = S.st_k1; } while (0)
#define SWRITE_HV(bf) do { *(bf16x8*)(V_lds + (bf) * SHM_V + vst0) = S.st_v0; *(bf16x8*)(V_lds + (bf) * SHM_V + vst1) = S.st_v1; } while (0)
#define SWRITE_H(bf) do { SWRITE_HV(bf); SWRITE_HK(bf); } while (0)
__device__ __forceinline__ void attn_prime(const BlockRef& cur, char* lds, Seam& S, const int tid) {
    const int wid = __builtin_amdgcn_readfirstlane(tid >> 6), lane = tid & 63, r32 = lane & 31, hi = lane >> 5;
    const int sr = tid >> 4, sc = (tid & 15) * 8, kws = KSWZ(sr, sc * 2); char* K_lds = lds + 2 * SHM_V;
    const int kb0 = cur.jlo * KVBLK;
    { const char* qb_ = (const char*)(cur.Q + (size_t)(wid * QBLK) * cur.rs); const unsigned qv_ = (unsigned)(r32 * cur.rs + hi * 8) * 2u;
      for (int d0 = 0; d0 < 8; ++d0) S.qr[d0] = gld8(qb_ + d0 * 32, qv_); }
    { const unsigned vo_ = (unsigned)(sr * cur.rs + sc) * 2u; SLOAD_H(cur.K, cur.V, cur.rs, kb0, vo_); } VMW(); SWRITE_HK(0);
    __syncthreads();
}
template <int MODE>
__device__ __forceinline__ void attn_block(const BlockRef& cur, const BlockRef& nxt, char* lds, Seam& S, const int tid) {
    constexpr bool SK = MODE == 1;
    constexpr int W = MODE == 1 ? DILW : (1 << 30);
    const int wid = __builtin_amdgcn_readfirstlane(tid >> 6), lane = tid & 63, r32 = lane & 31, hi = lane >> 5;
    const int j_lo = cur.jlo;
    const int j_hi = (cur.P0 + QB - 1) / KVBLK + 1;
    const int NT = j_hi - j_lo;
    const int kbn = nxt.jlo * KVBLK;
    const int qlo = cur.P0 + wid * QBLK, qm = qlo + r32 - 4 * hi;
    char* V_lds = lds; char* K_lds = lds + 2 * SHM_V;
    float* ws = (float*)(lds + 2 * SHM_V + 2 * SHM_K) + wid * 64; float* li_l = ws, * al_l = ws + 32;
    float m_reg = -1e30f, l_reg = 0; f32x16 o[4] = {};
    const int sr = tid >> 4, sc = (tid & 15) * 8, vst0 = v_st(sr, sc), vst1 = v_st(32 + sr, sc), kws = KSWZ(sr, sc * 2);
    const int vb0 = (int)(uintptr_t)V_lds + v_rd_base(lane);
    const bf16_t* Kh = cur.K; const bf16_t* Vh = cur.V; const int rs = cur.rs; const unsigned kvo = (unsigned)(sr * rs + sc) * 2u;
    const char* bb0 = (MODE == 0) ? (lds + LDS_BIAS + hi * 16) : (lds + cur.tab + (128 - qm) * 4);
#define RESC(a) do { if (__any((a) < 1.f)) { if (hi == 0) al_l[r32] = (a); asm volatile("s_waitcnt lgkmcnt(0)" ::: "memory");              \
                     for (int d_ = 0; d_ < 4; ++d_) for (int r = 0; r < 16; ++r) o[d_][r] *= al_l[crow(r, hi)]; } } while (0)
#define KBASE(t) ((j_lo + (t)) * KVBLK)
#define ACT(t) (KBASE(t) <= qlo + QBLK - 1 && KBASE(t) + KVBLK - 1 >= qlo - W + 1)
#define MASKT(P0_, P1_, t) do { if (MODE == 0) { const int kb_ = KBASE(t); if (kb_ + KVBLK - 1 > qlo) mask_tile(P0_, P1_, qm - kb_, (unsigned)W); } } while (0)
#define QKT(KB, PX0, PX1, t) qkt<KB, MODE>(PX0, PX1, K_lds, r32, hi, S.qr, ACT(t), bb0 + KBASE(t) * 4, qm - KBASE(t))
#define PSM(PX0, PX1, mnX, alX, t) do { if (!SK || ACT(t)) partialSM(PX0, PX1, m_reg, mnX, alX); else { mnX = m_reg; alX = 1.f; } } while (0)
#define FSM(PY0, PY1, alY, t) do { if (!SK || ACT(t)) finishSM(PY0, PY1, alY, l_reg, pa0, pa1, pa2, pa3); } while (0)
    constexpr int NQL = 8;
#define SEAM_K0() do { VMWN(NQL); SWRITE_HK(0); SBAR(); } while (0)
    f32x16 pA0, pA1, pB0, pB1; float mnA, mnB, alA, alB; bf16x8 pa0, pa1, pa2, pa3;
    SWRITE_HV(0); SBAR();
    if (NT > 1) { SLOAD_H(Kh, Vh, rs, KBASE(1), kvo); }
    SBAR(); QKT(0, pA0, pA1, 0);
    MASKT(pA0, pA1, 0); PSM(pA0, pA1, mnA, alA, 0);
    if (NT > 1) { VMW(); SWRITE_H(1); }
    __syncthreads();
#define HALF_STEP(PX0, PX1, mnX, alX, PY0, PY1, alY, t, KB, VB, SB) do {                                                      \
        SBAR(); QKT(KB, PX0, PX1, t);                                             \
        FSM(PY0, PY1, alY, (t) - 1); SBAR();                                                           \
        if ((t) + 1 < NT) { SLOAD_H(Kh, Vh, rs, KBASE((t) + 1), kvo); SBAR(); }                                               \
        pv_tile<VB, SK>(o, vb0, pa0, pa1, pa2, pa3, ACT((t) - 1)); MASKT(PX0, PX1, (t)); PSM(PX0, PX1, mnX, alX, (t));                                        \
        __syncthreads();                                                                                                      \
        if ((t) + 1 < NT) { VMW(); SWRITE_H(SB); }                                                                          \
        RESC(alX); __syncthreads(); } while (0)
    for (int t = 1; t + 1 < NT; t += 2) {
        HALF_STEP(pB0, pB1, mnB, alB, pA0, pA1, alA, t, 1, 0, 0);
        HALF_STEP(pA0, pA1, mnA, alA, pB0, pB1, alB, t + 1, 0, 1, 1);
    }
    const bool even = (NT & 1) == 0;
    if (even) { SBAR(); QKT(1, pB0, pB1, NT - 1); SBAR(); }
    { const unsigned vo_ = (unsigned)(sr * nxt.rs + sc) * 2u; SLOAD_H(nxt.K, nxt.V, nxt.rs, kbn, vo_); } SBAR();
    { const char* qb_ = (const char*)(nxt.Q + (size_t)(wid * QBLK) * nxt.rs); const unsigned qv_ = (unsigned)(r32 * nxt.rs + hi * 8) * 2u;
#pragma unroll
      for (int d0 = 0; d0 < 8; ++d0) S.qr[d0] = gld8(qb_ + d0 * 32, qv_); }
    SBAR();
    FSM(pA0, pA1, alA, (even ? NT - 2 : NT - 1)); SBAR();
    pv_tile<0, SK>(o, vb0, pa0, pa1, pa2, pa3, ACT(even ? NT - 2 : NT - 1));
    if (even) { MASKT(pB0, pB1, NT - 1); PSM(pB0, pB1, mnB, alB, NT - 1); __syncthreads(); RESC(alB);
        FSM(pB0, pB1, alB, NT - 1); SBAR(); pv_tile<1, SK>(o, vb0, pa0, pa1, pa2, pa3, ACT(NT - 1)); }
    SBAR(); SEAM_K0();
    if (hi == 0) li_l[r32] = l_reg; asm volatile("s_waitcnt lgkmcnt(0)" ::: "memory");
    float rli[16];
#pragma unroll
    for (int r = 0; r < 16; ++r) rli[r] = __builtin_amdgcn_rcpf(li_l[crow(r, hi)]);
    int os_ = __builtin_amdgcn_readfirstlane(cur.os); asm volatile("" : "+s"(os_));
    bf16_t* Ow = cur.O + (size_t)(wid * QBLK) * os_; const unsigned ovo = (unsigned)(4 * hi * os_ + r32) * 2u;
#pragma unroll
    for (int r = 0; r < 16; ++r) { char* ob_ = (char*)(Ow + (size_t)((r & 3) + 8 * (r >> 2)) * os_);
#pragma unroll
        for (int d0 = 0; d0 < 4; ++d0) { const float v = o[d0][r] * rli[r];
            const float vn = __shfl_xor(v, 1);
            if ((r32 & 1) == 0) *(unsigned*)(ob_ + d0 * 64 + ovo) = cvtpk(v, vn); } }
    if (MODE == 1) { constexpr float C2 = 1.4426950408889634f * SCALE;
        if (hi == 0) cur.lse[(size_t)(wid * QBLK + r32) * cur.ls] = m_reg * C2 + __builtin_amdgcn_logf(l_reg); }
    __syncthreads();
#undef RESC
#undef KBASE
#undef ACT
#undef MASKT
#undef QKT
#undef PSM
#undef FSM
#undef SEAM_K0
#undef HALF_STEP
}
#undef ROWP
#undef VMW
#undef VMWN
#undef SLOAD_H
#undef SWRITE_HK
#undef SWRITE_HV
#undef SWRITE_H
#undef KSWZ
#undef SBAR
}
constexpr int SEQ = 8192, DM = 4096, NH = 16, HD = 128, FW = 2048, NQKV = 12288, INW = 12304, DFF = 11008, NUP = 22016;
constexpr float RMS_EPS = 1e-6f;
constexpr float INV_SCALE = 11.313708498984761f;
constexpr int NWAVES = 8;
constexpr size_t MiB = 1u << 20;
constexpr size_t WS_WIN = 0, WS_WF = 96 * MiB, WS_WOUT = 97 * MiB, WS_WUP = 129 * MiB, WS_WDN = 301 * MiB, WS_XN = 387 * MiB, WS_X1 = 453 * MiB, WS_ACT = 581 * MiB;
constexpr size_t WS_MISC = 753 * MiB, WS_CTL = WS_MISC + 3 * MiB, CTL_NORM = 64, CTL_SSQ = 4096, CTL_SSQ2 = 4096 + 32768, CTL_BAR = 4096 + 2 * 32768, CTL_BYTES = CTL_BAR + 16384;
constexpr size_t WS_LOGF = WS_MISC, WS_CNEG = WS_MISC + 1 * MiB, WS_TAB = WS_MISC + 2 * MiB, WS_GB = WS_MISC + 4 * MiB, WS_GF = WS_MISC + 16 * MiB, WS_VF = WS_MISC + 28 * MiB;
constexpr size_t WS_QKV = 817 * MiB, WS_OA = WS_QKV + 192 * MiB, WS_OB = WS_OA + 32 * MiB, WS_LSE = WS_OB + 96 * MiB, WS_MIX = WS_LSE + 2 * MiB, WS_END = WS_MIX + 64 * MiB;
static_assert((size_t)(SEQ / 64) * 2 * DFF * 4 <= 12 * MiB, "side buffers");
constexpr int EPI_SLOTS = 11;
constexpr int LDS_BYTES = 131072 + 1024 + EPI_SLOTS * 2048 + 1024;
static_assert(att::LDS_END <= 131072 + 8192, "attention LDS");
static_assert(8 * 16640 <= LDS_BYTES, "P0 transpose scratch");

#define LAS __attribute__((address_space(3)))
typedef unsigned short bf16;
typedef unsigned v4u __attribute__((ext_vector_type(4)));
typedef unsigned v2u __attribute__((ext_vector_type(2)));
typedef float f32x4 __attribute__((ext_vector_type(4)));
typedef short bf16x8 __attribute__((ext_vector_type(8)));
#define LDS_WAIT() asm volatile("s_waitcnt lgkmcnt(0)" ::: "memory")
__device__ __forceinline__ unsigned pk2(float lo, float hi) { unsigned r; asm volatile("v_cvt_pk_bf16_f32 %0, %1, %2" : "=v"(r) : "v"(lo), "v"(hi)); return r; }
__device__ __forceinline__ float bflo(unsigned u) { return __uint_as_float(u << 16); }
__device__ __forceinline__ float bfhi(unsigned u) { return __uint_as_float(u & 0xffff0000u); }
__device__ __forceinline__ float wave_sum(float v) {
#pragma unroll
    for (int o = 1; o < 64; o <<= 1) v += __shfl_xor(v, o);
    return v;
}
typedef float f32x2 __attribute__((ext_vector_type(2)));
__device__ __forceinline__ void tr_item(const float* W, size_t ldw, int Kdim, bf16* WT, LAS float* scr, int k0, int lane, const float* gk = nullptr) {
    const float* wp = W + (size_t)(k0 + (lane >> 5)) * ldw + 2 * (lane & 31); f32x2 v[32];
#pragma unroll
    for (int i = 0; i < 32; ++i) v[i] = *(const f32x2*)(wp + (size_t)(2 * i) * ldw);
#pragma unroll
    for (int i = 0; i < 32; ++i) { LAS float* d = scr + (2 * i + (lane >> 5)) * 65 + 2 * (lane & 31); d[0] = v[i].x; d[1] = v[i].y; }
    const int c = lane & 7;
    f32x4 g0 = {1.f, 1.f, 1.f, 1.f}, g1 = g0; if (gk) { g0 = *(const f32x4*)(gk + k0 + 8 * c); g1 = *(const f32x4*)(gk + k0 + 8 * c + 4); }
    LDS_WAIT(); asm volatile("" ::: "memory");
#pragma unroll
    for (int j = 0; j < 8; ++j) { const int n = (lane >> 3) + 8 * j; const LAS float* s = scr + (8 * c) * 65 + n;
        v4u o; o.x = pk2(s[0 * 65] * g0.x, s[1 * 65] * g0.y); o.y = pk2(s[2 * 65] * g0.z, s[3 * 65] * g0.w); o.z = pk2(s[4 * 65] * g1.x, s[5 * 65] * g1.y); o.w = pk2(s[6 * 65] * g1.z, s[7 * 65] * g1.w);
        *(v4u*)(WT + (size_t)n * Kdim + k0 + 8 * c) = o; }
    LDS_WAIT(); asm volatile("" ::: "memory");
}
__device__ __forceinline__ void rms_row_bf16(const float* xrow, const float* g, bf16* orow, int lane) {
    const f32x4* xr = (const f32x4*)xrow + lane; f32x4 v[16]; float s = 0.f;
#pragma unroll
    for (int j = 0; j < 16; ++j) { v[j] = xr[64 * j]; s += (v[j].x * v[j].x + v[j].y * v[j].y) + (v[j].z * v[j].z + v[j].w * v[j].w); }
    const float r = rsqrtf(wave_sum(s) * (1.f / DM) + RMS_EPS);
    const f32x4* gr = (const f32x4*)g + lane; v2u* o8 = (v2u*)orow + lane;
#pragma unroll
    for (int j = 0; j < 16; ++j) { const f32x4 gg = gr[64 * j]; v2u w; w.x = pk2(v[j].x * r * gg.x, v[j].y * r * gg.y); w.y = pk2(v[j].z * r * gg.z, v[j].w * r * gg.w); o8[64 * j] = w; }
}
__device__ __forceinline__ void rms_row_f32(const float* xrow, const float* g, float* orow, int lane) {
    const f32x4* xr = (const f32x4*)xrow + lane; f32x4 v[16]; float s = 0.f;
#pragma unroll
    for (int j = 0; j < 16; ++j) { v[j] = xr[64 * j]; s += (v[j].x * v[j].x + v[j].y * v[j].y) + (v[j].z * v[j].z + v[j].w * v[j].w); }
    const float r = rsqrtf(wave_sum(s) * (1.f / DM) + RMS_EPS);
    const f32x4* gr = (const f32x4*)g + lane; f32x4* o = (f32x4*)orow + lane;
#pragma unroll
    for (int j = 0; j < 16; ++j) { const f32x4 gg = gr[64 * j]; o[64 * j] = v[j] * r * gg; }
}
__device__ __forceinline__ int t5_bucket(int dist) {
    if (dist < 16) return dist;
    const float df = (float)dist;
    int large = 16 + (int)(logf(df / 16.0f) / 4.852030263919617f * 16.0f);
    return large < 31 ? large : 31;
}

__device__ __forceinline__ int lane_id_v() { int l; asm volatile("v_mbcnt_lo_u32_b32 %0, -1, 0\n\tv_mbcnt_hi_u32_b32 %0, -1, %0" : "=v"(l)); return l; }
#define XB_CEN(j)  (64 * (j))
#define XB_ARR(j)  (64 * (16 + (j)))
#define XB_REL(j)  (64 * (32 + (j)))
#define XB_TOP     (64 * 48)
#define XB_TOPGEN  (64 * 49)
#define XB_WORDS   (64 * 50)
__device__ __forceinline__ unsigned xb_ld(unsigned* p) { return __hip_atomic_load(p, __ATOMIC_RELAXED, __HIP_MEMORY_SCOPE_AGENT); }
__device__ __forceinline__ unsigned xb_add(unsigned* p, unsigned v) { return __hip_atomic_fetch_add(p, v, __ATOMIC_RELAXED, __HIP_MEMORY_SCOPE_AGENT); }
__device__ __forceinline__ void xb_st(unsigned* p, unsigned v) { __hip_atomic_store(p, v, __ATOMIC_RELAXED, __HIP_MEMORY_SCOPE_AGENT); }
__device__ __forceinline__ unsigned xcc_id() { return (unsigned)__builtin_amdgcn_s_getreg((3 << 11) | 20) & 0xFu; }
__device__ __forceinline__ void grid_barrier(unsigned* bar, unsigned r, unsigned x, unsigned nloc, unsigned nx, int tid) {
    asm volatile("s_waitcnt vmcnt(0) lgkmcnt(0)" ::: "memory");
    __syncthreads();
    if (tid == 0) {
        const unsigned old = xb_add(bar + XB_ARR(x), 1u);
        if (old + 1u == nloc * r) {
            __builtin_amdgcn_fence(__ATOMIC_RELEASE, "agent");
            asm volatile("s_waitcnt vmcnt(0)" ::: "memory");
            const unsigned o2 = xb_add(bar + XB_TOP, 1u);
            if (o2 + 1u == nx * r) xb_st(bar + XB_TOPGEN, r);
            else while (xb_ld(bar + XB_TOPGEN) < r) __builtin_amdgcn_s_sleep(1);
            xb_st(bar + XB_REL(x), r);
        } else { while (xb_ld(bar + XB_REL(x)) < r) __builtin_amdgcn_s_sleep(1); }
        __builtin_amdgcn_fence(__ATOMIC_ACQUIRE, "agent");
        asm volatile("s_waitcnt vmcnt(0)" ::: "memory");
    }
    __syncthreads();
}
struct Args { const float* in[14]; float* out; unsigned char* ws; int ph_lo, ph_hi; };
enum { I_X = 0, I_ANG, I_WIN, I_FB, I_RBT, I_FOG, I_DOG, I_WOUT, I_FNG, I_WUP, I_CW, I_CB, I_WDN, I_FING };
constexpr int N_PHASES = 11;
constexpr int DN_KB_SPLIT = 129;
#define PROBE_FOX 1
#define PROBE_DIL 1
#ifndef PROBE_PH
#define PROBE_PH -1
#endif

__global__ void __launch_bounds__(NWAVES * 64, 2) hymba_fwd(Args args) {
    extern __shared__ __attribute__((aligned(16))) unsigned char lds[];
    cg::grid_group grid = cg::this_grid();
    const int wave = __builtin_amdgcn_readfirstlane((int)threadIdx.x >> 6);
    const int G = gridDim.x; const int bx = blockIdx.x; const int vcu = (G % 8 == 0) ? (bx % 8) * (G / 8) + bx / 8 : bx;
    const int gw = vcu * NWAVES + wave, NGW = G * NWAVES;
    unsigned char* ws = args.ws;
    bf16* WinT = (bf16*)(ws + WS_WIN); bf16* WfT = (bf16*)(ws + WS_WF); bf16* WoutT = (bf16*)(ws + WS_WOUT); bf16* WupT = (bf16*)(ws + WS_WUP); bf16* WdnT = (bf16*)(ws + WS_WDN);
    bf16* XN = (bf16*)(ws + WS_XN); float* X1 = (float*)(ws + WS_X1); bf16* ACT = (bf16*)(ws + WS_ACT);
    int* JLO = (int*)(ws + WS_TAB + 65536); float* LOGF = (float*)(ws + WS_LOGF); float* CNEG = (float*)(ws + WS_CNEG); float* TAB = (float*)(ws + WS_TAB);
    float* GB = (float*)(ws + WS_GB); float* GF = (float*)(ws + WS_GF); float* VF = (float*)(ws + WS_VF);
    bf16* QKV = (bf16*)(ws + WS_QKV); bf16* OA = (bf16*)(ws + WS_OA); bf16* OB = (bf16*)(ws + WS_OB); float* LSE = (float*)(ws + WS_LSE); bf16* MIX = (bf16*)(ws + WS_MIX);
    const int lo = args.ph_lo, hi_ph = args.ph_hi;
#define IN(k) (lo <= (k) && (k) < hi_ph)
#define REP(k) ((PROBE_PH == (k)) ? 2 : 1)
    unsigned* gbar = (unsigned*)(ws + WS_CTL + CTL_BAR);
    const unsigned xid = xcc_id(); if (threadIdx.x == 0) (void)xb_add(gbar + XB_CEN(xid), 1u);
    unsigned xb_nloc = 1u, xb_nx = 1u; unsigned* NORM = (unsigned*)(ws + WS_CTL + CTL_NORM); float* SSQ = (float*)(ws + WS_CTL + CTL_SSQ); float* SSQ2 = (float*)(ws + WS_CTL + CTL_SSQ2);
    unsigned nbar = 0;
#define SEAM(k) do { if (IN(k) && IN((k) + 1)) { if ((k) == 0) { asm volatile("s_waitcnt vmcnt(0) lgkmcnt(0)" ::: "memory");     \
        grid.sync(); xb_nx = 0u; for (unsigned j_ = 0; j_ < 16u; ++j_) { const unsigned c_ = xb_ld(gbar + XB_CEN(j_)); xb_nx += c_ ? 1u : 0u; if (j_ == xid) xb_nloc = c_; } \
        xb_nloc = (unsigned)__builtin_amdgcn_readfirstlane((int)xb_nloc); xb_nx = (unsigned)__builtin_amdgcn_readfirstlane((int)xb_nx); \
        ++nbar; grid_barrier(gbar, nbar, xid, xb_nloc, xb_nx, (int)threadIdx.x); }   \
      else if ((k) != 2 && (k) != 5) { ++nbar; grid_barrier(gbar, nbar, xid, xb_nloc, xb_nx, wave * 64 + lane_id_v()); } } } while (0)

    if (IN(0)) for (int rep_ = 0; rep_ < REP(0); ++rep_) {
        const int tid = threadIdx.x, lane = tid & 63;
        LAS float* scr = (LAS float*)((LAS unsigned char*)lds + wave * 16640);
        constexpr int KB4 = DM / 64;
        constexpr int I_IN = KB4 * (NQKV / 64), I_OUT = KB4 * (DM / 64);
        constexpr int I_DNB = ((DFF / 64) - DN_KB_SPLIT) * (DM / 64); constexpr int NITEMS = I_IN + I_OUT + I_DNB;
        for (int it = gw; it < NITEMS; it += NGW) {
            int r = it;
            if (r < I_IN) { const int nblk = NQKV / 64, kb = r / nblk, nb = r % nblk; const int n0 = nb * 64; const int src = n0 < 6144 ? n0 : n0 + 16;
                tr_item(args.in[I_WIN] + src, INW, DM, WinT + (size_t)n0 * DM, scr, kb * 64, lane); continue; } r -= I_IN;
            if (r < I_OUT) { const int nblk = DM / 64, kb = r / nblk, nb = r % nblk;
                tr_item(args.in[I_WOUT] + nb * 64, DM, DM, WoutT + (size_t)(nb * 64) * DM, scr, kb * 64, lane); continue; } r -= I_OUT;
            { const int nblk = DM / 64, kb = DN_KB_SPLIT + r / nblk, nb = r % nblk;
                tr_item(args.in[I_WDN] + nb * 64, DM, DFF, WdnT + (size_t)(nb * 64) * DFF, scr, kb * 64, lane); }
        }
        for (int m = gw; m < SEQ; m += NGW) rms_row_bf16(args.in[I_X] + (size_t)m * DM, args.in[I_ANG], XN + (size_t)m * DM, lane);
        for (int item = gw; item < 16 * (DM / 64); item += NGW) { const int j = item & 15, k = (item >> 4) * 64 + lane;
            const float v = args.in[I_WIN][(size_t)k * INW + 6144 + j]; WfT[(size_t)j * DM + k] = (bf16)(pk2(v, v) & 0xffffu); }
        for (int idx = bx * (NWAVES * 64) + tid; idx < 48 * 132; idx += G * NWAVES * 64) { const int t = idx / 132, i = idx % 132, br = t / 16, h = t % 16;
            float v = 0.f; if (i <= 128) { const int dil = br == 0 ? 1 : (br == 1 ? 4 : 16); v = args.in[I_RBT][t5_bucket((128 - i) * dil) * 16 + h] * INV_SCALE; }
            TAB[idx] = v; }
    }
    SEAM(0);
    if (IN(1)) for (int rep_ = 0; rep_ < REP(1); ++rep_) {
        pg8::Gemm g{XN, WinT, SEQ, NQKV, DM}; pg8::StaticOrder S; S.init(SEQ, NQKV, G, bx);
        pg8::EpiQKV E{QKV, SEQ, NORM};
        const int lane = lane_id_v(), tid = wave * 64 + lane;
        pg8::gemm_phase<pg8::EpiQKV, pg8::StaticOrder, true, true>((LAS unsigned char*)lds, g, S, E, tid);
        for (int task = bx; task < SEQ / 32; task += G) {
            const int t0 = task * 32, row = lane & 15, quad = lane >> 4;
            const bf16* ap = XN + (size_t)(t0 + row) * DM + wave * 512 + quad * 8; const bf16* bp = WfT + (size_t)row * DM + wave * 512 + quad * 8;
            f32x4 acc0 = {0.f, 0.f, 0.f, 0.f}, acc1 = acc0;
#pragma unroll
            for (int k0 = 0; k0 < 512; k0 += 32) { const bf16x8 a0 = *(const bf16x8*)(ap + k0), a1 = *(const bf16x8*)(ap + (size_t)16 * DM + k0), b = *(const bf16x8*)(bp + k0);
                acc0 = __builtin_amdgcn_mfma_f32_16x16x32_bf16(a0, b, acc0, 0, 0, 0); acc1 = __builtin_amdgcn_mfma_f32_16x16x32_bf16(a1, b, acc1, 0, 0, 0); }
            LAS f32x4* red = (LAS f32x4*)lds;
            red[wave * 128 + lane] = acc0; red[wave * 128 + 64 + lane] = acc1;
            __syncthreads();
            if (wave == 0) {
#pragma unroll
                for (int w = 1; w < 8; ++w) { acc0 += red[w * 128 + lane]; acc1 += red[w * 128 + 64 + lane]; }
                const int h = lane & 15; const float fb = args.in[I_FB][h];
#pragma unroll
                for (int j = 0; j < 4; ++j) { const float x0 = acc0[j] + fb, x1 = acc1[j] + fb;
                    LOGF[(size_t)h * SEQ + t0 + quad * 4 + j] = fminf(x0, 0.f) - log1pf(expf(-fabsf(x0)));
                    LOGF[(size_t)h * SEQ + t0 + 16 + quad * 4 + j] = fminf(x1, 0.f) - log1pf(expf(-fabsf(x1))); }
            }
            __syncthreads();
        }
    }
    SEAM(1);
    SEAM(2);
    if (IN(3)) for (int rep_ = 0; rep_ < REP(3); ++rep_) {
        char* al = (char*)lds; const int tid = wave * 64 + lane_id_v();
        for (int i = tid; i < 48 * 132; i += NWAVES * 64) ((float*)(al + att::LDS_DTAB))[i] = TAB[i];
        __syncthreads();
        att::Seam S;
        if (vcu < 256) {
            const int L_ = vcu; const int h_ = L_ >> 4, pr_ = L_ & 15, lane_ = tid & 63;
            float* cbl = (float*)(al + att::LDS_BIAS); float* wsum = (float*)(al + 2 * att::SHM_V + 2 * att::SHM_K);
            { const f32x4* lf = (const f32x4*)(LOGF + (size_t)h_ * SEQ + tid * 16); f32x4 v[4]; float p[16]; float run = 0.f;
#pragma unroll
              for (int i = 0; i < 4; ++i) v[i] = lf[i];
#pragma unroll
              for (int i = 0; i < 4; ++i) { run += v[i].x; p[4 * i] = run; run += v[i].y; p[4 * i + 1] = run; run += v[i].z; p[4 * i + 2] = run; run += v[i].w; p[4 * i + 3] = run; }
              float inc = run;
#pragma unroll
              for (int o = 1; o < 64; o <<= 1) { const float t_ = __shfl_up(inc, o); if (lane_ >= o) inc += t_; }
              if (lane_ == 63) wsum[wave] = inc;
              __syncthreads();
              float off = inc - run;
              for (int w = 0; w < wave; ++w) off += wsum[w];
#pragma unroll
              for (int i = 0; i < 4; ++i) { f32x4 o; o.x = -(off + p[4 * i]) * INV_SCALE; o.y = -(off + p[4 * i + 1]) * INV_SCALE; o.z = -(off + p[4 * i + 2]) * INV_SCALE; o.w = -(off + p[4 * i + 3]) * INV_SCALE; ((f32x4*)cbl)[tid * 4 + i] = o; }
              __syncthreads(); }
            float qn2 = 0.f, kn2 = 0.f;
#pragma unroll
            for (int w = 0; w < 4; ++w) { qn2 += __uint_as_float(NORM[h_ * 4 + w]); kn2 += __uint_as_float(NORM[(16 + h_) * 4 + w]); }
            const float thr = (34.f + 2.02f * sqrtf(qn2 * kn2) * att::SCALE) * INV_SCALE;
#define FOX_REF(R, pass) do { const int qb_ = (pass) ? 31 - pr_ : pr_; \
            R.Q = QKV + ((size_t)(0 * 16 + h_) * SEQ + (size_t)qb_ * 256) * 128; R.K = QKV + (size_t)(1 * 16 + h_) * SEQ * 128; R.V = QKV + (size_t)(2 * 16 + h_) * SEQ * 128; \
            R.O = OA + (size_t)qb_ * 256 * FW + h_ * 128; R.lse = nullptr; R.gb = nullptr; R.P0 = qb_ * 256; R.rs = 128; R.os = FW; R.ls = 0; R.tab = 0; \
            { const float lim_ = cbl[R.P0] - thr; const int nt_ = R.P0 >> 6; int cnt_ = 0; \
              for (int b_ = 0; b_ < nt_; b_ += 64) { const int j_ = b_ + lane_; const bool sk_ = (j_ < nt_) && (cbl[64 * (j_ < nt_ ? j_ : 0) + 63] <= lim_); cnt_ += __popcll(__ballot(sk_)); } R.jlo = cnt_; } } while (0)
            att::BlockRef cur, nxt; FOX_REF(cur, 0); att::attn_prime(cur, al, S, tid);
            FOX_REF(nxt, 1); att::attn_block<0>(cur, nxt, al, S, tid); cur = nxt;
            att::attn_block<0>(cur, cur, al, S, tid);
#undef FOX_REF
        }
        { const int per = (1536 + G - 1) / G; const int L0 = vcu * per; const int L1 = (L0 + per < 1536) ? L0 + per : 1536;
#define DIL_REF(R, L) do { const int h_ = (L) / 96, rem_ = (L) % 96, br_ = rem_ >> 5, idx_ = rem_ & 31; const int dil_ = br_ == 0 ? 1 : (br_ == 1 ? 4 : 16); const int nq_ = 32 / dil_; \
            const int cls_ = idx_ / nq_, qb_ = idx_ % nq_; const size_t tok0_ = (size_t)cls_ + (size_t)qb_ * 256 * dil_; \
            R.Q = QKV + ((size_t)(3 * 16 + h_) * SEQ + tok0_) * 128; R.K = QKV + ((size_t)(4 * 16 + h_) * SEQ + cls_) * 128; R.V = QKV + ((size_t)(5 * 16 + h_) * SEQ + cls_) * 128; \
            R.O = OB + ((size_t)br_ * SEQ + tok0_) * FW + h_ * 128; R.lse = LSE + (size_t)(br_ * 16 + h_) * SEQ + (size_t)cls_ * (SEQ / dil_) + (size_t)qb_ * 256; R.gb = nullptr; R.P0 = qb_ * 256; R.rs = 128 * dil_; R.os = FW * dil_; R.ls = 1;     \
            { const int lowk_ = qb_ * 256 - 128; R.jlo = lowk_ > 0 ? lowk_ / 64 : 0; } R.tab = att::LDS_DTAB + (br_ * 16 + h_) * att::DTAB_STRIDE; } while (0)
          if (L0 < L1) { att::BlockRef cur, nxt; DIL_REF(cur, L0); att::attn_prime(cur, al, S, tid);
            const int nd = (L1 - L0) * PROBE_DIL;
            for (int i = 0; i < nd; ++i) { if (i + 1 < nd) DIL_REF(nxt, L0 + (i + 1) % (L1 - L0)); else nxt = cur; att::attn_block<1>(cur, nxt, al, S, tid); cur = nxt; } }
#undef DIL_REF
        }
    }
    SEAM(3);
    if (IN(4)) for (int rep_ = 0; rep_ < REP(4); ++rep_) {
        const float* ga = args.in[I_FOG]; const float* gd = args.in[I_DOG]; const int lane = lane_id_v();
        for (int t = gw; t < SEQ; t += NGW) {
            { const v4u* oa = (const v4u*)(OA + (size_t)t * FW) + lane; v4u raw[4]; float ss = 0.f;
#pragma unroll
              for (int j = 0; j < 4; ++j) { raw[j] = oa[64 * j];
#pragma unroll
                  for (int e = 0; e < 4; ++e) { const float a = bflo(raw[j][e]), b = bfhi(raw[j][e]); ss += a * a + b * b; } }
              const float r = rsqrtf(wave_sum(ss) * (1.f / FW) + RMS_EPS);
#pragma unroll
              for (int j = 0; j < 4; ++j) { const int col = 8 * (lane + 64 * j); const f32x4 g0 = *(const f32x4*)(ga + col), g1 = *(const f32x4*)(ga + col + 4); v4u w;
                  w.x = pk2(bflo(raw[j].x) * r * g0.x, bfhi(raw[j].x) * r * g0.y); w.y = pk2(bflo(raw[j].y) * r * g0.z, bfhi(raw[j].y) * r * g0.w);
                  w.z = pk2(bflo(raw[j].z) * r * g1.x, bfhi(raw[j].z) * r * g1.y); w.w = pk2(bflo(raw[j].w) * r * g1.z, bfhi(raw[j].w) * r * g1.w);
                  *(v4u*)(MIX + (size_t)t * DM + col) = w; } }
            { float v[4][8]; float ss = 0.f;
#pragma unroll
              for (int j = 0; j < 4; ++j) { const int col = 8 * (lane + 64 * j), h = col >> 7;
                  const float l0 = LSE[(size_t)(0 * 16 + h) * SEQ + t], l1 = LSE[(size_t)(1 * 16 + h) * SEQ + (size_t)(t & 3) * (SEQ / 4) + (t >> 2)], l2 = LSE[(size_t)(2 * 16 + h) * SEQ + (size_t)(t & 15) * (SEQ / 16) + (t >> 4)];
                  const float mx = fmaxf(l0, fmaxf(l1, l2)); float w0 = __builtin_amdgcn_exp2f(l0 - mx), w1 = __builtin_amdgcn_exp2f(l1 - mx), w2 = __builtin_amdgcn_exp2f(l2 - mx);
                  const float inv = 1.f / (w0 + w1 + w2); w0 *= inv; w1 *= inv; w2 *= inv;
                  const v4u a = *(const v4u*)(OB + ((size_t)0 * SEQ + t) * FW + col), b = *(const v4u*)(OB + ((size_t)1 * SEQ + t) * FW + col), c = *(const v4u*)(OB + ((size_t)2 * SEQ + t) * FW + col);
#pragma unroll
                  for (int e = 0; e < 4; ++e) { v[j][2 * e] = w0 * bflo(a[e]) + w1 * bflo(b[e]) + w2 * bflo(c[e]); v[j][2 * e + 1] = w0 * bfhi(a[e]) + w1 * bfhi(b[e]) + w2 * bfhi(c[e]);
                      ss += v[j][2 * e] * v[j][2 * e] + v[j][2 * e + 1] * v[j][2 * e + 1]; } }
              const float r = rsqrtf(wave_sum(ss) * (1.f / FW) + RMS_EPS);
#pragma unroll
              for (int j = 0; j < 4; ++j) { const int col = 8 * (lane + 64 * j); const f32x4 g0 = *(const f32x4*)(gd + col), g1 = *(const f32x4*)(gd + col + 4); v4u w;
                  w.x = pk2(v[j][0] * r * g0.x, v[j][1] * r * g0.y); w.y = pk2(v[j][2] * r * g0.z, v[j][3] * r * g0.w); w.z = pk2(v[j][4] * r * g1.x, v[j][5] * r * g1.y); w.w = pk2(v[j][6] * r * g1.z, v[j][7] * r * g1.w);
                  *(v4u*)(MIX + (size_t)t * DM + FW + col) = w; } }
        }
    }
    SEAM(4);
    if (IN(5)) for (int rep_ = 0; rep_ < REP(5); ++rep_) {
        pg8::Gemm g{MIX, WoutT, SEQ, DM, DM}; pg8::StaticOrder S; S.init(SEQ, DM, G, bx);
        pg8::EpiX1 E{args.in[I_X], XN, SSQ, DM};
        pg8::gemm_phase<pg8::EpiX1, pg8::StaticOrder, true, true>((LAS unsigned char*)lds, g, S, E, wave * 64 + lane_id_v());
    }
    SEAM(5);
    if (IN(6)) for (int rep_ = 0; rep_ < REP(6); ++rep_) {
        const int lane = lane_id_v(); LAS float* scr = (LAS float*)((LAS unsigned char*)lds + wave * 16640);
        constexpr int I_UP = (DM / 64) * (NUP / 64);
        for (int r = gw; r < I_UP; r += NGW) { const int nblk = NUP / 64, kb = r / nblk, nb = r % nblk; const int n0 = nb * 64;
            const int f = n0 < DFF ? n0 : n0 - DFF; const int drow = 256 * (f >> 7) + (f & 127) + (n0 < DFF ? 0 : 128);
            tr_item(args.in[I_WUP] + n0, NUP, DM, WupT + (size_t)drow * DM, scr, kb * 64, lane, args.in[I_FNG]); }
    }
    SEAM(6);
    if (IN(7)) for (int rep_ = 0; rep_ < REP(7); ++rep_) {
        pg8::Gemm g{XN, WupT, SEQ, NUP, DM}; pg8::StaticOrder S; S.init(SEQ, NUP, G, bx);
        LAS float* rsL = (LAS float*)((LAS unsigned char*)lds + 131072); LAS float* cwL = rsL + 256;
        int pm0 = -1, pn0 = 0, nslot = 0;
        { const int tid_ = wave * 64 + lane_id_v(); pg8::Unit u0, ui;
          if (S.next(0, u0)) { pm0 = u0.pm; pn0 = u0.pn; nslot = 1;
            for (int i = 1; i < EPI_SLOTS && S.next(i, ui); ++i) { if (ui.pm != pm0 || ui.pn != pn0 + 4 * i) break; nslot = i + 1; }
            if (tid_ < 256) rsL[tid_] = rsqrtf(SSQ[pm0 * 256 + tid_] * (1.0f / 4096.0f) + 1e-6f);
            const int arr = tid_ >> 7, c = tid_ & 127;
            for (int i = 0; i < nslot; ++i) { const int col = (pn0 + 4 * i) * 128 + c; cwL[i * 512 + tid_] = arr < 3 ? args.in[I_CW][(size_t)arr * DFF + col] : args.in[I_CB][col]; } }
          __syncthreads(); }
        pg8::EpiGate E{ACT, DFF, args.in[I_CW], args.in[I_CB], GB, GF, VF, SSQ, rsL, cwL, pm0, pn0, nslot};
        pg8::gemm_phase<pg8::EpiGate, pg8::StaticOrder, true, true>((LAS unsigned char*)lds, g, S, E, wave * 64 + lane_id_v());
        { const int nwg = (SEQ / 256) * (NUP / 256), rem = nwg % G, first = rem ? rem : 0, nconv = rem ? G - rem : G;
          if (bx >= first) { const int lane = lane_id_v(); LAS float* scr = (LAS float*)((LAS unsigned char*)lds + wave * 16640);
            constexpr int I_DN = DN_KB_SPLIT * (DM / 64);
            for (int r = (bx - first) * NWAVES + wave; r < I_DN; r += nconv * NWAVES) { const int nblk = DM / 64, kb = r / nblk, nb = r % nblk;
                tr_item(args.in[I_WDN] + nb * 64, DM, DFF, WdnT + (size_t)(nb * 64) * DFF, scr, kb * 64, lane); } } }
    }
    SEAM(7);
    if (IN(8)) for (int rep_ = 0; rep_ < REP(8); ++rep_) {
        const float* cw = args.in[I_CW]; const float* cb = args.in[I_CB];
        const int total = (SEQ / 64) * 2 * (DFF / 4); const int tid = wave * 64 + lane_id_v();
        for (int idx = bx * (NWAVES * 64) + tid; idx < total; idx += G * NWAVES * 64) {
            const int c4 = idx % (DFF / 4), rk = idx / (DFF / 4), g64 = rk >> 1, k = rk & 1, c = c4 * 4;
            const f32x4 cur = *(const f32x4*)(GF + ((size_t)g64 * 2 + k) * DFF + c), val = *(const f32x4*)(VF + ((size_t)g64 * 2 + k) * DFF + c);
            f32x4 p1 = {0.f, 0.f, 0.f, 0.f}, p2 = {0.f, 0.f, 0.f, 0.f};
            if (k == 1) { p1 = *(const f32x4*)(GF + ((size_t)g64 * 2) * DFF + c); if (g64 > 0) p2 = *(const f32x4*)(GB + ((size_t)(g64 - 1) * 2 + 1) * DFF + c); }
            else if (g64 > 0) { p1 = *(const f32x4*)(GB + ((size_t)(g64 - 1) * 2 + 1) * DFF + c); p2 = *(const f32x4*)(GB + ((size_t)(g64 - 1) * 2) * DFF + c); }
            const f32x4 w0 = *(const f32x4*)(cw + c), w1 = *(const f32x4*)(cw + DFF + c), w2 = *(const f32x4*)(cw + 2 * DFF + c), b = *(const f32x4*)(cb + c);
            float a[4];
#pragma unroll
            for (int j = 0; j < 4; ++j) { const float gg = w2[j] * cur[j] + w1[j] * p1[j] + w0[j] * p2[j] + b[j]; a[j] = pg8::silu_f(gg) * val[j]; }
            v2u w; w.x = pk2(a[0], a[1]); w.y = pk2(a[2], a[3]);
            *(v2u*)(ACT + (size_t)(g64 * 64 + k) * DFF + c) = w;
        }
    }
    SEAM(8);
    if (IN(9)) for (int rep_ = 0; rep_ < REP(9); ++rep_) {
        pg8::Gemm g{ACT, WdnT, SEQ, DM, DFF}; pg8::StaticOrder S; S.init(SEQ, DM, G, bx);
        pg8::EpiX2 E{XN, SSQ2, DM};
        pg8::gemm_phase<pg8::EpiX2, pg8::StaticOrder, true, true>((LAS unsigned char*)lds, g, S, E, wave * 64 + lane_id_v());
    }
    SEAM(9);
    if (IN(10)) for (int rep_ = 0; rep_ < REP(10); ++rep_) { const int lane = lane_id_v(); const float* gf = args.in[I_FING];
        for (int m = gw; m < SEQ; m += NGW) { const float r = rsqrtf(SSQ2[m] * (1.f / DM) + RMS_EPS); const v4u* xr = (const v4u*)(XN + (size_t)m * DM) + lane; float* orow = args.out + (size_t)m * DM;
            v4u raw[8];
#pragma unroll
            for (int j = 0; j < 8; ++j) raw[j] = xr[64 * j];
#pragma unroll
            for (int j = 0; j < 8; ++j) { const int col = 8 * (lane + 64 * j); const f32x4 g0 = *(const f32x4*)(gf + col), g1 = *(const f32x4*)(gf + col + 4);
                f32x4 o0, o1; o0.x = bflo(raw[j].x) * r * g0.x; o0.y = bfhi(raw[j].x) * r * g0.y; o0.z = bflo(raw[j].y) * r * g0.z; o0.w = bfhi(raw[j].y) * r * g0.w;
                o1.x = bflo(raw[j].z) * r * g1.x; o1.y = bfhi(raw[j].z) * r * g1.y; o1.z = bflo(raw[j].w) * r * g1.z; o1.w = bfhi(raw[j].w) * r * g1.w;
                *(f32x4*)(orow + col) = o0; *(f32x4*)(orow + col + 4) = o1; } }
    }
#undef IN
#undef SEAM
}

#ifndef MK_N_LAUNCHES
#define MK_N_LAUNCHES 1
#endif
extern "C" void kernel_launch(void* const* d_in, const int* in_sizes, int n_in, void* d_out, int out_size, void* d_ws, size_t ws_size, hipStream_t stream) {
    static int grid = 0;
    if (grid == 0) {
        if (n_in != 14 || in_sizes[0] != SEQ * DM || out_size != SEQ * DM || ws_size < WS_END) { fprintf(stderr, "kernel_launch: unexpected shapes (n_in %d, ws %zu < %zu)\n", n_in, ws_size, (size_t)WS_END); grid = -1; return; }
        int dev = 0, cus = 0, per_cu = 0;
        (void)hipGetDevice(&dev); (void)hipDeviceGetAttribute(&cus, hipDeviceAttributeMultiprocessorCount, dev);
        if (hipFuncSetAttribute((const void*)hymba_fwd, hipFuncAttributeMaxDynamicSharedMemorySize, LDS_BYTES) != hipSuccess) { fprintf(stderr, "kernel_launch: hipFuncSetAttribute failed\n"); grid = -1; return; }
        if (hipOccupancyMaxActiveBlocksPerMultiprocessor(&per_cu, (const void*)hymba_fwd, NWAVES * 64, LDS_BYTES) != hipSuccess || per_cu < 1) { fprintf(stderr, "kernel_launch: occupancy query says %d\n", per_cu); per_cu = 1; }
        (void)hipGetLastError();
        grid = cus * 1;
        if (grid <= 0) grid = 256;
        if (grid < 256) { fprintf(stderr, "kernel_launch: needs >= 256 workgroups (one FoX item each), device has %d CUs\n", grid); grid = -1; return; }
    }
    if (grid < 0) return;
    if (hipMemsetAsync((char*)d_ws + WS_CTL, 0, CTL_BYTES, stream) != hipSuccess) { fprintf(stderr, "kernel_launch: memset failed\n"); return; }
    Args a{};
    for (int i = 0; i < 14; ++i) a.in[i] = (const float*)d_in[i];
    a.out = (float*)d_out; a.ws = (unsigned char*)d_ws;
#if MK_N_LAUNCHES == 1
    a.ph_lo = 0; a.ph_hi = N_PHASES;
    { void* kargs[] = {&a}; hipError_t e = hipLaunchCooperativeKernel((const void*)hymba_fwd, dim3(grid), dim3(NWAVES * 64), kargs, LDS_BYTES, stream);
      if (e != hipSuccess) fprintf(stderr, "kernel_launch: cooperative launch failed: %s (grid %d)\n", hipGetErrorString(e), grid); }
#else
    for (int p = 0; p < N_PHASES; ++p) { a.ph_lo = p; a.ph_hi = p + 1; void* kargs[] = {&a};
        hipError_t e = hipLaunchCooperativeKernel((const void*)hymba_fwd, dim3(grid), dim3(NWAVES * 64), kargs, LDS_BYTES, stream);
        if (e != hipSuccess) { fprintf(stderr, "kernel_launch: launch %d failed: %s\n", p, hipGetErrorString(e)); break; } }
#endif
}
```

```cpp
#include <hip/hip_runtime.h>
#include <hip/hip_bf16.h>
#include <hip/hip_cooperative_groups.h>
#include <cstdio>
#include <cstdint>
namespace cg = cooperative_groups;
namespace pg8 {
#define PG8_LAS __attribute__((address_space(3)))
typedef unsigned short bf16_t;
typedef short bf16x8 __attribute__((ext_vector_type(8)));
typedef float f32x4 __attribute__((ext_vector_type(4)));
typedef unsigned u32x4 __attribute__((ext_vector_type(4)));
constexpr int BM = 256, BK = 64, HALF = 128, HTB = HALF * BK * 2  , STAGE_BYTES = 8 * HTB, NXCD = 8, WGM = 8;

__host__ __device__ __forceinline__ int lds_byte(int r, int c) { const int st = (r >> 4) * 2 + (c >> 5), rr = r & 15, cc = c & 31, ob = rr * 64 + cc * 2; return st * 1024 + (ob ^ (((ob >> 9) & 1) << 5)); }
__host__ __device__ __forceinline__ void stage_rc(int b, int& R, int& C) { const int st = b / 1024, sb = b % 1024, swz = sb ^ (((sb >> 9) & 1) << 5); R = (st >> 1) * 16 + swz / 64; C = (st & 1) * 32 + (swz % 64) / 2; }
__host__ __device__ __forceinline__ int perm32(int rho) { const int n = rho >> 4, i = rho & 15; return 8 * (i >> 2) + 4 * n + (i & 3); }

struct Unit { int pm, pn; };
struct Gemm { const bf16_t* A; const bf16_t* Bt; int M, N, K; };

struct StaticOrder {
    int nM, nN, nwg, G, c, wgm;
    __host__ __device__ void init(int M, int N, int G_, int c_, int wgm_ = WGM) { nM = M / BM; nN = N / BM; nwg = nM * nN; G = G_; c = c_; wgm = wgm_; }
    __host__ __device__ bool next(int i, Unit& u) const {
        const long L = (long)i * G + c; if (L >= nwg) return false;
        int wgid = (int)L; { const int q = nwg / NXCD, r = nwg % NXCD, xcd = wgid % NXCD, off = wgid / NXCD; wgid = (xcd < r ? xcd * (q + 1) : r * (q + 1) + (xcd - r) * q) + off; }
        const int nig = wgm * nN, gid = wgid / nig, fm = gid * wgm, gsz = (nM - fm) < wgm ? (nM - fm) : wgm;
        u.pm = fm + ((wgid % nig) % gsz); u.pn = (wgid % nig) / gsz; return true;
    }
    __device__ __forceinline__ void a_ready(const Unit&) const {}
    __device__ __forceinline__ void done(const Unit&) const {}
};

__device__ __forceinline__ unsigned cvt_pk_bf16(float lo, float hi) { unsigned r; asm volatile("v_cvt_pk_bf16_f32 %0, %1, %2" : "=v"(r) : "v"(lo), "v"(hi)); return r; }
typedef float f32x2 __attribute__((ext_vector_type(2)));
typedef unsigned u32x2 __attribute__((ext_vector_type(2)));
struct EpiQKV {
    static constexpr bool PERM = true, AFTER_DRAIN = false;
    bf16_t* O; int S; unsigned* norm4;
    __device__ __forceinline__ void operator()(const f32x4 (&acc)[2][2][4][2], const Unit& u, int wr, int wc, int fr, int fq) const {
        const int row0 = u.pm * BM + wr * 64 + fr, d0 = wc * 32 + 8 * fq;
#pragma unroll
        for (int bj = 0; bj < 2; ++bj) { bf16_t* hb = O + (size_t)(2 * u.pn + bj) * S * 128 + d0;
#pragma unroll
            for (int ai = 0; ai < 2; ++ai)
#pragma unroll
                for (int m = 0; m < 4; ++m) { const f32x4 v0 = acc[ai][bj][m][0], v1 = acc[ai][bj][m][1];
                    u32x4 w; w.x = cvt_pk_bf16(v0[0], v0[1]); w.y = cvt_pk_bf16(v0[2], v0[3]); w.z = cvt_pk_bf16(v1[0], v1[1]); w.w = cvt_pk_bf16(v1[2], v1[3]);
                    *(u32x4*)(hb + (size_t)(row0 + ai * HALF + m * 16) * 128) = w; } }
        if (u.pn < 16) {
#pragma unroll
            for (int bj = 0; bj < 2; ++bj) { float mx = 0.f;
#pragma unroll
                for (int ai = 0; ai < 2; ++ai)
#pragma unroll
                    for (int m = 0; m < 4; ++m) { const f32x4 v0 = acc[ai][bj][m][0], v1 = acc[ai][bj][m][1];
                        float ss = (v0[0] * v0[0] + v0[1] * v0[1]) + (v0[2] * v0[2] + v0[3] * v0[3]) + (v1[0] * v1[0] + v1[1] * v1[1]) + (v1[2] * v1[2] + v1[3] * v1[3]);
                        ss += __shfl_xor(ss, 16); ss += __shfl_xor(ss, 32); mx = fmaxf(mx, ss); }
                mx = fmaxf(mx, __shfl_xor(mx, 1)); mx = fmaxf(mx, __shfl_xor(mx, 2)); mx = fmaxf(mx, __shfl_xor(mx, 4)); mx = fmaxf(mx, __shfl_xor(mx, 8));
                if (fr == 0 && fq == 0) atomicMax(norm4 + (2 * u.pn + bj) * 4 + wc, __float_as_uint(mx)); }
        }
    }
};
struct EpiRes {
    static constexpr bool PERM = false, AFTER_DRAIN = false;
    const float* base; float* out; int ldc;
    __device__ __forceinline__ void operator()(const f32x4 (&acc)[2][2][4][2], const Unit& u, int wr, int wc, int fr, int fq) const {
        const int col0 = u.pn * BM + wc * 32 + 4 * fq;
#pragma unroll
        for (int ai = 0; ai < 2; ++ai)
#pragma unroll
            for (int m = 0; m < 4; ++m) { const size_t off = (size_t)(u.pm * BM + ai * HALF + wr * 64 + m * 16 + fr) * ldc + col0;
#pragma unroll
                for (int bj = 0; bj < 2; ++bj)
#pragma unroll
                    for (int n = 0; n < 2; ++n) { const f32x4 bs = *(const f32x4*)(base + off + bj * HALF + n * 16); *(f32x4*)(out + off + bj * HALF + n * 16) = bs + acc[ai][bj][m][n]; }
                if (m & 1) asm volatile("" ::: "memory"); }
    }
};
struct EpiX1 {
    static constexpr bool PERM = false, AFTER_DRAIN = false;
    const float* base; bf16_t* xb; float* ssq; int ldc; const float* ssqa;
    __device__ __forceinline__ void operator()(const f32x4 (&acc)[2][2][4][2], const Unit& u, int wr, int wc, int fr, int fq) const {
        const int col0 = u.pn * BM + wc * 32 + 4 * fq;
#pragma unroll
        for (int ai = 0; ai < 2; ++ai) {
#pragma unroll
            for (int m = 0; m < 4; ++m) { const int row = u.pm * BM + ai * HALF + wr * 64 + m * 16 + fr; const size_t off = (size_t)row * ldc + col0; float s = 0.f; const float ra = rsqrtf(ssqa[row] * (1.0f / 2048.0f) + 1e-6f);
#pragma unroll
                for (int bj = 0; bj < 2; ++bj)
#pragma unroll
                    for (int n = 0; n < 2; ++n) { const f32x4 v = *(const f32x4*)(base + off + bj * HALF + n * 16) + acc[ai][bj][m][n] * ra;
                        u32x2 w; w.x = cvt_pk_bf16(v[0], v[1]); w.y = cvt_pk_bf16(v[2], v[3]); *(u32x2*)(xb + off + bj * HALF + n * 16) = w; s += (v[0] * v[0] + v[1] * v[1]) + (v[2] * v[2] + v[3] * v[3]); }
                s += __shfl_xor(s, 16); s += __shfl_xor(s, 32);
                if (fq == 0) atomicAdd(ssq + row, s); }
            asm volatile("" ::: "memory"); }
    }
};
struct EpiX2 {
    static constexpr bool PERM = false, AFTER_DRAIN = false;
    bf16_t* xb; float* ssq; int ldc;
    __device__ __forceinline__ void operator()(const f32x4 (&acc)[2][2][4][2], const Unit& u, int wr, int wc, int fr, int fq) const {
        const int col0 = u.pn * BM + wc * 32 + 4 * fq;
#pragma unroll
        for (int ai = 0; ai < 2; ++ai) {
#pragma unroll
            for (int m = 0; m < 4; ++m) { const int row = u.pm * BM + ai * HALF + wr * 64 + m * 16 + fr; const size_t off = (size_t)row * ldc + col0; float s = 0.f;
#pragma unroll
                for (int bj = 0; bj < 2; ++bj)
#pragma unroll
                    for (int n = 0; n < 2; ++n) { bf16_t* p = xb + off + bj * HALF + n * 16; const u32x2 r = *(const u32x2*)p; f32x4 v;
                        v[0] = __uint_as_float(r.x << 16); v[1] = __uint_as_float(r.x & 0xffff0000u); v[2] = __uint_as_float(r.y << 16); v[3] = __uint_as_float(r.y & 0xffff0000u); v += acc[ai][bj][m][n];
                        u32x2 w; w.x = cvt_pk_bf16(v[0], v[1]); w.y = cvt_pk_bf16(v[2], v[3]); *(u32x2*)p = w; s += (v[0] * v[0] + v[1] * v[1]) + (v[2] * v[2] + v[3] * v[3]); }
                s += __shfl_xor(s, 16); s += __shfl_xor(s, 32);
                if (fq == 0) atomicAdd(ssq + row, s); }
            asm volatile("" ::: "memory"); }
    }
};
__device__ __forceinline__ float dpp_shr1(float cur, float prev) {
    const int o = __builtin_amdgcn_update_dpp(0, __builtin_bit_cast(int, prev), 0x121, 0xf, 0xf, false);
    return __builtin_bit_cast(float, __builtin_amdgcn_update_dpp(o, __builtin_bit_cast(int, cur), 0x111, 0xf, 0xf, false));
}
__device__ __forceinline__ float dpp_shr2(float cur, float prev) {
    const int o = __builtin_amdgcn_update_dpp(0, __builtin_bit_cast(int, prev), 0x122, 0xf, 0xf, false);
    return __builtin_bit_cast(float, __builtin_amdgcn_update_dpp(o, __builtin_bit_cast(int, cur), 0x112, 0xf, 0xf, false));
}
__device__ __forceinline__ float silu_f(float g) { return g * __builtin_amdgcn_rcpf(1.0f + __builtin_amdgcn_exp2f(-1.4426950408889634f * g)); }
struct EpiGate {
    static constexpr bool PERM = true, AFTER_DRAIN = false;
    bf16_t* ACT; int ldc;
    const float* cw; const float* cb;
    float* GB; float* GF; float* VF;
    const float* ssq;
    const PG8_LAS float* rsL; const PG8_LAS float* cwL; int pm0, pn0, nslot;
    __device__ __forceinline__ void operator()(const f32x4 (&acc)[2][2][4][2], const Unit& u, int wr, int wc, int fr, int fq) const {
        const int c0 = u.pn * HALF + wc * 32 + 8 * fq;
        const int dpn = u.pn - pn0; const bool fast = (u.pm == pm0) && dpn >= 0 && (dpn & 3) == 0 && (dpn >> 2) < nslot;
        f32x4 w0[2], w1[2], w2[2], bb[2];
        if (fast) { const PG8_LAS float* cp = cwL + (dpn >> 2) * 512 + wc * 32 + 8 * fq;
#pragma unroll
            for (int n = 0; n < 2; ++n) { w0[n] = *(const PG8_LAS f32x4*)(cp + 4 * n); w1[n] = *(const PG8_LAS f32x4*)(cp + 128 + 4 * n); w2[n] = *(const PG8_LAS f32x4*)(cp + 256 + 4 * n); bb[n] = *(const PG8_LAS f32x4*)(cp + 384 + 4 * n); }
        } else {
#pragma unroll
            for (int n = 0; n < 2; ++n) { w0[n] = *(const f32x4*)(cw + c0 + 4 * n); w1[n] = *(const f32x4*)(cw + ldc + c0 + 4 * n); w2[n] = *(const f32x4*)(cw + 2 * ldc + c0 + 4 * n); bb[n] = *(const f32x4*)(cb + c0 + 4 * n); }
        }
#pragma unroll
        for (int ai = 0; ai < 2; ++ai) {
            const int g64 = u.pm * 4 + ai * 2 + wr;
            float rs[4];
            if (fast) {
#pragma unroll
                for (int m = 0; m < 4; ++m) rs[m] = rsL[ai * HALF + wr * 64 + m * 16 + fr];
            } else {
#pragma unroll
                for (int m = 0; m < 4; ++m) rs[m] = rsqrtf(ssq[u.pm * BM + ai * HALF + wr * 64 + m * 16 + fr] * (1.0f / 4096.0f) + 1e-6f);
            }
#pragma unroll
            for (int m = 0; m < 4; ++m) {
                const int row = u.pm * BM + ai * HALF + wr * 64 + m * 16 + fr;
                f32x4 a[2];
#pragma unroll
                for (int n = 0; n < 2; ++n)
#pragma unroll
                    for (int j = 0; j < 4; ++j) {
                        const float cur = acc[ai][0][m][n][j] * rs[m], prev = acc[ai][0][m > 0 ? m - 1 : 0][n][j] * rs[m > 0 ? m - 1 : 0];
                        const float s1 = dpp_shr1(cur, prev), s2 = dpp_shr2(cur, prev);
                        const float g = w2[n][j] * cur + w1[n][j] * s1 + w0[n][j] * s2 + bb[n][j];
                        a[n][j] = silu_f(g) * (acc[ai][1][m][n][j] * rs[m]);
                    }
                if (m == 0 && fr < 2) {
                    float* gf = GF + ((size_t)g64 * 2 + fr) * ldc + c0; float* vf = VF + ((size_t)g64 * 2 + fr) * ldc + c0;
                    *(f32x4*)gf = acc[ai][0][0][0] * rs[0]; *(f32x4*)(gf + 4) = acc[ai][0][0][1] * rs[0]; *(f32x4*)vf = acc[ai][1][0][0] * rs[0]; *(f32x4*)(vf + 4) = acc[ai][1][0][1] * rs[0];
                } else {
                    u32x4 w; w.x = cvt_pk_bf16(a[0][0], a[0][1]); w.y = cvt_pk_bf16(a[0][2], a[0][3]); w.z = cvt_pk_bf16(a[1][0], a[1][1]); w.w = cvt_pk_bf16(a[1][2], a[1][3]);
                    *(u32x4*)(ACT + (size_t)row * ldc + c0) = w;
                }
                if (m == 3 && fr >= 14) { float* gb = GB + ((size_t)g64 * 2 + (fr - 14)) * ldc + c0; *(f32x4*)gb = acc[ai][0][3][0] * rs[3]; *(f32x4*)(gb + 4) = acc[ai][0][3][1] * rs[3]; }
            }
        }
    }
};
template <class Epi, class Sched, bool ALIGN_EPI = false, bool SP2 = false>
__device__ __forceinline__ void gemm_phase(PG8_LAS unsigned char* lds, const Gemm g, const Sched& S, const Epi& E, const int tid) {
    const int wid = __builtin_amdgcn_readfirstlane(tid >> 6), lane = tid & 63, wr = wid >> 2, wc = wid & 3, fr = lane & 15, fq = lane >> 4;
    const int K = g.K, nt = K / BK;
    unsigned voffA[2], voffB[2];
#pragma unroll
    for (int i = 0; i < 2; ++i) { int R, C; stage_rc(tid * 16 + i * 8192, R, C); const int Rb = Epi::PERM ? ((R & ~31) + perm32(R & 31)) : R;
        voffA[i] = (unsigned)(R * K + C) * 2u; voffB[i] = (unsigned)(Rb * K + C) * 2u; }
    const size_t kstep = (size_t)(BK * 2);
    const size_t hstep = (size_t)HALF * K * 2;
    const size_t tstep = 2 * hstep;
    const unsigned ldsw = (unsigned)wid * 1024u;
    const int aoff = lds_byte(wr * 64 + fr, fq * 8), boff = lds_byte(wc * 32 + fr, fq * 8);
#define PG8_SA(b, h) (((b) * 2 + (h)) * HTB)
#define PG8_SB(b, h) ((4 + (b) * 2 + (h)) * HTB)
#define PG8_STAGE(bufoff, gbase, voff) do { _Pragma("unroll") for (int _i = 0; _i < 2; ++_i) \
        __builtin_amdgcn_global_load_lds((const unsigned*)((const char*)(gbase) + (voff)[_i]), (PG8_LAS unsigned*)(lds + (bufoff) + ldsw + _i * 8192), 16, 0, 0); } while (0)
#define PG8_LDA(dst, b, h) do { _Pragma("unroll") for (int m = 0; m < 4; ++m) _Pragma("unroll") for (int k = 0; k < 2; ++k) dst[m][k] = *(const PG8_LAS bf16x8*)(lds + PG8_SA(b, h) + aoff + m * 2048 + k * 1024); } while (0)
#define PG8_LDB(dst, b, h) do { _Pragma("unroll") for (int n = 0; n < 2; ++n) _Pragma("unroll") for (int k = 0; k < 2; ++k) dst[n][k] = *(const PG8_LAS bf16x8*)(lds + PG8_SB(b, h) + boff + n * 2048 + k * 1024); } while (0)
#define PG8_MMA(ai, bj, At, Bt) do { __builtin_amdgcn_s_setprio(1); _Pragma("unroll") for (int m = 0; m < 4; ++m) _Pragma("unroll") for (int n = 0; n < 2; ++n) _Pragma("unroll") for (int k = 0; k < 2; ++k) \
        acc[ai][bj][m][n] = __builtin_amdgcn_mfma_f32_16x16x32_bf16(Bt[n][k], At[m][k], acc[ai][bj][m][n], 0, 0, 0); __builtin_amdgcn_s_setprio(0); } while (0)
#define PG8_WAIT_V(n) asm volatile("s_waitcnt vmcnt(" #n ")" ::: "memory")
#define PG8_WAIT_L(n) asm volatile("s_waitcnt lgkmcnt(" #n ")" ::: "memory")
#define PG8_BAR __builtin_amdgcn_s_barrier()
#define PG8_SCHED __builtin_amdgcn_sched_barrier(0)
    Unit cur, nxt; int ui = 0;
    if (!S.next(0, cur)) return;
    f32x4 acc[2][2][4][2];
#pragma unroll
    for (int a = 0; a < 2; ++a)
#pragma unroll
        for (int b = 0; b < 2; ++b)
#pragma unroll
            for (int m = 0; m < 4; ++m)
#pragma unroll
                for (int n = 0; n < 2; ++n) acc[a][b][m][n] = (f32x4){0.f, 0.f, 0.f, 0.f};
    bf16x8 At[4][2], B0[2][2], B1[2][2];
    const char* cA = (const char*)g.A + (size_t)cur.pm * tstep; const char* cB = (const char*)g.Bt + (size_t)cur.pn * tstep;
    S.a_ready(cur);
    if constexpr (SP2) {
        PG8_STAGE(PG8_SB(0, 0), cB, voffB); PG8_STAGE(PG8_SB(0, 1), cB + hstep, voffB); PG8_STAGE(PG8_SA(0, 0), cA, voffA); PG8_STAGE(PG8_SA(0, 1), cA + hstep, voffA);
        if (wr == 1) PG8_BAR;
        PG8_WAIT_V(2); PG8_BAR;
        PG8_STAGE(PG8_SB(1, 0), cB + kstep, voffB); PG8_STAGE(PG8_SA(1, 0), cA + kstep, voffA); PG8_STAGE(PG8_SB(1, 1), cB + hstep + kstep, voffB);
        PG8_WAIT_V(6); PG8_BAR;
    } else {
        PG8_STAGE(PG8_SB(0, 0), cB, voffB); PG8_STAGE(PG8_SA(0, 0), cA, voffA); PG8_STAGE(PG8_SB(0, 1), cB + hstep, voffB); PG8_STAGE(PG8_SA(0, 1), cA + hstep, voffA);
        if (wr == 1) PG8_BAR;
        PG8_WAIT_V(4); PG8_BAR;
        PG8_STAGE(PG8_SB(1, 0), cB + kstep, voffB); PG8_STAGE(PG8_SA(1, 0), cA + kstep, voffA); PG8_STAGE(PG8_SB(1, 1), cB + hstep + kstep, voffB);
        PG8_WAIT_V(6); PG8_BAR;
    }
    for (;;) {
        const bool has_next = S.next(ui + 1, nxt);
        const char* nA = has_next ? (const char*)g.A + (size_t)nxt.pm * tstep : cA; const char* nB = has_next ? (const char*)g.Bt + (size_t)nxt.pn * tstep : cB;
        for (int t = 0; t < nt; t += 2) {
            const bool last = (t == nt - 2);
            const char* a1 = cA + (size_t)(t + 1) * kstep;
            const char* a2 = last ? nA : cA + (size_t)(t + 2) * kstep; const char* b2 = last ? nB : cB + (size_t)(t + 2) * kstep;
            const char* a3 = a2 + kstep; const char* b3 = b2 + kstep;
            if (last && has_next) S.a_ready(nxt);
            if constexpr (SP2) {
            PG8_LDB(B0, 0, 0); PG8_LDB(B1, 0, 1); PG8_SCHED; PG8_LDA(At, 0, 0); PG8_STAGE(PG8_SA(1, 1), a1 + hstep, voffA);
            PG8_WAIT_V(8); PG8_WAIT_L(0); PG8_BAR; PG8_MMA(0, 0, At, B0); PG8_MMA(0, 1, At, B1); PG8_BAR; PG8_SCHED;
            PG8_LDA(At, 0, 1); PG8_STAGE(PG8_SB(0, 0), b2, voffB); PG8_STAGE(PG8_SB(0, 1), b2 + hstep, voffB); PG8_STAGE(PG8_SA(0, 0), a2, voffA);
            PG8_WAIT_V(8); PG8_WAIT_L(0); PG8_BAR; PG8_MMA(1, 0, At, B0); PG8_MMA(1, 1, At, B1); PG8_BAR; PG8_SCHED;
            PG8_LDB(B0, 1, 0); PG8_LDB(B1, 1, 1); PG8_SCHED; PG8_LDA(At, 1, 0); PG8_STAGE(PG8_SA(0, 1), a2 + hstep, voffA);
            PG8_WAIT_V(8); PG8_WAIT_L(0); PG8_BAR; PG8_MMA(0, 0, At, B0); PG8_MMA(0, 1, At, B1); PG8_BAR; PG8_SCHED;
            PG8_LDA(At, 1, 1); PG8_STAGE(PG8_SB(1, 0), b3, voffB); PG8_STAGE(PG8_SB(1, 1), b3 + hstep, voffB); PG8_STAGE(PG8_SA(1, 0), a3, voffA);
            PG8_WAIT_V(8); PG8_WAIT_L(0); PG8_BAR; PG8_MMA(1, 0, At, B0); PG8_MMA(1, 1, At, B1); PG8_BAR; PG8_SCHED;
            } else {
            PG8_LDB(B0, 0, 0); PG8_SCHED; PG8_LDA(At, 0, 0); PG8_STAGE(PG8_SA(1, 1), a1 + hstep, voffA);
            PG8_WAIT_L(8); PG8_BAR; PG8_WAIT_L(0); PG8_MMA(0, 0, At, B0); PG8_BAR; PG8_SCHED;
            PG8_LDB(B1, 0, 1); PG8_STAGE(PG8_SB(0, 0), b2, voffB);
            PG8_BAR; PG8_WAIT_L(0); PG8_MMA(0, 1, At, B1); PG8_BAR;
            PG8_LDA(At, 0, 1); PG8_STAGE(PG8_SA(0, 0), a2, voffA);
            PG8_BAR; PG8_WAIT_L(0); PG8_MMA(1, 0, At, B0); PG8_BAR; PG8_SCHED;
            PG8_STAGE(PG8_SB(0, 1), b2 + hstep, voffB);
            PG8_WAIT_V(6); PG8_BAR; PG8_MMA(1, 1, At, B1); PG8_BAR;
            PG8_LDB(B0, 1, 0); PG8_SCHED; PG8_LDA(At, 1, 0); PG8_STAGE(PG8_SA(0, 1), a2 + hstep, voffA);
            PG8_WAIT_L(8); PG8_BAR; PG8_WAIT_L(0); PG8_MMA(0, 0, At, B0); PG8_BAR; PG8_SCHED;
            PG8_LDB(B1, 1, 1); PG8_STAGE(PG8_SB(1, 0), b3, voffB);
            PG8_BAR; PG8_WAIT_L(0); PG8_MMA(0, 1, At, B1); PG8_BAR;
            PG8_LDA(At, 1, 1); PG8_STAGE(PG8_SA(1, 0), a3, voffA);
            PG8_BAR; PG8_WAIT_L(0); PG8_MMA(1, 0, At, B0); PG8_BAR; PG8_SCHED;
            PG8_STAGE(PG8_SB(1, 1), b3 + hstep, voffB);
            PG8_WAIT_V(6); PG8_BAR; PG8_MMA(1, 1, At, B1); PG8_BAR;
            }
        }
        if constexpr (ALIGN_EPI) { if (wr == 0) PG8_BAR; }
        if constexpr (!Epi::AFTER_DRAIN) { E(acc, cur, wr, wc, fr, fq); S.done(cur); }
        if (!has_next) break;
#pragma unroll
        for (int a = 0; a < 2; ++a)
#pragma unroll
            for (int b = 0; b < 2; ++b)
#pragma unroll
                for (int m = 0; m < 4; ++m)
#pragma unroll
                    for (int n = 0; n < 2; ++n) acc[a][b][m][n] = (f32x4){0.f, 0.f, 0.f, 0.f};
        cur = nxt; cA = nA; cB = nB; ++ui;
        if constexpr (ALIGN_EPI) { if (wr == 1) PG8_BAR; }
    }
    PG8_WAIT_V(0);
    if constexpr (!ALIGN_EPI) { if (wr == 0) PG8_BAR; }
    PG8_BAR;
    if constexpr (Epi::AFTER_DRAIN) { E.fused(acc, cur, wr, wc, fr, fq, lds, wid, lane); S.done(cur); }
#undef PG8_SA
#undef PG8_SB
#undef PG8_STAGE
#undef PG8_LDA
#undef PG8_LDB
#undef PG8_MMA
#undef PG8_WAIT_V
#undef PG8_WAIT_L
#undef PG8_BAR
#undef PG8_SCHED
}
}
namespace att {
typedef unsigned short bf16_t;
typedef short bf16x8 __attribute__((ext_vector_type(8)));
typedef short s16x4 __attribute__((ext_vector_type(4)));
typedef float f32x16 __attribute__((ext_vector_type(16)));
typedef float f32x4 __attribute__((ext_vector_type(4)));
typedef unsigned u32x4 __attribute__((ext_vector_type(4)));
constexpr int D = 128;
constexpr float SCALE = 0.08838834764831845f;
constexpr float THR = 8.f;
constexpr int NW = 8, QBLK = 32, KVBLK = 64, QB = NW * QBLK;
constexpr int SHM_V = KVBLK * D * 2, SHM_K = KVBLK * D * 2;
constexpr int LDS_TILES = 2 * SHM_V + 2 * SHM_K + NW * 64 * 4;
constexpr int LDS_BIAS = LDS_TILES;
constexpr int LDS_DTAB = LDS_BIAS + 32768 + 2048;
constexpr int DTAB_STRIDE = 132 * 4, DTAB_BYTES = 48 * DTAB_STRIDE;
constexpr int LDS_END = LDS_DTAB + DTAB_BYTES + 2048;
constexpr int DILW = 129;

#define KSWZ(row, colB) ((row) * 256 + ((colB) ^ (((row) & 7) << 4)))
#define SBAR() __builtin_amdgcn_sched_barrier(0)
__device__ __forceinline__ int v_st(int k, int c) { const int kk = (k & ~0xC) | ((k & 4) << 1) | ((k & 8) >> 1); return ((kk >> 3) * 4 + (c >> 5)) * 512 + ((kk & 7) * 32 + (c & 31)) * 2; }
__device__ __forceinline__ int v_rd_base(int lane) { return ((lane & 3) << 3) | (((lane >> 2) & 3) << 6) | (((lane >> 4) & 1) << 5) | (((lane >> 5) & 1) << 8); }
constexpr int v_rd_off(int d0, int ks, int half) { return d0 * 512 + ks * 4096 + half * 2048; }
__device__ __forceinline__ int crow(int r, int hi) { return (r & 3) + 8 * (r >> 2) + 4 * hi; }
__device__ __forceinline__ unsigned cvtpk(float lo, float hi) { unsigned r; asm volatile("v_cvt_pk_bf16_f32 %0, %1, %2" : "=v"(r) : "v"(lo), "v"(hi)); return r; }
__device__ __forceinline__ bf16x8 gld8(const void* ubase, unsigned voff) { return *reinterpret_cast<const bf16x8*>((const char*)ubase + voff); }
__device__ __forceinline__ void mask_tile(f32x16& p0, f32x16& p1, int dq, unsigned W) {
    const float NEG = -__builtin_inff();
#pragma unroll
    for (int r = 0; r < 16; ++r) {
        const int c = (r & 3) + 8 * (r >> 2);
        if ((unsigned)(dq - c) >= W) p0[r] = NEG;
        if ((unsigned)(dq - c - 32) >= W) p1[r] = NEG;
    }
}
__device__ __forceinline__ void partialSM(f32x16& p0, f32x16& p1, float& m_reg, float& mn, float& alpha) {
    float pmax = p0[0]; for (int r = 1; r < 16; ++r) pmax = fmaxf(pmax, p0[r]); for (int r = 0; r < 16; ++r) pmax = fmaxf(pmax, p1[r]);
    { auto rr = __builtin_amdgcn_permlane32_swap(__float_as_uint(pmax), __float_as_uint(pmax), false, false);
      pmax = fmaxf(__uint_as_float(rr[0]), __uint_as_float(rr[1])); }
    constexpr float C2 = 1.4426950408889634f * SCALE;
    if (__builtin_expect(__all((pmax - m_reg) * SCALE <= THR), 1)) { mn = m_reg; alpha = 1.f; }
    else { mn = fmaxf(m_reg, pmax); alpha = __builtin_amdgcn_exp2f((m_reg - mn) * C2); m_reg = mn; }
    const float mnL = -mn * C2;
    for (int r = 0; r < 16; ++r) p0[r] = fmaf(p0[r], C2, mnL); for (int r = 0; r < 16; ++r) p1[r] = fmaf(p1[r], C2, mnL);
    for (int r = 0; r < 16; ++r) p0[r] = __builtin_amdgcn_exp2f(p0[r]);
}
__device__ __forceinline__ void finishSM(f32x16& p0, f32x16& p1, float alpha, float& l_reg, bf16x8& pa0, bf16x8& pa1, bf16x8& pa2, bf16x8& pa3) {
    for (int r = 0; r < 16; ++r) p1[r] = __builtin_amdgcn_exp2f(p1[r]);
    float ps = 0; for (int r = 0; r < 16; ++r) ps += p0[r]; for (int r = 0; r < 16; ++r) ps += p1[r];
    { auto rr = __builtin_amdgcn_permlane32_swap(__float_as_uint(ps), __float_as_uint(ps), false, false);
      ps = __uint_as_float(rr[0]) + __uint_as_float(rr[1]); }
    l_reg = l_reg * alpha + ps;
#define PK4(P, B_, OUT) do { unsigned a0 = cvtpk(P[B_+0], P[B_+1]), a1 = cvtpk(P[B_+2], P[B_+3]);                          \
        unsigned b0 = cvtpk(P[B_+4], P[B_+5]), b1 = cvtpk(P[B_+6], P[B_+7]);                                             \
        auto r0 = __builtin_amdgcn_permlane32_swap(a0, b0, false, false); auto r1 = __builtin_amdgcn_permlane32_swap(a1, b1, false, false); \
        u32x4 w = {r0[0], r1[0], r0[1], r1[1]}; OUT = *reinterpret_cast<bf16x8*>(&w); } while (0)
    PK4(p0, 0, pa0); PK4(p0, 8, pa1); PK4(p1, 0, pa2); PK4(p1, 8, pa3);
#undef PK4
}
template <int KB, int MODE>
__device__ __forceinline__ void qkt(f32x16& p0, f32x16& p1, const char* K_lds, int r32, int hi, const bf16x8* qr, bool act, const char* bptr, int dq) {
    constexpr bool SK = MODE == 1;
    const float NEG = -__builtin_inff();
    if (SK && !act) {
#pragma unroll
        for (int r = 0; r < 16; ++r) { p0[r] = NEG; p1[r] = NEG; } return; }
    if (MODE == 0) {
#pragma unroll
        for (int g = 0; g < 4; ++g) { const f32x4 v0 = *(const f32x4*)(bptr + 32 * g), v1 = *(const f32x4*)(bptr + 128 + 32 * g);
#pragma unroll
            for (int j = 0; j < 4; ++j) { p0[4 * g + j] = v0[j]; p1[4 * g + j] = v1[j]; } }
    } else {
#pragma unroll
        for (int r = 0; r < 16; ++r) { const int c = (r & 3) + 8 * (r >> 2);
            const float b0 = *(const float*)(bptr + 4 * c), b1 = *(const float*)(bptr + 4 * c + 128);
            p0[r] = ((unsigned)(dq - c) < (unsigned)DILW) ? b0 : NEG; p1[r] = ((unsigned)(dq - c - 32) < (unsigned)DILW) ? b1 : NEG; }
    }
    const char* kb[4];
#pragma unroll
    for (int dd = 0; dd < 4; ++dd) kb[dd] = K_lds + KB * SHM_K + KSWZ(r32, (dd * 16 + hi * 8) * 2);
#pragma unroll
    for (int d0 = 0; d0 < 8; ++d0) { const char* a = kb[d0 & 3] + (d0 >> 2) * 128;
        bf16x8 b0 = *reinterpret_cast<const bf16x8*>(a);
        bf16x8 b1 = *reinterpret_cast<const bf16x8*>(a + 32 * 256);
        p0 = __builtin_amdgcn_mfma_f32_32x32x16_bf16(b0, qr[d0], p0, 0, 0, 0);
        p1 = __builtin_amdgcn_mfma_f32_32x32x16_bf16(b1, qr[d0], p1, 0, 0, 0); }
}
template <int VB, bool SK>
__device__ __forceinline__ void pv_tile(f32x16* o, int vb0, bf16x8 pa0, bf16x8 pa1, bf16x8 pa2, bf16x8 pa3, bool act) {
    if (SK && !act) return;
#define TRRD(dst, off) asm volatile("ds_read_b64_tr_b16 %0, %1 offset:%2" : "=&v"(dst) : "v"(vb0), "i"(off) : "memory")
#define PV_D0(d0) do { s16x4 l0, l1, l2, l3, h0, h1, h2, h3; constexpr int b_ = VB * SHM_V + v_rd_off(d0, 0, 0);  \
        TRRD(l0, b_); TRRD(h0, b_ + 2048); TRRD(l1, b_ + 4096); TRRD(h1, b_ + 6144); TRRD(l2, b_ + 8192); TRRD(h2, b_ + 10240); TRRD(l3, b_ + 12288); TRRD(h3, b_ + 14336); \
        asm volatile("s_waitcnt lgkmcnt(0)" ::: "memory"); SBAR();   \
        o[d0] = __builtin_amdgcn_mfma_f32_32x32x16_bf16(pa0, (bf16x8){l0[0], l0[1], l0[2], l0[3], h0[0], h0[1], h0[2], h0[3]}, o[d0], 0, 0, 0);   \
        o[d0] = __builtin_amdgcn_mfma_f32_32x32x16_bf16(pa1, (bf16x8){l1[0], l1[1], l1[2], l1[3], h1[0], h1[1], h1[2], h1[3]}, o[d0], 0, 0, 0);   \
        o[d0] = __builtin_amdgcn_mfma_f32_32x32x16_bf16(pa2, (bf16x8){l2[0], l2[1], l2[2], l2[3], h2[0], h2[1], h2[2], h2[3]}, o[d0], 0, 0, 0);   \
        o[d0] = __builtin_amdgcn_mfma_f32_32x32x16_bf16(pa3, (bf16x8){l3[0], l3[1], l3[2], l3[3], h3[0], h3[1], h3[2], h3[3]}, o[d0], 0, 0, 0); } while (0)
    PV_D0(0); PV_D0(1); PV_D0(2); PV_D0(3);
#undef PV_D0
#undef TRRD
}

struct BlockRef { const bf16_t* Q; const bf16_t* K; const bf16_t* V; bf16_t* O; float* lse; const float* gb; int P0, rs, os, ls, jlo, tab; };
struct Seam { bf16x8 qr[8]; bf16x8 st_v0, st_v1, st_k0, st_k1; };
#define ROWP(p, rs_, k0, rr) ((p) + (size_t)((k0) + (rr)) * (rs_) + sc)
#define VMW() asm volatile("s_waitcnt vmcnt(0)" ::: "memory")
#define VMWN(n) asm volatile("s_waitcnt vmcnt(%0)" :: "i"(n) : "memory")
#define SLOAD_H(Kp, Vp, rs_, k0, vo) do { const char* kb_ = (const char*)((Kp) + (size_t)(k0) * (rs_)); const char* vb_ = (const char*)((Vp) + (size_t)(k0) * (rs_)); const size_t h_ = (size_t)64 * (rs_); \
                         S.st_v0 = gld8(vb_, vo); S.st_v1 = gld8(vb_ + h_, vo); S.st_k0 = gld8(kb_, vo); S.st_k1 = gld8(kb_ + h_, vo); } while (0)
#define SWRITE_HK(bf) do { *(bf16x8*)(K_lds + (bf) * SHM_K + kws) = S.st_k0; *(bf16x8*)(K_lds + (bf) * SHM_K + kws + 32 * 256) = S.st_k1; } while (0)
#define SWRITE_HV(bf) do { *(bf16x8*)(V_lds + (bf) * SHM_V + vst0) = S.st_v0; *(bf16x8*)(V_lds + (bf) * SHM_V + vst1) = S.st_v1; } while (0)
#define SWRITE_H(bf) do { SWRITE_HV(bf); SWRITE_HK(bf); } while (0)
__device__ __forceinline__ void attn_prime(const BlockRef& cur, char* lds, Seam& S, const int tid) {
    const int wid = __builtin_amdgcn_readfirstlane(tid >> 6), lane = tid & 63, r32 = lane & 31, hi = lane >> 5;
    const int sr = tid >> 4, sc = (tid & 15) * 8, kws = KSWZ(sr, sc * 2); char* K_lds = lds + 2 * SHM_V;
    const int kb0 = cur.jlo * KVBLK;
    { const char* qb_ = (const char*)(cur.Q + (size_t)(wid * QBLK) * cur.rs); const unsigned qv_ = (unsigned)(r32 * cur.rs + hi * 8) * 2u;
      for (int d0 = 0; d0 < 8; ++d0) S.qr[d0] = gld8(qb_ + d0 * 32, qv_); }
    { const unsigned vo_ = (unsigned)(sr * cur.rs + sc) * 2u; SLOAD_H(cur.K, cur.V, cur.rs, kb0, vo_); } VMW(); SWRITE_HK(0);
    __syncthreads();
}
template <int MODE>
__device__ __forceinline__ void attn_block(const BlockRef& cur, const BlockRef& nxt, char* lds, Seam& S, const int tid) {
    constexpr bool SK = MODE == 1;
    constexpr int W = MODE == 1 ? DILW : (1 << 30);
    const int wid = __builtin_amdgcn_readfirstlane(tid >> 6), lane = tid & 63, r32 = lane & 31, hi = lane >> 5;
    const int j_lo = cur.jlo;
    const int j_hi = (cur.P0 + QB - 1) / KVBLK + 1;
    const int NT = j_hi - j_lo;
    const int kbn = nxt.jlo * KVBLK;
    const int qlo = cur.P0 + wid * QBLK, qm = qlo + r32 - 4 * hi;
    char* V_lds = lds; char* K_lds = lds + 2 * SHM_V;
    float* ws = (float*)(lds + 2 * SHM_V + 2 * SHM_K) + wid * 64; float* li_l = ws, * al_l = ws + 32;
    float m_reg = -1e30f, l_reg = 0; f32x16 o[4] = {};
    const int sr = tid >> 4, sc = (tid & 15) * 8, vst0 = v_st(sr, sc), vst1 = v_st(32 + sr, sc), kws = KSWZ(sr, sc * 2);
    const int vb0 = (int)(uintptr_t)V_lds + v_rd_base(lane);
    const bf16_t* Kh = cur.K; const bf16_t* Vh = cur.V; const int rs = cur.rs; const unsigned kvo = (unsigned)(sr * rs + sc) * 2u;
    const char* bb0 = (MODE == 0) ? (lds + LDS_BIAS + hi * 16) : (lds + cur.tab + (128 - qm) * 4);
#define RESC(a) do { if (__any((a) < 1.f)) { if (hi == 0) al_l[r32] = (a); asm volatile("s_waitcnt lgkmcnt(0)" ::: "memory");              \
                     for (int d_ = 0; d_ < 4; ++d_) for (int r = 0; r < 16; ++r) o[d_][r] *= al_l[crow(r, hi)]; } } while (0)
#define KBASE(t) ((j_lo + (t)) * KVBLK)
#define ACT(t) (KBASE(t) <= qlo + QBLK - 1 && KBASE(t) + KVBLK - 1 >= qlo - W + 1)
#define MASKT(P0_, P1_, t) do { if (MODE == 0) { const int kb_ = KBASE(t); if (kb_ + KVBLK - 1 > qlo) mask_tile(P0_, P1_, qm - kb_, (unsigned)W); } } while (0)
#define QKT(KB, PX0, PX1, t) qkt<KB, MODE>(PX0, PX1, K_lds, r32, hi, S.qr, ACT(t), bb0 + KBASE(t) * 4, qm - KBASE(t))
#define PSM(PX0, PX1, mnX, alX, t) do { if (!SK || ACT(t)) partialSM(PX0, PX1, m_reg, mnX, alX); else { mnX = m_reg; alX = 1.f; } } while (0)
#define FSM(PY0, PY1, alY, t) do { if (!SK || ACT(t)) finishSM(PY0, PY1, alY, l_reg, pa0, pa1, pa2, pa3); } while (0)
    constexpr int NQL = 8;
#define SEAM_K0() do { VMWN(NQL); SWRITE_HK(0); SBAR(); } while (0)
    f32x16 pA0, pA1, pB0, pB1; float mnA, mnB, alA, alB; bf16x8 pa0, pa1, pa2, pa3;
    SWRITE_HV(0); SBAR();
    if (NT > 1) { SLOAD_H(Kh, Vh, rs, KBASE(1), kvo); }
    SBAR(); QKT(0, pA0, pA1, 0);
    MASKT(pA0, pA1, 0); PSM(pA0, pA1, mnA, alA, 0);
    if (NT > 1) { VMW(); SWRITE_H(1); }
    __syncthreads();
#define HALF_STEP(PX0, PX1, mnX, alX, PY0, PY1, alY, t, KB, VB, SB) do {                                                      \
        SBAR(); QKT(KB, PX0, PX1, t);                                             \
        FSM(PY0, PY1, alY, (t) - 1); SBAR();                                                           \
        if ((t) + 1 < NT) { SLOAD_H(Kh, Vh, rs, KBASE((t) + 1), kvo); SBAR(); }                                               \
        pv_tile<VB, SK>(o, vb0, pa0, pa1, pa2, pa3, ACT((t) - 1)); MASKT(PX0, PX1, (t)); PSM(PX0, PX1, mnX, alX, (t));                                        \
        __syncthreads();                                                                                                      \
        if ((t) + 1 < NT) { VMW(); SWRITE_H(SB); }                                                                          \
        RESC(alX); __syncthreads(); } while (0)
    for (int t = 1; t + 1 < NT; t += 2) {
        HALF_STEP(pB0, pB1, mnB, alB, pA0, pA1, alA, t, 1, 0, 0);
        HALF_STEP(pA0, pA1, mnA, alA, pB0, pB1, alB, t + 1, 0, 1, 1);
    }
    const bool even = (NT & 1) == 0;
    if (even) { SBAR(); QKT(1, pB0, pB1, NT - 1); SBAR(); }
    { const unsigned vo_ = (unsigned)(sr * nxt.rs + sc) * 2u; SLOAD_H(nxt.K, nxt.V, nxt.rs, kbn, vo_); } SBAR();
    { const char* qb_ = (const char*)(nxt.Q + (size_t)(wid * QBLK) * nxt.rs); const unsigned qv_ = (unsigned)(r32 * nxt.rs + hi * 8) * 2u;
#pragma unroll
      for (int d0 = 0; d0 < 8; ++d0) S.qr[d0] = gld8(qb_ + d0 * 32, qv_); }
    SBAR();
    FSM(pA0, pA1, alA, (even ? NT - 2 : NT - 1)); SBAR();
    pv_tile<0, SK>(o, vb0, pa0, pa1, pa2, pa3, ACT(even ? NT - 2 : NT - 1));
    if (even) { MASKT(pB0, pB1, NT - 1); PSM(pB0, pB1, mnB, alB, NT - 1); __syncthreads(); RESC(alB);
        FSM(pB0, pB1, alB, NT - 1); SBAR(); pv_tile<1, SK>(o, vb0, pa0, pa1, pa2, pa3, ACT(NT - 1)); }
    SBAR(); SEAM_K0();
    if (hi == 0) li_l[r32] = l_reg; asm volatile("s_waitcnt lgkmcnt(0)" ::: "memory");
    float rli[16];
#pragma unroll
    for (int r = 0; r < 16; ++r) rli[r] = __builtin_amdgcn_rcpf(li_l[crow(r, hi)]);
    int os_ = __builtin_amdgcn_readfirstlane(cur.os); asm volatile("" : "+s"(os_));
    bf16_t* Ow = cur.O + (size_t)(wid * QBLK) * os_; const unsigned ovo = (unsigned)(4 * hi * os_ + r32) * 2u;
#pragma unroll
    for (int r = 0; r < 16; ++r) { char* ob_ = (char*)(Ow + (size_t)((r & 3) + 8 * (r >> 2)) * os_);
#pragma unroll
        for (int d0 = 0; d0 < 4; ++d0) { const float v = o[d0][r] * rli[r];
            const float vn = __shfl_xor(v, 1);
            if ((r32 & 1) == 0) *(unsigned*)(ob_ + d0 * 64 + ovo) = cvtpk(v, vn); } }
    if (MODE == 0) {
#pragma unroll
        for (int r = 0; r < 16; ++r) { float ss = 0.f;
#pragma unroll
            for (int d0 = 0; d0 < 4; ++d0) { const float v = o[d0][r] * rli[r]; ss += v * v; }
            ss += __shfl_xor(ss, 1); ss += __shfl_xor(ss, 2); ss += __shfl_xor(ss, 4); ss += __shfl_xor(ss, 8); ss += __shfl_xor(ss, 16);
            if (r32 == 0) atomicAdd(cur.lse + (wid * QBLK + crow(r, hi)), ss); }
    }
    if (MODE == 1) { constexpr float C2 = 1.4426950408889634f * SCALE;
        if (hi == 0) cur.lse[(size_t)(wid * QBLK + r32) * cur.ls] = m_reg * C2 + __builtin_amdgcn_logf(l_reg); }
    __syncthreads();
#undef RESC
#undef KBASE
#undef ACT
#undef MASKT
#undef QKT
#undef PSM
#undef FSM
#undef SEAM_K0
#undef HALF_STEP
}
#undef ROWP
#undef VMW
#undef VMWN
#undef SLOAD_H
#undef SWRITE_HK
#undef SWRITE_HV
#undef SWRITE_H
#undef KSWZ
#undef SBAR
}
constexpr int SEQ = 8192, DM = 4096, NH = 16, HD = 128, FW = 2048, NQKV = 12288, INW = 12304, DFF = 11008, NUP = 22016;
constexpr float RMS_EPS = 1e-6f;
constexpr float INV_SCALE = 11.313708498984761f;
constexpr int NWAVES = 8;
constexpr size_t MiB = 1u << 20;
constexpr size_t WS_WIN = 0, WS_WF = 96 * MiB, WS_WOUT = 97 * MiB, WS_WUP = 129 * MiB, WS_WDN = 301 * MiB, WS_XN = 387 * MiB, WS_X1 = 453 * MiB, WS_ACT = 581 * MiB;
constexpr size_t WS_MISC = 753 * MiB, WS_CTL = WS_MISC + 3 * MiB, CTL_NORM = 64, CTL_SSQ = 4096, CTL_SSQ2 = 4096 + 32768, CTL_BAR = 4096 + 2 * 32768, CTL_SSQA = CTL_BAR + 16384, CTL_BYTES = CTL_SSQA + 32768;
constexpr size_t WS_LOGF = WS_MISC, WS_CNEG = WS_MISC + 1 * MiB, WS_TAB = WS_MISC + 2 * MiB, WS_GB = WS_MISC + 4 * MiB, WS_GF = WS_MISC + 16 * MiB, WS_VF = WS_MISC + 28 * MiB;
constexpr size_t WS_QKV = 817 * MiB, WS_OA = WS_QKV + 192 * MiB, WS_OB = WS_OA + 32 * MiB, WS_LSE = WS_OB + 96 * MiB, WS_MIX = WS_LSE + 2 * MiB, WS_END = WS_MIX + 64 * MiB;
static_assert((size_t)(SEQ / 64) * 2 * DFF * 4 <= 12 * MiB, "side buffers");
constexpr int EPI_SLOTS = 11;
constexpr int LDS_BYTES = 131072 + 1024 + EPI_SLOTS * 2048 + 1024;
static_assert(att::LDS_END <= 131072 + 8192, "attention LDS");
static_assert(8 * 16640 <= LDS_BYTES, "P0 transpose scratch");

#define LAS __attribute__((address_space(3)))
typedef unsigned short bf16;
typedef unsigned v4u __attribute__((ext_vector_type(4)));
typedef unsigned v2u __attribute__((ext_vector_type(2)));
typedef float f32x4 __attribute__((ext_vector_type(4)));
typedef short bf16x8 __attribute__((ext_vector_type(8)));
#define LDS_WAIT() asm volatile("s_waitcnt lgkmcnt(0)" ::: "memory")
__device__ __forceinline__ unsigned pk2(float lo, float hi) { unsigned r; asm volatile("v_cvt_pk_bf16_f32 %0, %1, %2" : "=v"(r) : "v"(lo), "v"(hi)); return r; }
__device__ __forceinline__ float bflo(unsigned u) { return __uint_as_float(u << 16); }
__device__ __forceinline__ float bfhi(unsigned u) { return __uint_as_float(u & 0xffff0000u); }
__device__ __forceinline__ float wave_sum(float v) {
#pragma unroll
    for (int o = 1; o < 64; o <<= 1) v += __shfl_xor(v, o);
    return v;
}
typedef float f32x2 __attribute__((ext_vector_type(2)));
__device__ __forceinline__ void tr_item(const float* W, size_t ldw, int Kdim, bf16* WT, LAS float* scr, int k0, int lane, const float* gk = nullptr) {
    const float* wp = W + (size_t)(k0 + (lane >> 5)) * ldw + 2 * (lane & 31); f32x2 v[32];
#pragma unroll
    for (int i = 0; i < 32; ++i) v[i] = *(const f32x2*)(wp + (size_t)(2 * i) * ldw);
#pragma unroll
    for (int i = 0; i < 32; ++i) { LAS float* d = scr + (2 * i + (lane >> 5)) * 65 + 2 * (lane & 31); d[0] = v[i].x; d[1] = v[i].y; }
    const int c = lane & 7;
    f32x4 g0 = {1.f, 1.f, 1.f, 1.f}, g1 = g0; if (gk) { g0 = *(const f32x4*)(gk + k0 + 8 * c); g1 = *(const f32x4*)(gk + k0 + 8 * c + 4); }
    LDS_WAIT(); asm volatile("" ::: "memory");
#pragma unroll
    for (int j = 0; j < 8; ++j) { const int n = (lane >> 3) + 8 * j; const LAS float* s = scr + (8 * c) * 65 + n;
        v4u o; o.x = pk2(s[0 * 65] * g0.x, s[1 * 65] * g0.y); o.y = pk2(s[2 * 65] * g0.z, s[3 * 65] * g0.w); o.z = pk2(s[4 * 65] * g1.x, s[5 * 65] * g1.y); o.w = pk2(s[6 * 65] * g1.z, s[7 * 65] * g1.w);
        *(v4u*)(WT + (size_t)n * Kdim + k0 + 8 * c) = o; }
    LDS_WAIT(); asm volatile("" ::: "memory");
}
__device__ __forceinline__ void rms_row_bf16(const float* xrow, const float* g, bf16* orow, int lane) {
    const f32x4* xr = (const f32x4*)xrow + lane; f32x4 v[16]; float s = 0.f;
#pragma unroll
    for (int j = 0; j < 16; ++j) { v[j] = xr[64 * j]; s += (v[j].x * v[j].x + v[j].y * v[j].y) + (v[j].z * v[j].z + v[j].w * v[j].w); }
    const float r = rsqrtf(wave_sum(s) * (1.f / DM) + RMS_EPS);
    const f32x4* gr = (const f32x4*)g + lane; v2u* o8 = (v2u*)orow + lane;
#pragma unroll
    for (int j = 0; j < 16; ++j) { const f32x4 gg = gr[64 * j]; v2u w; w.x = pk2(v[j].x * r * gg.x, v[j].y * r * gg.y); w.y = pk2(v[j].z * r * gg.z, v[j].w * r * gg.w); o8[64 * j] = w; }
}
__device__ __forceinline__ void rms_row_f32(const float* xrow, const float* g, float* orow, int lane) {
    const f32x4* xr = (const f32x4*)xrow + lane; f32x4 v[16]; float s = 0.f;
#pragma unroll
    for (int j = 0; j < 16; ++j) { v[j] = xr[64 * j]; s += (v[j].x * v[j].x + v[j].y * v[j].y) + (v[j].z * v[j].z + v[j].w * v[j].w); }
    const float r = rsqrtf(wave_sum(s) * (1.f / DM) + RMS_EPS);
    const f32x4* gr = (const f32x4*)g + lane; f32x4* o = (f32x4*)orow + lane;
#pragma unroll
    for (int j = 0; j < 16; ++j) { const f32x4 gg = gr[64 * j]; o[64 * j] = v[j] * r * gg; }
}
__device__ __forceinline__ int t5_bucket(int dist) {
    if (dist < 16) return dist;
    const float df = (float)dist;
    int large = 16 + (int)(logf(df / 16.0f) / 4.852030263919617f * 16.0f);
    return large < 31 ? large : 31;
}

__device__ __forceinline__ int lane_id_v() { int l; asm volatile("v_mbcnt_lo_u32_b32 %0, -1, 0\n\tv_mbcnt_hi_u32_b32 %0, -1, %0" : "=v"(l)); return l; }
#define XB_CEN(j)  (64 * (j))
#define XB_ARR(j)  (64 * (16 + (j)))
#define XB_REL(j)  (64 * (32 + (j)))
#define XB_TOP     (64 * 48)
#define XB_TOPGEN  (64 * 49)
#define XB_WORDS   (64 * 50)
__device__ __forceinline__ unsigned xb_ld(unsigned* p) { return __hip_atomic_load(p, __ATOMIC_RELAXED, __HIP_MEMORY_SCOPE_AGENT); }
__device__ __forceinline__ unsigned xb_add(unsigned* p, unsigned v) { return __hip_atomic_fetch_add(p, v, __ATOMIC_RELAXED, __HIP_MEMORY_SCOPE_AGENT); }
__device__ __forceinline__ void xb_st(unsigned* p, unsigned v) { __hip_atomic_store(p, v, __ATOMIC_RELAXED, __HIP_MEMORY_SCOPE_AGENT); }
__device__ __forceinline__ unsigned xcc_id() { return (unsigned)__builtin_amdgcn_s_getreg((3 << 11) | 20) & 0xFu; }
__device__ __forceinline__ void grid_barrier(unsigned* bar, unsigned r, unsigned x, unsigned nloc, unsigned nx, int tid) {
    asm volatile("s_waitcnt vmcnt(0) lgkmcnt(0)" ::: "memory");
    __syncthreads();
    if (tid == 0) {
        const unsigned old = xb_add(bar + XB_ARR(x), 1u);
        if (old + 1u == nloc * r) {
            __builtin_amdgcn_fence(__ATOMIC_RELEASE, "agent");
            asm volatile("s_waitcnt vmcnt(0)" ::: "memory");
            const unsigned o2 = xb_add(bar + XB_TOP, 1u);
            if (o2 + 1u == nx * r) xb_st(bar + XB_TOPGEN, r);
            else while (xb_ld(bar + XB_TOPGEN) < r) __builtin_amdgcn_s_sleep(1);
            xb_st(bar + XB_REL(x), r);
        } else { while (xb_ld(bar + XB_REL(x)) < r) __builtin_amdgcn_s_sleep(1); }
        __builtin_amdgcn_fence(__ATOMIC_ACQUIRE, "agent");
        asm volatile("s_waitcnt vmcnt(0)" ::: "memory");
    }
    __syncthreads();
}
struct Args { const float* in[14]; float* out; unsigned char* ws; int ph_lo, ph_hi; };
enum { I_X = 0, I_ANG, I_WIN, I_FB, I_RBT, I_FOG, I_DOG, I_WOUT, I_FNG, I_WUP, I_CW, I_CB, I_WDN, I_FING };
constexpr int N_PHASES = 11;
constexpr int DN_KB_SPLIT = 129;
#define PROBE_FOX 1
#define PROBE_DIL 1
#ifndef PROBE_PH
#define PROBE_PH -1
#endif

__global__ void __launch_bounds__(NWAVES * 64, 2) hymba_fwd(Args args) {
    extern __shared__ __attribute__((aligned(16))) unsigned char lds[];
    cg::grid_group grid = cg::this_grid();
    const int wave = __builtin_amdgcn_readfirstlane((int)threadIdx.x >> 6);
    const int G = gridDim.x; const int bx = blockIdx.x; const int vcu = (G % 8 == 0) ? (bx % 8) * (G / 8) + bx / 8 : bx;
    const int gw = vcu * NWAVES + wave, NGW = G * NWAVES;
    unsigned char* ws = args.ws;
    bf16* WinT = (bf16*)(ws + WS_WIN); bf16* WfT = (bf16*)(ws + WS_WF); bf16* WoutT = (bf16*)(ws + WS_WOUT); bf16* WupT = (bf16*)(ws + WS_WUP); bf16* WdnT = (bf16*)(ws + WS_WDN);
    bf16* XN = (bf16*)(ws + WS_XN); float* X1 = (float*)(ws + WS_X1); bf16* ACT = (bf16*)(ws + WS_ACT);
    int* JLO = (int*)(ws + WS_TAB + 65536); float* LOGF = (float*)(ws + WS_LOGF); float* CNEG = (float*)(ws + WS_CNEG); float* TAB = (float*)(ws + WS_TAB);
    float* GB = (float*)(ws + WS_GB); float* GF = (float*)(ws + WS_GF); float* VF = (float*)(ws + WS_VF);
    bf16* QKV = (bf16*)(ws + WS_QKV); bf16* OA = (bf16*)(ws + WS_OA); bf16* OB = (bf16*)(ws + WS_OB); float* LSE = (float*)(ws + WS_LSE); bf16* MIX = (bf16*)(ws + WS_MIX);
    const int lo = args.ph_lo, hi_ph = args.ph_hi;
#define IN(k) (lo <= (k) && (k) < hi_ph)
#define REP(k) ((PROBE_PH == (k)) ? 2 : 1)
    unsigned* gbar = (unsigned*)(ws + WS_CTL + CTL_BAR);
    const unsigned xid = xcc_id(); if (threadIdx.x == 0) (void)xb_add(gbar + XB_CEN(xid), 1u);
    unsigned xb_nloc = 1u, xb_nx = 1u; unsigned* NORM = (unsigned*)(ws + WS_CTL + CTL_NORM); float* SSQ = (float*)(ws + WS_CTL + CTL_SSQ); float* SSQ2 = (float*)(ws + WS_CTL + CTL_SSQ2); float* SSQA = (float*)(ws + WS_CTL + CTL_SSQA);
    unsigned nbar = 0;
#define SEAM(k) do { if (IN(k) && IN((k) + 1)) { if ((k) == 0) { asm volatile("s_waitcnt vmcnt(0) lgkmcnt(0)" ::: "memory");     \
        grid.sync(); xb_nx = 0u; for (unsigned j_ = 0; j_ < 16u; ++j_) { const unsigned c_ = xb_ld(gbar + XB_CEN(j_)); xb_nx += c_ ? 1u : 0u; if (j_ == xid) xb_nloc = c_; } \
        xb_nloc = (unsigned)__builtin_amdgcn_readfirstlane((int)xb_nloc); xb_nx = (unsigned)__builtin_amdgcn_readfirstlane((int)xb_nx); \
        ++nbar; grid_barrier(gbar, nbar, xid, xb_nloc, xb_nx, (int)threadIdx.x); }   \
      else if ((k) != 2 && (k) != 5) { ++nbar; grid_barrier(gbar, nbar, xid, xb_nloc, xb_nx, wave * 64 + lane_id_v()); } } } while (0)

    if (IN(0)) for (int rep_ = 0; rep_ < REP(0); ++rep_) {
        const int tid = threadIdx.x, lane = tid & 63;
        LAS float* scr = (LAS float*)((LAS unsigned char*)lds + wave * 16640);
        constexpr int KB4 = DM / 64;
        constexpr int I_IN = KB4 * (NQKV / 64), I_OUT = KB4 * (DM / 64);
        constexpr int I_DNB = ((DFF / 64) - DN_KB_SPLIT) * (DM / 64); constexpr int NITEMS = I_IN + I_OUT + I_DNB;
        for (int it = gw; it < NITEMS; it += NGW) {
            int r = it;
            if (r < I_IN) { const int nblk = NQKV / 64, kb = r / nblk, nb = r % nblk; const int n0 = nb * 64; const int src = n0 < 6144 ? n0 : n0 + 16;
                tr_item(args.in[I_WIN] + src, INW, DM, WinT + (size_t)n0 * DM, scr, kb * 64, lane); continue; } r -= I_IN;
            if (r < I_OUT) { const int nblk = DM / 64, kb = r / nblk, nb = r % nblk;
                tr_item(args.in[I_WOUT] + nb * 64, DM, DM, WoutT + (size_t)(nb * 64) * DM, scr, kb * 64, lane, (kb * 64 < FW) ? args.in[I_FOG] : args.in[I_DOG] - FW); continue; } r -= I_OUT;
            { const int nblk = DM / 64, kb = DN_KB_SPLIT + r / nblk, nb = r % nblk;
                tr_item(args.in[I_WDN] + nb * 64, DM, DFF, WdnT + (size_t)(nb * 64) * DFF, scr, kb * 64, lane); }
        }
        for (int m = gw; m < SEQ; m += NGW) rms_row_bf16(args.in[I_X] + (size_t)m * DM, args.in[I_ANG], XN + (size_t)m * DM, lane);
        for (int item = gw; item < 16 * (DM / 64); item += NGW) { const int j = item & 15, k = (item >> 4) * 64 + lane;
            const float v = args.in[I_WIN][(size_t)k * INW + 6144 + j]; WfT[(size_t)j * DM + k] = (bf16)(pk2(v, v) & 0xffffu); }
        for (int idx = bx * (NWAVES * 64) + tid; idx < 48 * 132; idx += G * NWAVES * 64) { const int t = idx / 132, i = idx % 132, br = t / 16, h = t % 16;
            float v = 0.f; if (i <= 128) { const int dil = br == 0 ? 1 : (br == 1 ? 4 : 16); v = args.in[I_RBT][t5_bucket((128 - i) * dil) * 16 + h] * INV_SCALE; }
            TAB[idx] = v; }
    }
    SEAM(0);
    if (IN(1)) for (int rep_ = 0; rep_ < REP(1); ++rep_) {
        pg8::Gemm g{XN, WinT, SEQ, NQKV, DM}; pg8::StaticOrder S; S.init(SEQ, NQKV, G, bx);
        pg8::EpiQKV E{QKV, SEQ, NORM};
        const int lane = lane_id_v(), tid = wave * 64 + lane;
        pg8::gemm_phase<pg8::EpiQKV, pg8::StaticOrder, true, true>((LAS unsigned char*)lds, g, S, E, tid);
        for (int task = bx; task < SEQ / 32; task += G) {
            const int t0 = task * 32, row = lane & 15, quad = lane >> 4;
            const bf16* ap = XN + (size_t)(t0 + row) * DM + wave * 512 + quad * 8; const bf16* bp = WfT + (size_t)row * DM + wave * 512 + quad * 8;
            f32x4 acc0 = {0.f, 0.f, 0.f, 0.f}, acc1 = acc0;
#pragma unroll
            for (int k0 = 0; k0 < 512; k0 += 32) { const bf16x8 a0 = *(const bf16x8*)(ap + k0), a1 = *(const bf16x8*)(ap + (size_t)16 * DM + k0), b = *(const bf16x8*)(bp + k0);
                acc0 = __builtin_amdgcn_mfma_f32_16x16x32_bf16(a0, b, acc0, 0, 0, 0); acc1 = __builtin_amdgcn_mfma_f32_16x16x32_bf16(a1, b, acc1, 0, 0, 0); }
            LAS f32x4* red = (LAS f32x4*)lds;
            red[wave * 128 + lane] = acc0; red[wave * 128 + 64 + lane] = acc1;
            __syncthreads();
            if (wave == 0) {
#pragma unroll
                for (int w = 1; w < 8; ++w) { acc0 += red[w * 128 + lane]; acc1 += red[w * 128 + 64 + lane]; }
                const int h = lane & 15; const float fb = args.in[I_FB][h];
#pragma unroll
                for (int j = 0; j < 4; ++j) { const float x0 = acc0[j] + fb, x1 = acc1[j] + fb;
                    LOGF[(size_t)h * SEQ + t0 + quad * 4 + j] = fminf(x0, 0.f) - log1pf(expf(-fabsf(x0)));
                    LOGF[(size_t)h * SEQ + t0 + 16 + quad * 4 + j] = fminf(x1, 0.f) - log1pf(expf(-fabsf(x1))); }
            }
            __syncthreads();
        }
    }
    SEAM(1);
    SEAM(2);
    if (IN(3)) for (int rep_ = 0; rep_ < REP(3); ++rep_) {
        char* al = (char*)lds; const int tid = wave * 64 + lane_id_v();
        for (int i = tid; i < 48 * 132; i += NWAVES * 64) ((float*)(al + att::LDS_DTAB))[i] = TAB[i];
        __syncthreads();
        att::Seam S;
        if (vcu < 256) {
            const int L_ = vcu; const int h_ = L_ >> 4, pr_ = L_ & 15, lane_ = tid & 63;
            float* cbl = (float*)(al + att::LDS_BIAS); float* wsum = (float*)(al + 2 * att::SHM_V + 2 * att::SHM_K);
            { const f32x4* lf = (const f32x4*)(LOGF + (size_t)h_ * SEQ + tid * 16); f32x4 v[4]; float p[16]; float run = 0.f;
#pragma unroll
              for (int i = 0; i < 4; ++i) v[i] = lf[i];
#pragma unroll
              for (int i = 0; i < 4; ++i) { run += v[i].x; p[4 * i] = run; run += v[i].y; p[4 * i + 1] = run; run += v[i].z; p[4 * i + 2] = run; run += v[i].w; p[4 * i + 3] = run; }
              float inc = run;
#pragma unroll
              for (int o = 1; o < 64; o <<= 1) { const float t_ = __shfl_up(inc, o); if (lane_ >= o) inc += t_; }
              if (lane_ == 63) wsum[wave] = inc;
              __syncthreads();
              float off = inc - run;
              for (int w = 0; w < wave; ++w) off += wsum[w];
#pragma unroll
              for (int i = 0; i < 4; ++i) { f32x4 o; o.x = -(off + p[4 * i]) * INV_SCALE; o.y = -(off + p[4 * i + 1]) * INV_SCALE; o.z = -(off + p[4 * i + 2]) * INV_SCALE; o.w = -(off + p[4 * i + 3]) * INV_SCALE; ((f32x4*)cbl)[tid * 4 + i] = o; }
              __syncthreads(); }
            float qn2 = 0.f, kn2 = 0.f;
#pragma unroll
            for (int w = 0; w < 4; ++w) { qn2 += __uint_as_float(NORM[h_ * 4 + w]); kn2 += __uint_as_float(NORM[(16 + h_) * 4 + w]); }
            const float thr = (34.f + 2.02f * sqrtf(qn2 * kn2) * att::SCALE) * INV_SCALE;
#define FOX_REF(R, pass) do { const int qb_ = (pass) ? 31 - pr_ : pr_; \
            R.Q = QKV + ((size_t)(0 * 16 + h_) * SEQ + (size_t)qb_ * 256) * 128; R.K = QKV + (size_t)(1 * 16 + h_) * SEQ * 128; R.V = QKV + (size_t)(2 * 16 + h_) * SEQ * 128; \
            R.O = MIX + (size_t)qb_ * 256 * DM + h_ * 128; R.lse = SSQA + qb_ * 256; R.gb = nullptr; R.P0 = qb_ * 256; R.rs = 128; R.os = DM; R.ls = 1; R.tab = 0; \
            { const float lim_ = cbl[R.P0] - thr; const int nt_ = R.P0 >> 6; int cnt_ = 0; \
              for (int b_ = 0; b_ < nt_; b_ += 64) { const int j_ = b_ + lane_; const bool sk_ = (j_ < nt_) && (cbl[64 * (j_ < nt_ ? j_ : 0) + 63] <= lim_); cnt_ += __popcll(__ballot(sk_)); } R.jlo = cnt_; } } while (0)
            att::BlockRef cur, nxt; FOX_REF(cur, 0); att::attn_prime(cur, al, S, tid);
            FOX_REF(nxt, 1); att::attn_block<0>(cur, nxt, al, S, tid); cur = nxt;
            att::attn_block<0>(cur, cur, al, S, tid);
#undef FOX_REF
        }
        { const int per = (1536 + G - 1) / G; const int L0 = vcu * per; const int L1 = (L0 + per < 1536) ? L0 + per : 1536;
#define DIL_REF(R, L) do { const int h_ = (L) / 96, rem_ = (L) % 96, br_ = rem_ >> 5, idx_ = rem_ & 31; const int dil_ = br_ == 0 ? 1 : (br_ == 1 ? 4 : 16); const int nq_ = 32 / dil_; \
            const int cls_ = idx_ / nq_, qb_ = idx_ % nq_; const size_t tok0_ = (size_t)cls_ + (size_t)qb_ * 256 * dil_; \
            R.Q = QKV + ((size_t)(3 * 16 + h_) * SEQ + tok0_) * 128; R.K = QKV + ((size_t)(4 * 16 + h_) * SEQ + cls_) * 128; R.V = QKV + ((size_t)(5 * 16 + h_) * SEQ + cls_) * 128; \
            R.O = OB + ((size_t)br_ * SEQ + tok0_) * FW + h_ * 128; R.lse = LSE + (size_t)(br_ * 16 + h_) * SEQ + (size_t)cls_ * (SEQ / dil_) + (size_t)qb_ * 256; R.gb = nullptr; R.P0 = qb_ * 256; R.rs = 128 * dil_; R.os = FW * dil_; R.ls = 1;     \
            { const int lowk_ = qb_ * 256 - 128; R.jlo = lowk_ > 0 ? lowk_ / 64 : 0; } R.tab = att::LDS_DTAB + (br_ * 16 + h_) * att::DTAB_STRIDE; } while (0)
          if (L0 < L1) { att::BlockRef cur, nxt; DIL_REF(cur, L0); att::attn_prime(cur, al, S, tid);
            const int nd = (L1 - L0) * PROBE_DIL;
            for (int i = 0; i < nd; ++i) { if (i + 1 < nd) DIL_REF(nxt, L0 + (i + 1) % (L1 - L0)); else nxt = cur; att::attn_block<1>(cur, nxt, al, S, tid); cur = nxt; } }
#undef DIL_REF
        }
    }
    SEAM(3);
    if (IN(4)) for (int rep_ = 0; rep_ < REP(4); ++rep_) {
        const float* ga = args.in[I_FOG]; const float* gd = args.in[I_DOG]; const int lane = lane_id_v();
        for (int t = gw; t < SEQ; t += NGW) {
            { float v[4][8]; float ss = 0.f;
#pragma unroll
              for (int j = 0; j < 4; ++j) { const int col = 8 * (lane + 64 * j), h = col >> 7;
                  const float l0 = LSE[(size_t)(0 * 16 + h) * SEQ + t], l1 = LSE[(size_t)(1 * 16 + h) * SEQ + (size_t)(t & 3) * (SEQ / 4) + (t >> 2)], l2 = LSE[(size_t)(2 * 16 + h) * SEQ + (size_t)(t & 15) * (SEQ / 16) + (t >> 4)];
                  const float mx = fmaxf(l0, fmaxf(l1, l2)); float w0 = __builtin_amdgcn_exp2f(l0 - mx), w1 = __builtin_amdgcn_exp2f(l1 - mx), w2 = __builtin_amdgcn_exp2f(l2 - mx);
                  const float inv = 1.f / (w0 + w1 + w2); w0 *= inv; w1 *= inv; w2 *= inv;
                  const v4u a = *(const v4u*)(OB + ((size_t)0 * SEQ + t) * FW + col), b = *(const v4u*)(OB + ((size_t)1 * SEQ + t) * FW + col), c = *(const v4u*)(OB + ((size_t)2 * SEQ + t) * FW + col);
#pragma unroll
                  for (int e = 0; e < 4; ++e) { v[j][2 * e] = w0 * bflo(a[e]) + w1 * bflo(b[e]) + w2 * bflo(c[e]); v[j][2 * e + 1] = w0 * bfhi(a[e]) + w1 * bfhi(b[e]) + w2 * bfhi(c[e]);
                      ss += v[j][2 * e] * v[j][2 * e] + v[j][2 * e + 1] * v[j][2 * e + 1]; } }
              const float r = rsqrtf(wave_sum(ss) * (1.f / FW) + RMS_EPS) * sqrtf(SSQA[t] * (1.f / FW) + RMS_EPS);
#pragma unroll
              for (int j = 0; j < 4; ++j) { const int col = 8 * (lane + 64 * j); v4u w;
                  w.x = pk2(v[j][0] * r, v[j][1] * r); w.y = pk2(v[j][2] * r, v[j][3] * r); w.z = pk2(v[j][4] * r, v[j][5] * r); w.w = pk2(v[j][6] * r, v[j][7] * r);
                  *(v4u*)(MIX + (size_t)t * DM + FW + col) = w; } }
        }
    }
    SEAM(4);
    if (IN(5)) for (int rep_ = 0; rep_ < REP(5); ++rep_) {
        pg8::Gemm g{MIX, WoutT, SEQ, DM, DM}; pg8::StaticOrder S; S.init(SEQ, DM, G, bx);
        pg8::EpiX1 E{args.in[I_X], XN, SSQ, DM, SSQA};
        pg8::gemm_phase<pg8::EpiX1, pg8::StaticOrder, true, true>((LAS unsigned char*)lds, g, S, E, wave * 64 + lane_id_v());
    }
    SEAM(5);
    if (IN(6)) for (int rep_ = 0; rep_ < REP(6); ++rep_) {
        const int lane = lane_id_v(); LAS float* scr = (LAS float*)((LAS unsigned char*)lds + wave * 16640);
        constexpr int I_UP = (DM / 64) * (NUP / 64);
        for (int r = gw; r < I_UP; r += NGW) { const int nblk = NUP / 64, kb = r / nblk, nb = r % nblk; const int n0 = nb * 64;
            const int f = n0 < DFF ? n0 : n0 - DFF; const int drow = 256 * (f >> 7) + (f & 127) + (n0 < DFF ? 0 : 128);
            tr_item(args.in[I_WUP] + n0, NUP, DM, WupT + (size_t)drow * DM, scr, kb * 64, lane, args.in[I_FNG]); }
    }
    SEAM(6);
    if (IN(7)) for (int rep_ = 0; rep_ < REP(7); ++rep_) {
        pg8::Gemm g{XN, WupT, SEQ, NUP, DM}; pg8::StaticOrder S; S.init(SEQ, NUP, G, bx);
        LAS float* rsL = (LAS float*)((LAS unsigned char*)lds + 131072); LAS float* cwL = rsL + 256;
        int pm0 = -1, pn0 = 0, nslot = 0;
        { const int tid_ = wave * 64 + lane_id_v(); pg8::Unit u0, ui;
          if (S.next(0, u0)) { pm0 = u0.pm; pn0 = u0.pn; nslot = 1;
            for (int i = 1; i < EPI_SLOTS && S.next(i, ui); ++i) { if (ui.pm != pm0 || ui.pn != pn0 + 4 * i) break; nslot = i + 1; }
            if (tid_ < 256) rsL[tid_] = rsqrtf(SSQ[pm0 * 256 + tid_] * (1.0f / 4096.0f) + 1e-6f);
            const int arr = tid_ >> 7, c = tid_ & 127;
            for (int i = 0; i < nslot; ++i) { const int col = (pn0 + 4 * i) * 128 + c; cwL[i * 512 + tid_] = arr < 3 ? args.in[I_CW][(size_t)arr * DFF + col] : args.in[I_CB][col]; } }
          __syncthreads(); }
        pg8::EpiGate E{ACT, DFF, args.in[I_CW], args.in[I_CB], GB, GF, VF, SSQ, rsL, cwL, pm0, pn0, nslot};
        pg8::gemm_phase<pg8::EpiGate, pg8::StaticOrder, true, true>((LAS unsigned char*)lds, g, S, E, wave * 64 + lane_id_v());
        { const int nwg = (SEQ / 256) * (NUP / 256), rem = nwg % G, first = rem ? rem : 0, nconv = rem ? G - rem : G;
          if (bx >= first) { const int lane = lane_id_v(); LAS float* scr = (LAS float*)((LAS unsigned char*)lds + wave * 16640);
            constexpr int I_DN = DN_KB_SPLIT * (DM / 64);
            for (int r = (bx - first) * NWAVES + wave; r < I_DN; r += nconv * NWAVES) { const int nblk = DM / 64, kb = r / nblk, nb = r % nblk;
                tr_item(args.in[I_WDN] + nb * 64, DM, DFF, WdnT + (size_t)(nb * 64) * DFF, scr, kb * 64, lane); } } }
    }
    SEAM(7);
    if (IN(8)) for (int rep_ = 0; rep_ < REP(8); ++rep_) {
        const float* cw = args.in[I_CW]; const float* cb = args.in[I_CB];
        const int total = (SEQ / 64) * 2 * (DFF / 4); const int tid = wave * 64 + lane_id_v();
        for (int idx = bx * (NWAVES * 64) + tid; idx < total; idx += G * NWAVES * 64) {
            const int c4 = idx % (DFF / 4), rk = idx / (DFF / 4), g64 = rk >> 1, k = rk & 1, c = c4 * 4;
            const f32x4 cur = *(const f32x4*)(GF + ((size_t)g64 * 2 + k) * DFF + c), val = *(const f32x4*)(VF + ((size_t)g64 * 2 + k) * DFF + c);
            f32x4 p1 = {0.f, 0.f, 0.f, 0.f}, p2 = {0.f, 0.f, 0.f, 0.f};
            if (k == 1) { p1 = *(const f32x4*)(GF + ((size_t)g64 * 2) * DFF + c); if (g64 > 0) p2 = *(const f32x4*)(GB + ((size_t)(g64 - 1) * 2 + 1) * DFF + c); }
            else if (g64 > 0) { p1 = *(const f32x4*)(GB + ((size_t)(g64 - 1) * 2 + 1) * DFF + c); p2 = *(const f32x4*)(GB + ((size_t)(g64 - 1) * 2) * DFF + c); }
            const f32x4 w0 = *(const f32x4*)(cw + c), w1 = *(const f32x4*)(cw + DFF + c), w2 = *(const f32x4*)(cw + 2 * DFF + c), b = *(const f32x4*)(cb + c);
            float a[4];
#pragma unroll
            for (int j = 0; j < 4; ++j) { const float gg = w2[j] * cur[j] + w1[j] * p1[j] + w0[j] * p2[j] + b[j]; a[j] = pg8::silu_f(gg) * val[j]; }
            v2u w; w.x = pk2(a[0], a[1]); w.y = pk2(a[2], a[3]);
            *(v2u*)(ACT + (size_t)(g64 * 64 + k) * DFF + c) = w;
        }
    }
    SEAM(8);
    if (IN(9)) for (int rep_ = 0; rep_ < REP(9); ++rep_) {
        pg8::Gemm g{ACT, WdnT, SEQ, DM, DFF}; pg8::StaticOrder S; S.init(SEQ, DM, G, bx);
        pg8::EpiX2 E{XN, SSQ2, DM};
        pg8::gemm_phase<pg8::EpiX2, pg8::StaticOrder, true, true>((LAS unsigned char*)lds, g, S, E, wave * 64 + lane_id_v());
    }
    SEAM(9);
    if (IN(10)) for (int rep_ = 0; rep_ < REP(10); ++rep_) { const int lane = lane_id_v(); const float* gf = args.in[I_FING];
        for (int m = gw; m < SEQ; m += NGW) { const float r = rsqrtf(SSQ2[m] * (1.f / DM) + RMS_EPS); const v4u* xr = (const v4u*)(XN + (size_t)m * DM) + lane; float* orow = args.out + (size_t)m * DM;
            v4u raw[8];
#pragma unroll
            for (int j = 0; j < 8; ++j) raw[j] = xr[64 * j];
#pragma unroll
            for (int j = 0; j < 8; ++j) { const int col = 8 * (lane + 64 * j); const f32x4 g0 = *(const f32x4*)(gf + col), g1 = *(const f32x4*)(gf + col + 4);
                f32x4 o0, o1; o0.x = bflo(raw[j].x) * r * g0.x; o0.y = bfhi(raw[j].x) * r * g0.y; o0.z = bflo(raw[j].y) * r * g0.z; o0.w = bfhi(raw[j].y) * r * g0.w;
                o1.x = bflo(raw[j].z) * r * g1.x; o1.y = bfhi(raw[j].z) * r * g1.y; o1.z = bflo(raw[j].w) * r * g1.z; o1.w = bfhi(raw[j].w) * r * g1.w;
                *(f32x4*)(orow + col) = o0; *(f32x4*)(orow + col + 4) = o1; } }
    }
#undef IN
#undef SEAM
}

#ifndef MK_N_LAUNCHES
#define MK_N_LAUNCHES 1
#endif
extern "C" void kernel_launch(void* const* d_in, const int* in_sizes, int n_in, void* d_out, int out_size, void* d_ws, size_t ws_size, hipStream_t stream) {
    static int grid = 0;
    if (grid == 0) {
        if (n_in != 14 || in_sizes[0] != SEQ * DM || out_size != SEQ * DM || ws_size < WS_END) { fprintf(stderr, "kernel_launch: unexpected shapes (n_in %d, ws %zu < %zu)\n", n_in, ws_size, (size_t)WS_END); grid = -1; return; }
        int dev = 0, cus = 0, per_cu = 0;
        (void)hipGetDevice(&dev); (void)hipDeviceGetAttribute(&cus, hipDeviceAttributeMultiprocessorCount, dev);
        if (hipFuncSetAttribute((const void*)hymba_fwd, hipFuncAttributeMaxDynamicSharedMemorySize, LDS_BYTES) != hipSuccess) { fprintf(stderr, "kernel_launch: hipFuncSetAttribute failed\n"); grid = -1; return; }
        if (hipOccupancyMaxActiveBlocksPerMultiprocessor(&per_cu, (const void*)hymba_fwd, NWAVES * 64, LDS_BYTES) != hipSuccess || per_cu < 1) { fprintf(stderr, "kernel_launch: occupancy query says %d\n", per_cu); per_cu = 1; }
        (void)hipGetLastError();
        grid = cus * 1;
        if (grid <= 0) grid = 256;
        if (grid < 256) { fprintf(stderr, "kernel_launch: needs >= 256 workgroups (one FoX item each), device has %d CUs\n", grid); grid = -1; return; }
    }
    if (grid < 0) return;
    if (hipMemsetAsync((char*)d_ws + WS_CTL, 0, CTL_BYTES, stream) != hipSuccess) { fprintf(stderr, "kernel_launch: memset failed\n"); return; }
    Args a{};
    for (int i = 0; i < 14; ++i) a.in[i] = (const float*)d_in[i];
    a.out = (float*)d_out; a.ws = (unsigned char*)d_ws;
#if MK_N_LAUNCHES == 1
    a.ph_lo = 0; a.ph_hi = N_PHASES;
    { void* kargs[] = {&a}; hipError_t e = hipLaunchCooperativeKernel((const void*)hymba_fwd, dim3(grid), dim3(NWAVES * 64), kargs, LDS_BYTES, stream);
      if (e != hipSuccess) fprintf(stderr, "kernel_launch: cooperative launch failed: %s (grid %d)\n", hipGetErrorString(e), grid); }
#else
    for (int p = 0; p < N_PHASES; ++p) { a.ph_lo = p; a.ph_hi = p + 1; void* kargs[] = {&a};
        hipError_t e = hipLaunchCooperativeKernel((const void*)hymba_fwd, dim3(grid), dim3(NWAVES * 64), kargs, LDS_BYTES, stream);
        if (e != hipSuccess) { fprintf(stderr, "kernel_launch: launch %d failed: %s\n", p, hipGetErrorString(e)); break; } }
#endif
}
```

```cpp
#include <hip/hip_runtime.h>
#include <hip/hip_bf16.h>
#include <hip/hip_cooperative_groups.h>
#include <cstdio>
#include <cstdint>
namespace cg = cooperative_groups;
namespace pg8 {
#define PG8_LAS __attribute__((address_space(3)))
typedef unsigned short bf16_t;
typedef short bf16x8 __attribute__((ext_vector_type(8)));
typedef float f32x4 __attribute__((ext_vector_type(4)));
typedef unsigned u32x4 __attribute__((ext_vector_type(4)));
constexpr int BM = 256, BK = 64, HALF = 128, HTB = HALF * BK * 2  , STAGE_BYTES = 8 * HTB, NXCD = 8, WGM = 8;

__host__ __device__ __forceinline__ int lds_byte(int r, int c) { const int st = (r >> 4) * 2 + (c >> 5), rr = r & 15, cc = c & 31, ob = rr * 64 + cc * 2; return st * 1024 + (ob ^ (((ob >> 9) & 1) << 5)); }
__host__ __device__ __forceinline__ void stage_rc(int b, int& R, int& C) { const int st = b / 1024, sb = b % 1024, swz = sb ^ (((sb >> 9) & 1) << 5); R = (st >> 1) * 16 + swz / 64; C = (st & 1) * 32 + (swz % 64) / 2; }
__host__ __device__ __forceinline__ int perm32(int rho) { const int n = rho >> 4, i = rho & 15; return 8 * (i >> 2) + 4 * n + (i & 3); }

struct Unit { int pm, pn; };
struct Gemm { const bf16_t* A; const bf16_t* Bt; int M, N, K; };

struct StaticOrder {
    int nM, nN, nwg, G, c, wgm;
    __host__ __device__ void init(int M, int N, int G_, int c_, int wgm_ = WGM) { nM = M / BM; nN = N / BM; nwg = nM * nN; G = G_; c = c_; wgm = wgm_; }
    __host__ __device__ bool next(int i, Unit& u) const {
        const long L = (long)i * G + c; if (L >= nwg) return false;
        int wgid = (int)L; { const int q = nwg / NXCD, r = nwg % NXCD, xcd = wgid % NXCD, off = wgid / NXCD; wgid = (xcd < r ? xcd * (q + 1) : r * (q + 1) + (xcd - r) * q) + off; }
        const int nig = wgm * nN, gid = wgid / nig, fm = gid * wgm, gsz = (nM - fm) < wgm ? (nM - fm) : wgm;
        u.pm = fm + ((wgid % nig) % gsz); u.pn = (wgid % nig) / gsz; return true;
    }
    __device__ __forceinline__ void a_ready(const Unit&) const {}
    __device__ __forceinline__ void done(const Unit&) const {}
};

__device__ __forceinline__ unsigned cvt_pk_bf16(float lo, float hi) { unsigned r; asm volatile("v_cvt_pk_bf16_f32 %0, %1, %2" : "=v"(r) : "v"(lo), "v"(hi)); return r; }
typedef float f32x2 __attribute__((ext_vector_type(2)));
typedef unsigned u32x2 __attribute__((ext_vector_type(2)));
struct EpiQKV {
    static constexpr bool PERM = true, AFTER_DRAIN = false;
    bf16_t* O; int S; unsigned* norm4;
    __device__ __forceinline__ void operator()(const f32x4 (&acc)[2][2][4][2], const Unit& u, int wr, int wc, int fr, int fq) const {
        const int row0 = u.pm * BM + wr * 64 + fr, d0 = wc * 32 + 8 * fq;
#pragma unroll
        for (int bj = 0; bj < 2; ++bj) { bf16_t* hb = O + (size_t)(2 * u.pn + bj) * S * 128 + d0;
#pragma unroll
            for (int ai = 0; ai < 2; ++ai)
#pragma unroll
                for (int m = 0; m < 4; ++m) { const f32x4 v0 = acc[ai][bj][m][0], v1 = acc[ai][bj][m][1];
                    u32x4 w; w.x = cvt_pk_bf16(v0[0], v0[1]); w.y = cvt_pk_bf16(v0[2], v0[3]); w.z = cvt_pk_bf16(v1[0], v1[1]); w.w = cvt_pk_bf16(v1[2], v1[3]);
                    *(u32x4*)(hb + (size_t)(row0 + ai * HALF + m * 16) * 128) = w; } }
        if (u.pn < 16) {
#pragma unroll
            for (int bj = 0; bj < 2; ++bj) { float mx = 0.f;
#pragma unroll
                for (int ai = 0; ai < 2; ++ai)
#pragma unroll
                    for (int m = 0; m < 4; ++m) { const f32x4 v0 = acc[ai][bj][m][0], v1 = acc[ai][bj][m][1];
                        float ss = (v0[0] * v0[0] + v0[1] * v0[1]) + (v0[2] * v0[2] + v0[3] * v0[3]) + (v1[0] * v1[0] + v1[1] * v1[1]) + (v1[2] * v1[2] + v1[3] * v1[3]);
                        ss += __shfl_xor(ss, 16); ss += __shfl_xor(ss, 32); mx = fmaxf(mx, ss); }
                mx = fmaxf(mx, __shfl_xor(mx, 1)); mx = fmaxf(mx, __shfl_xor(mx, 2)); mx = fmaxf(mx, __shfl_xor(mx, 4)); mx = fmaxf(mx, __shfl_xor(mx, 8));
                if (fr == 0 && fq == 0) atomicMax(norm4 + (2 * u.pn + bj) * 4 + wc, __float_as_uint(mx)); }
        }
    }
};
struct EpiRes {
    static constexpr bool PERM = false, AFTER_DRAIN = false;
    const float* base; float* out; int ldc;
    __device__ __forceinline__ void operator()(const f32x4 (&acc)[2][2][4][2], const Unit& u, int wr, int wc, int fr, int fq) const {
        const int col0 = u.pn * BM + wc * 32 + 4 * fq;
#pragma unroll
        for (int ai = 0; ai < 2; ++ai)
#pragma unroll
            for (int m = 0; m < 4; ++m) { const size_t off = (size_t)(u.pm * BM + ai * HALF + wr * 64 + m * 16 + fr) * ldc + col0;
#pragma unroll
                for (int bj = 0; bj < 2; ++bj)
#pragma unroll
                    for (int n = 0; n < 2; ++n) { const f32x4 bs = *(const f32x4*)(base + off + bj * HALF + n * 16); *(f32x4*)(out + off + bj * HALF + n * 16) = bs + acc[ai][bj][m][n]; }
                if (m & 1) asm volatile("" ::: "memory"); }
    }
};
struct EpiX1 {
    static constexpr bool PERM = false, AFTER_DRAIN = false;
    const float* base; bf16_t* xb; float* ssq; int ldc; const float* ssqa;
    __device__ __forceinline__ void operator()(const f32x4 (&acc)[2][2][4][2], const Unit& u, int wr, int wc, int fr, int fq) const {
        const int col0 = u.pn * BM + wc * 32 + 4 * fq;
#pragma unroll
        for (int ai = 0; ai < 2; ++ai) {
#pragma unroll
            for (int m = 0; m < 4; ++m) { const int row = u.pm * BM + ai * HALF + wr * 64 + m * 16 + fr; const size_t off = (size_t)row * ldc + col0; float s = 0.f; const float ra = rsqrtf(ssqa[row] * (1.0f / 2048.0f) + 1e-6f);
#pragma unroll
                for (int bj = 0; bj < 2; ++bj)
#pragma unroll
                    for (int n = 0; n < 2; ++n) { const f32x4 v = *(const f32x4*)(base + off + bj * HALF + n * 16) + acc[ai][bj][m][n] * ra;
                        u32x2 w; w.x = cvt_pk_bf16(v[0], v[1]); w.y = cvt_pk_bf16(v[2], v[3]); *(u32x2*)(xb + off + bj * HALF + n * 16) = w; s += (v[0] * v[0] + v[1] * v[1]) + (v[2] * v[2] + v[3] * v[3]); }
                s += __shfl_xor(s, 16); s += __shfl_xor(s, 32);
                if (fq == 0) atomicAdd(ssq + row, s); }
            asm volatile("" ::: "memory"); }
    }
};
struct EpiX2 {
    static constexpr bool PERM = false, AFTER_DRAIN = false;
    bf16_t* xb; float* ssq; int ldc;
    __device__ __forceinline__ void operator()(const f32x4 (&acc)[2][2][4][2], const Unit& u, int wr, int wc, int fr, int fq) const {
        const int col0 = u.pn * BM + wc * 32 + 4 * fq;
#pragma unroll
        for (int ai = 0; ai < 2; ++ai) {
#pragma unroll
            for (int m = 0; m < 4; ++m) { const int row = u.pm * BM + ai * HALF + wr * 64 + m * 16 + fr; const size_t off = (size_t)row * ldc + col0; float s = 0.f;
#pragma unroll
                for (int bj = 0; bj < 2; ++bj)
#pragma unroll
                    for (int n = 0; n < 2; ++n) { bf16_t* p = xb + off + bj * HALF + n * 16; const u32x2 r = *(const u32x2*)p; f32x4 v;
                        v[0] = __uint_as_float(r.x << 16); v[1] = __uint_as_float(r.x & 0xffff0000u); v[2] = __uint_as_float(r.y << 16); v[3] = __uint_as_float(r.y & 0xffff0000u); v += acc[ai][bj][m][n];
                        u32x2 w; w.x = cvt_pk_bf16(v[0], v[1]); w.y = cvt_pk_bf16(v[2], v[3]); *(u32x2*)p = w; s += (v[0] * v[0] + v[1] * v[1]) + (v[2] * v[2] + v[3] * v[3]); }
                s += __shfl_xor(s, 16); s += __shfl_xor(s, 32);
                if (fq == 0) atomicAdd(ssq + row, s); }
            asm volatile("" ::: "memory"); }
    }
};
__device__ __forceinline__ float dpp_shr1(float cur, float prev) {
    const int o = __builtin_amdgcn_update_dpp(0, __builtin_bit_cast(int, prev), 0x121, 0xf, 0xf, false);
    return __builtin_bit_cast(float, __builtin_amdgcn_update_dpp(o, __builtin_bit_cast(int, cur), 0x111, 0xf, 0xf, false));
}
__device__ __forceinline__ float dpp_shr2(float cur, float prev) {
    const int o = __builtin_amdgcn_update_dpp(0, __builtin_bit_cast(int, prev), 0x122, 0xf, 0xf, false);
    return __builtin_bit_cast(float, __builtin_amdgcn_update_dpp(o, __builtin_bit_cast(int, cur), 0x112, 0xf, 0xf, false));
}
__device__ __forceinline__ float silu_f(float g) { return g * __builtin_amdgcn_rcpf(1.0f + __builtin_amdgcn_exp2f(-1.4426950408889634f * g)); }
struct EpiGate {
    static constexpr bool PERM = true, AFTER_DRAIN = false;
    bf16_t* ACT; int ldc;
    const float* cw; const float* cb;
    float* GB; float* GF; float* VF;
    const float* ssq;
    const PG8_LAS float* rsL; const PG8_LAS float* cwL; int pm0, pn0, nslot;
    __device__ __forceinline__ void operator()(const f32x4 (&acc)[2][2][4][2], const Unit& u, int wr, int wc, int fr, int fq) const {
        const int c0 = u.pn * HALF + wc * 32 + 8 * fq;
        const int dpn = u.pn - pn0; const bool fast = (u.pm == pm0) && dpn >= 0 && (dpn & 3) == 0 && (dpn >> 2) < nslot;
        f32x4 w0[2], w1[2], w2[2], bb[2];
        if (fast) { const PG8_LAS float* cp = cwL + (dpn >> 2) * 512 + wc * 32 + 8 * fq;
#pragma unroll
            for (int n = 0; n < 2; ++n) { w0[n] = *(const PG8_LAS f32x4*)(cp + 4 * n); w1[n] = *(const PG8_LAS f32x4*)(cp + 128 + 4 * n); w2[n] = *(const PG8_LAS f32x4*)(cp + 256 + 4 * n); bb[n] = *(const PG8_LAS f32x4*)(cp + 384 + 4 * n); }
        } else {
#pragma unroll
            for (int n = 0; n < 2; ++n) { w0[n] = *(const f32x4*)(cw + c0 + 4 * n); w1[n] = *(const f32x4*)(cw + ldc + c0 + 4 * n); w2[n] = *(const f32x4*)(cw + 2 * ldc + c0 + 4 * n); bb[n] = *(const f32x4*)(cb + c0 + 4 * n); }
        }
#pragma unroll
        for (int ai = 0; ai < 2; ++ai) {
            const int g64 = u.pm * 4 + ai * 2 + wr;
            float rs[4];
            if (fast) {
#pragma unroll
                for (int m = 0; m < 4; ++m) rs[m] = rsL[ai * HALF + wr * 64 + m * 16 + fr];
            } else {
#pragma unroll
                for (int m = 0; m < 4; ++m) rs[m] = rsqrtf(ssq[u.pm * BM + ai * HALF + wr * 64 + m * 16 + fr] * (1.0f / 4096.0f) + 1e-6f);
            }
#pragma unroll
            for (int m = 0; m < 4; ++m) {
                const int row = u.pm * BM + ai * HALF + wr * 64 + m * 16 + fr;
                f32x4 a[2];
#pragma unroll
                for (int n = 0; n < 2; ++n)
#pragma unroll
                    for (int j = 0; j < 4; ++j) {
                        const float cur = acc[ai][0][m][n][j] * rs[m], prev = acc[ai][0][m > 0 ? m - 1 : 0][n][j] * rs[m > 0 ? m - 1 : 0];
                        const float s1 = dpp_shr1(cur, prev), s2 = dpp_shr2(cur, prev);
                        const float g = w2[n][j] * cur + w1[n][j] * s1 + w0[n][j] * s2 + bb[n][j];
                        a[n][j] = silu_f(g) * (acc[ai][1][m][n][j] * rs[m]);
                    }
                if (m == 0 && fr < 2) {
                    float* gf = GF + ((size_t)g64 * 2 + fr) * ldc + c0; float* vf = VF + ((size_t)g64 * 2 + fr) * ldc + c0;
                    *(f32x4*)gf = acc[ai][0][0][0] * rs[0]; *(f32x4*)(gf + 4) = acc[ai][0][0][1] * rs[0]; *(f32x4*)vf = acc[ai][1][0][0] * rs[0]; *(f32x4*)(vf + 4) = acc[ai][1][0][1] * rs[0];
                } else {
                    u32x4 w; w.x = cvt_pk_bf16(a[0][0], a[0][1]); w.y = cvt_pk_bf16(a[0][2], a[0][3]); w.z = cvt_pk_bf16(a[1][0], a[1][1]); w.w = cvt_pk_bf16(a[1][2], a[1][3]);
                    *(u32x4*)(ACT + (size_t)row * ldc + c0) = w;
                }
                if (m == 3 && fr >= 14) { float* gb = GB + ((size_t)g64 * 2 + (fr - 14)) * ldc + c0; *(f32x4*)gb = acc[ai][0][3][0] * rs[3]; *(f32x4*)(gb + 4) = acc[ai][0][3][1] * rs[3]; }
            }
        }
    }
};
template <class Epi, class Sched, bool ALIGN_EPI = false, bool SP2 = false>
__device__ __forceinline__ void gemm_phase(PG8_LAS unsigned char* lds, const Gemm g, const Sched& S, const Epi& E, const int tid) {
    const int wid = __builtin_amdgcn_readfirstlane(tid >> 6), lane = tid & 63, wr = wid >> 2, wc = wid & 3, fr = lane & 15, fq = lane >> 4;
    const int K = g.K, nt = K / BK;
    unsigned voffA[2], voffB[2];
#pragma unroll
    for (int i = 0; i < 2; ++i) { int R, C; stage_rc(tid * 16 + i * 8192, R, C); const int Rb = Epi::PERM ? ((R & ~31) + perm32(R & 31)) : R;
        voffA[i] = (unsigned)(R * K + C) * 2u; voffB[i] = (unsigned)(Rb * K + C) * 2u; }
    const size_t kstep = (size_t)(BK * 2);
    const size_t hstep = (size_t)HALF * K * 2;
    const size_t tstep = 2 * hstep;
    const unsigned ldsw = (unsigned)wid * 1024u;
    const int aoff = lds_byte(wr * 64 + fr, fq * 8), boff = lds_byte(wc * 32 + fr, fq * 8);
#define PG8_SA(b, h) (((b) * 2 + (h)) * HTB)
#define PG8_SB(b, h) ((4 + (b) * 2 + (h)) * HTB)
#define PG8_STAGE(bufoff, gbase, voff) do { _Pragma("unroll") for (int _i = 0; _i < 2; ++_i) \
        __builtin_amdgcn_global_load_lds((const unsigned*)((const char*)(gbase) + (voff)[_i]), (PG8_LAS unsigned*)(lds + (bufoff) + ldsw + _i * 8192), 16, 0, 0); } while (0)
#define PG8_LDA(dst, b, h) do { _Pragma("unroll") for (int m = 0; m < 4; ++m) _Pragma("unroll") for (int k = 0; k < 2; ++k) dst[m][k] = *(const PG8_LAS bf16x8*)(lds + PG8_SA(b, h) + aoff + m * 2048 + k * 1024); } while (0)
#define PG8_LDB(dst, b, h) do { _Pragma("unroll") for (int n = 0; n < 2; ++n) _Pragma("unroll") for (int k = 0; k < 2; ++k) dst[n][k] = *(const PG8_LAS bf16x8*)(lds + PG8_SB(b, h) + boff + n * 2048 + k * 1024); } while (0)
#define PG8_MMA(ai, bj, At, Bt) do { __builtin_amdgcn_s_setprio(1); _Pragma("unroll") for (int m = 0; m < 4; ++m) _Pragma("unroll") for (int n = 0; n < 2; ++n) _Pragma("unroll") for (int k = 0; k < 2; ++k) \
        acc[ai][bj][m][n] = __builtin_amdgcn_mfma_f32_16x16x32_bf16(Bt[n][k], At[m][k], acc[ai][bj][m][n], 0, 0, 0); __builtin_amdgcn_s_setprio(0); } while (0)
#define PG8_WAIT_V(n) asm volatile("s_waitcnt vmcnt(" #n ")" ::: "memory")
#define PG8_WAIT_L(n) asm volatile("s_waitcnt lgkmcnt(" #n ")" ::: "memory")
#define PG8_BAR __builtin_amdgcn_s_barrier()
#define PG8_SCHED __builtin_amdgcn_sched_barrier(0)
    Unit cur, nxt; int ui = 0;
    if (!S.next(0, cur)) return;
    f32x4 acc[2][2][4][2];
#pragma unroll
    for (int a = 0; a < 2; ++a)
#pragma unroll
        for (int b = 0; b < 2; ++b)
#pragma unroll
            for (int m = 0; m < 4; ++m)
#pragma unroll
                for (int n = 0; n < 2; ++n) acc[a][b][m][n] = (f32x4){0.f, 0.f, 0.f, 0.f};
    bf16x8 At[4][2], B0[2][2], B1[2][2];
    const char* cA = (const char*)g.A + (size_t)cur.pm * tstep; const char* cB = (const char*)g.Bt + (size_t)cur.pn * tstep;
    S.a_ready(cur);
    if constexpr (SP2) {
        PG8_STAGE(PG8_SB(0, 0), cB, voffB); PG8_STAGE(PG8_SB(0, 1), cB + hstep, voffB); PG8_STAGE(PG8_SA(0, 0), cA, voffA); PG8_STAGE(PG8_SA(0, 1), cA + hstep, voffA);
        if (wr == 1) PG8_BAR;
        PG8_WAIT_V(2); PG8_BAR;
        PG8_STAGE(PG8_SB(1, 0), cB + kstep, voffB); PG8_STAGE(PG8_SA(1, 0), cA + kstep, voffA); PG8_STAGE(PG8_SB(1, 1), cB + hstep + kstep, voffB);
        PG8_WAIT_V(6); PG8_BAR;
    } else {
        PG8_STAGE(PG8_SB(0, 0), cB, voffB); PG8_STAGE(PG8_SA(0, 0), cA, voffA); PG8_STAGE(PG8_SB(0, 1), cB + hstep, voffB); PG8_STAGE(PG8_SA(0, 1), cA + hstep, voffA);
        if (wr == 1) PG8_BAR;
        PG8_WAIT_V(4); PG8_BAR;
        PG8_STAGE(PG8_SB(1, 0), cB + kstep, voffB); PG8_STAGE(PG8_SA(1, 0), cA + kstep, voffA); PG8_STAGE(PG8_SB(1, 1), cB + hstep + kstep, voffB);
        PG8_WAIT_V(6); PG8_BAR;
    }
    for (;;) {
        const bool has_next = S.next(ui + 1, nxt);
        const char* nA = has_next ? (const char*)g.A + (size_t)nxt.pm * tstep : cA; const char* nB = has_next ? (const char*)g.Bt + (size_t)nxt.pn * tstep : cB;
        for (int t = 0; t < nt; t += 2) {
            const bool last = (t == nt - 2);
            const char* a1 = cA + (size_t)(t + 1) * kstep;
            const char* a2 = last ? nA : cA + (size_t)(t + 2) * kstep; const char* b2 = last ? nB : cB + (size_t)(t + 2) * kstep;
            const char* a3 = a2 + kstep; const char* b3 = b2 + kstep;
            if (last && has_next) S.a_ready(nxt);
            if constexpr (SP2) {
            PG8_LDB(B0, 0, 0); PG8_LDB(B1, 0, 1); PG8_SCHED; PG8_LDA(At, 0, 0); PG8_STAGE(PG8_SA(1, 1), a1 + hstep, voffA);
            PG8_WAIT_V(8); PG8_WAIT_L(0); PG8_BAR; PG8_MMA(0, 0, At, B0); PG8_MMA(0, 1, At, B1); PG8_BAR; PG8_SCHED;
            PG8_LDA(At, 0, 1); PG8_STAGE(PG8_SB(0, 0), b2, voffB); PG8_STAGE(PG8_SB(0, 1), b2 + hstep, voffB); PG8_STAGE(PG8_SA(0, 0), a2, voffA);
            PG8_WAIT_V(8); PG8_WAIT_L(0); PG8_BAR; PG8_MMA(1, 0, At, B0); PG8_MMA(1, 1, At, B1); PG8_BAR; PG8_SCHED;
            PG8_LDB(B0, 1, 0); PG8_LDB(B1, 1, 1); PG8_SCHED; PG8_LDA(At, 1, 0); PG8_STAGE(PG8_SA(0, 1), a2 + hstep, voffA);
            PG8_WAIT_V(8); PG8_WAIT_L(0); PG8_BAR; PG8_MMA(0, 0, At, B0); PG8_MMA(0, 1, At, B1); PG8_BAR; PG8_SCHED;
            PG8_LDA(At, 1, 1); PG8_STAGE(PG8_SB(1, 0), b3, voffB); PG8_STAGE(PG8_SB(1, 1), b3 + hstep, voffB); PG8_STAGE(PG8_SA(1, 0), a3, voffA);
            PG8_WAIT_V(8); PG8_WAIT_L(0); PG8_BAR; PG8_MMA(1, 0, At, B0); PG8_MMA(1, 1, At, B1); PG8_BAR; PG8_SCHED;
            } else {
            PG8_LDB(B0, 0, 0); PG8_SCHED; PG8_LDA(At, 0, 0); PG8_STAGE(PG8_SA(1, 1), a1 + hstep, voffA);
            PG8_WAIT_L(8); PG8_BAR; PG8_WAIT_L(0); PG8_MMA(0, 0, At, B0); PG8_BAR; PG8_SCHED;
            PG8_LDB(B1, 0, 1); PG8_STAGE(PG8_SB(0, 0), b2, voffB);
            PG8_BAR; PG8_WAIT_L(0); PG8_MMA(0, 1, At, B1); PG8_BAR;
            PG8_LDA(At, 0, 1); PG8_STAGE(PG8_SA(0, 0), a2, voffA);
            PG8_BAR; PG8_WAIT_L(0); PG8_MMA(1, 0, At, B0); PG8_BAR; PG8_SCHED;
            PG8_STAGE(PG8_SB(0, 1), b2 + hstep, voffB);
            PG8_WAIT_V(6); PG8_BAR; PG8_MMA(1, 1, At, B1); PG8_BAR;
            PG8_LDB(B0, 1, 0); PG8_SCHED; PG8_LDA(At, 1, 0); PG8_STAGE(PG8_SA(0, 1), a2 + hstep, voffA);
            PG8_WAIT_L(8); PG8_BAR; PG8_WAIT_L(0); PG8_MMA(0, 0, At, B0); PG8_BAR; PG8_SCHED;
            PG8_LDB(B1, 1, 1); PG8_STAGE(PG8_SB(1, 0), b3, voffB);
            PG8_BAR; PG8_WAIT_L(0); PG8_MMA(0, 1, At, B1); PG8_BAR;
            PG8_LDA(At, 1, 1); PG8_STAGE(PG8_SA(1, 0), a3, voffA);
            PG8_BAR; PG8_WAIT_L(0); PG8_MMA(1, 0, At, B0); PG8_BAR; PG8_SCHED;
            PG8_STAGE(PG8_SB(1, 1), b3 + hstep, voffB);
            PG8_WAIT_V(6); PG8_BAR; PG8_MMA(1, 1, At, B1); PG8_BAR;
            }
        }
        if constexpr (ALIGN_EPI) { if (wr == 0) PG8_BAR; }
        if constexpr (!Epi::AFTER_DRAIN) { E(acc, cur, wr, wc, fr, fq); S.done(cur); }
        if (!has_next) break;
#pragma unroll
        for (int a = 0; a < 2; ++a)
#pragma unroll
            for (int b = 0; b < 2; ++b)
#pragma unroll
                for (int m = 0; m < 4; ++m)
#pragma unroll
                    for (int n = 0; n < 2; ++n) acc[a][b][m][n] = (f32x4){0.f, 0.f, 0.f, 0.f};
        cur = nxt; cA = nA; cB = nB; ++ui;
        if constexpr (ALIGN_EPI) { if (wr == 1) PG8_BAR; }
    }
    PG8_WAIT_V(0);
    if constexpr (!ALIGN_EPI) { if (wr == 0) PG8_BAR; }
    PG8_BAR;
    if constexpr (Epi::AFTER_DRAIN) { E.fused(acc, cur, wr, wc, fr, fq, lds, wid, lane); S.done(cur); }
#undef PG8_SA
#undef PG8_SB
#undef PG8_STAGE
#undef PG8_LDA
#undef PG8_LDB
#undef PG8_MMA
#undef PG8_WAIT_V
#undef PG8_WAIT_L
#undef PG8_BAR
#undef PG8_SCHED
}
}
namespace att {
typedef unsigned short bf16_t;
typedef short bf16x8 __attribute__((ext_vector_type(8)));
typedef short s16x4 __attribute__((ext_vector_type(4)));
typedef float f32x16 __attribute__((ext_vector_type(16)));
typedef float f32x4 __attribute__((ext_vector_type(4)));
typedef unsigned u32x4 __attribute__((ext_vector_type(4)));
constexpr int D = 128;
constexpr float SCALE = 0.08838834764831845f;
constexpr float THR = 8.f;
constexpr int NW = 8, QBLK = 32, KVBLK = 64, QB = NW * QBLK;
constexpr int SHM_V = KVBLK * D * 2, SHM_K = KVBLK * D * 2;
constexpr int LDS_TILES = 2 * SHM_V + 2 * SHM_K + NW * 64 * 4;
constexpr int LDS_BIAS = LDS_TILES;
constexpr int LDS_DTAB = LDS_BIAS + 32768 + 2048;
constexpr int DTAB_STRIDE = 132 * 4, DTAB_BYTES = 48 * DTAB_STRIDE;
constexpr int LDS_END = LDS_DTAB + DTAB_BYTES + 2048;
constexpr int DILW = 129;

#define KSWZ(row, colB) ((row) * 256 + ((colB) ^ (((row) & 7) << 4)))
#define SBAR() __builtin_amdgcn_sched_barrier(0)
__device__ __forceinline__ int v_st(int k, int c) { const int kk = (k & ~0xC) | ((k & 4) << 1) | ((k & 8) >> 1); return ((kk >> 3) * 4 + (c >> 5)) * 512 + ((kk & 7) * 32 + (c & 31)) * 2; }
__device__ __forceinline__ int v_rd_base(int lane) { return ((lane & 3) << 3) | (((lane >> 2) & 3) << 6) | (((lane >> 4) & 1) << 5) | (((lane >> 5) & 1) << 8); }
constexpr int v_rd_off(int d0, int ks, int half) { return d0 * 512 + ks * 4096 + half * 2048; }
__device__ __forceinline__ int crow(int r, int hi) { return (r & 3) + 8 * (r >> 2) + 4 * hi; }
__device__ __forceinline__ unsigned cvtpk(float lo, float hi) { unsigned r; asm volatile("v_cvt_pk_bf16_f32 %0, %1, %2" : "=v"(r) : "v"(lo), "v"(hi)); return r; }
__device__ __forceinline__ bf16x8 gld8(const void* ubase, unsigned voff) { return *reinterpret_cast<const bf16x8*>((const char*)ubase + voff); }
__device__ __forceinline__ void mask_tile(f32x16& p0, f32x16& p1, int dq, unsigned W) {
    const float NEG = -__builtin_inff();
#pragma unroll
    for (int r = 0; r < 16; ++r) {
        const int c = (r & 3) + 8 * (r >> 2);
        if ((unsigned)(dq - c) >= W) p0[r] = NEG;
        if ((unsigned)(dq - c - 32) >= W) p1[r] = NEG;
    }
}
__device__ __forceinline__ void partialSM(f32x16& p0, f32x16& p1, float& m_reg, float& mn, float& alpha) {
    float pmax = p0[0]; for (int r = 1; r < 16; ++r) pmax = fmaxf(pmax, p0[r]); for (int r = 0; r < 16; ++r) pmax = fmaxf(pmax, p1[r]);
    { auto rr = __builtin_amdgcn_permlane32_swap(__float_as_uint(pmax), __float_as_uint(pmax), false, false);
      pmax = fmaxf(__uint_as_float(rr[0]), __uint_as_float(rr[1])); }
    constexpr float C2 = 1.4426950408889634f * SCALE;
    if (__builtin_expect(__all((pmax - m_reg) * SCALE <= THR), 1)) { mn = m_reg; alpha = 1.f; }
    else { mn = fmaxf(m_reg, pmax); alpha = __builtin_amdgcn_exp2f((m_reg - mn) * C2); m_reg = mn; }
    const float mnL = -mn * C2;
    for (int r = 0; r < 16; ++r) p0[r] = fmaf(p0[r], C2, mnL); for (int r = 0; r < 16; ++r) p1[r] = fmaf(p1[r], C2, mnL);
    for (int r = 0; r < 16; ++r) p0[r] = __builtin_amdgcn_exp2f(p0[r]);
}
__device__ __forceinline__ void finishSM(f32x16& p0, f32x16& p1, float alpha, float& l_reg, bf16x8& pa0, bf16x8& pa1, bf16x8& pa2, bf16x8& pa3) {
    for (int r = 0; r < 16; ++r) p1[r] = __builtin_amdgcn_exp2f(p1[r]);
    float ps = 0; for (int r = 0; r < 16; ++r) ps += p0[r]; for (int r = 0; r < 16; ++r) ps += p1[r];
    { auto rr = __builtin_amdgcn_permlane32_swap(__float_as_uint(ps), __float_as_uint(ps), false, false);
      ps = __uint_as_float(rr[0]) + __uint_as_float(rr[1]); }
    l_reg = l_reg * alpha + ps;
#define PK4(P, B_, OUT) do { unsigned a0 = cvtpk(P[B_+0], P[B_+1]), a1 = cvtpk(P[B_+2], P[B_+3]);                          \
        unsigned b0 = cvtpk(P[B_+4], P[B_+5]), b1 = cvtpk(P[B_+6], P[B_+7]);                                             \
        auto r0 = __builtin_amdgcn_permlane32_swap(a0, b0, false, false); auto r1 = __builtin_amdgcn_permlane32_swap(a1, b1, false, false); \
        u32x4 w = {r0[0], r1[0], r0[1], r1[1]}; OUT = *reinterpret_cast<bf16x8*>(&w); } while (0)
    PK4(p0, 0, pa0); PK4(p0, 8, pa1); PK4(p1, 0, pa2); PK4(p1, 8, pa3);
#undef PK4
}
template <int KB, int MODE>
__device__ __forceinline__ void qkt(f32x16& p0, f32x16& p1, const char* K_lds, int r32, int hi, const bf16x8* qr, bool act, const char* bptr, int dq) {
    constexpr bool SK = MODE == 1;
    const float NEG = -__builtin_inff();
    if (SK && !act) {
#pragma unroll
        for (int r = 0; r < 16; ++r) { p0[r] = NEG; p1[r] = NEG; } return; }
    if (MODE == 0) {
#pragma unroll
        for (int g = 0; g < 4; ++g) { const f32x4 v0 = *(const f32x4*)(bptr + 32 * g), v1 = *(const f32x4*)(bptr + 128 + 32 * g);
#pragma unroll
            for (int j = 0; j < 4; ++j) { p0[4 * g + j] = v0[j]; p1[4 * g + j] = v1[j]; } }
    } else {
#pragma unroll
        for (int r = 0; r < 16; ++r) { const int c = (r & 3) + 8 * (r >> 2);
            const float b0 = *(const float*)(bptr + 4 * c), b1 = *(const float*)(bptr + 4 * c + 128);
            p0[r] = ((unsigned)(dq - c) < (unsigned)DILW) ? b0 : NEG; p1[r] = ((unsigned)(dq - c - 32) < (unsigned)DILW) ? b1 : NEG; }
    }
    const char* kb[4];
#pragma unroll
    for (int dd = 0; dd < 4; ++dd) kb[dd] = K_lds + KB * SHM_K + KSWZ(r32, (dd * 16 + hi * 8) * 2);
#pragma unroll
    for (int d0 = 0; d0 < 8; ++d0) { const char* a = kb[d0 & 3] + (d0 >> 2) * 128;
        bf16x8 b0 = *reinterpret_cast<const bf16x8*>(a);
        bf16x8 b1 = *reinterpret_cast<const bf16x8*>(a + 32 * 256);
        p0 = __builtin_amdgcn_mfma_f32_32x32x16_bf16(b0, qr[d0], p0, 0, 0, 0);
        p1 = __builtin_amdgcn_mfma_f32_32x32x16_bf16(b1, qr[d0], p1, 0, 0, 0); }
}
template <int VB, bool SK>
__device__ __forceinline__ void pv_tile(f32x16* o, int vb0, bf16x8 pa0, bf16x8 pa1, bf16x8 pa2, bf16x8 pa3, bool act) {
    if (SK && !act) return;
#define TRRD(dst, off) asm volatile("ds_read_b64_tr_b16 %0, %1 offset:%2" : "=&v"(dst) : "v"(vb0), "i"(off) : "memory")
#define PV_D0(d0) do { s16x4 l0, l1, l2, l3, h0, h1, h2, h3; constexpr int b_ = VB * SHM_V + v_rd_off(d0, 0, 0);  \
        TRRD(l0, b_); TRRD(h0, b_ + 2048); TRRD(l1, b_ + 4096); TRRD(h1, b_ + 6144); TRRD(l2, b_ + 8192); TRRD(h2, b_ + 10240); TRRD(l3, b_ + 12288); TRRD(h3, b_ + 14336); \
        asm volatile("s_waitcnt lgkmcnt(0)" ::: "memory"); SBAR();   \
        o[d0] = __builtin_amdgcn_mfma_f32_32x32x16_bf16(pa0, (bf16x8){l0[0], l0[1], l0[2], l0[3], h0[0], h0[1], h0[2], h0[3]}, o[d0], 0, 0, 0);   \
        o[d0] = __builtin_amdgcn_mfma_f32_32x32x16_bf16(pa1, (bf16x8){l1[0], l1[1], l1[2], l1[3], h1[0], h1[1], h1[2], h1[3]}, o[d0], 0, 0, 0);   \
        o[d0] = __builtin_amdgcn_mfma_f32_32x32x16_bf16(pa2, (bf16x8){l2[0], l2[1], l2[2], l2[3], h2[0], h2[1], h2[2], h2[3]}, o[d0], 0, 0, 0);   \
        o[d0] = __builtin_amdgcn_mfma_f32_32x32x16_bf16(pa3, (bf16x8){l3[0], l3[1], l3[2], l3[3], h3[0], h3[1], h3[2], h3[3]}, o[d0], 0, 0, 0); } while (0)
    PV_D0(0); PV_D0(1); PV_D0(2); PV_D0(3);
#undef PV_D0
#undef TRRD
}

struct BlockRef { const bf16_t* Q; const bf16_t* K; const bf16_t* V; bf16_t* O; float* lse; const float* gb; int P0, rs, os, ls, jlo, tab; };
struct Seam { bf16x8 qr[8]; bf16x8 st_v0, st_v1, st_k0, st_k1; };
#define ROWP(p, rs_, k0, rr) ((p) + (size_t)((k0) + (rr)) * (rs_) + sc)
#define VMW() asm volatile("s_waitcnt vmcnt(0)" ::: "memory")
#define VMWN(n) asm volatile("s_waitcnt vmcnt(%0)" :: "i"(n) : "memory")
#define SLOAD_H(Kp, Vp, rs_, k0, vo) do { const char* kb_ = (const char*)((Kp) + (size_t)(k0) * (rs_)); const char* vb_ = (const char*)((Vp) + (size_t)(k0) * (rs_)); const size_t h_ = (size_t)64 * (rs_); \
                         S.st_v0 = gld8(vb_, vo); S.st_v1 = gld8(vb_ + h_, vo); S.st_k0 = gld8(kb_, vo); S.st_k1 = gld8(kb_ + h_, vo); } while (0)
#define SWRITE_HK(bf) do { *(bf16x8*)(K_lds + (bf) * SHM_K + kws) = S.st_k0; *(bf16x8*)(K_lds + (bf) * SHM_K + kws + 32 * 256) = S.st_k1; } while (0)
#define SWRITE_HV(bf) do { *(bf16x8*)(V_lds + (bf) * SHM_V + vst0) = S.st_v0; *(bf16x8*)(V_lds + (bf) * SHM_V + vst1) = S.st_v1; } while (0)
#define SWRITE_H(bf) do { SWRITE_HV(bf); SWRITE_HK(bf); } while (0)
__device__ __forceinline__ void attn_prime(const BlockRef& cur, char* lds, Seam& S, const int tid) {
    const int wid = __builtin_amdgcn_readfirstlane(tid >> 6), lane = tid & 63, r32 = lane & 31, hi = lane >> 5;
    const int sr = tid >> 4, sc = (tid & 15) * 8, kws = KSWZ(sr, sc * 2); char* K_lds = lds + 2 * SHM_V;
    const int kb0 = cur.jlo * KVBLK;
    { const char* qb_ = (const char*)(cur.Q + (size_t)(wid * QBLK) * cur.rs); const unsigned qv_ = (unsigned)(r32 * cur.rs + hi * 8) * 2u;
      for (int d0 = 0; d0 < 8; ++d0) S.qr[d0] = gld8(qb_ + d0 * 32, qv_); }
    { const unsigned vo_ = (unsigned)(sr * cur.rs + sc) * 2u; SLOAD_H(cur.K, cur.V, cur.rs, kb0, vo_); } VMW(); SWRITE_HK(0);
    __syncthreads();
}
template <int MODE>
__device__ __forceinline__ void attn_block(const BlockRef& cur, const BlockRef& nxt, char* lds, Seam& S, const int tid) {
    constexpr bool SK = MODE == 1;
    constexpr int W = MODE == 1 ? DILW : (1 << 30);
    const int wid = __builtin_amdgcn_readfirstlane(tid >> 6), lane = tid & 63, r32 = lane & 31, hi = lane >> 5;
    const int j_lo = cur.jlo;
    const int j_hi = (cur.P0 + QB - 1) / KVBLK + 1;
    const int NT = j_hi - j_lo;
    const int kbn = nxt.jlo * KVBLK;
    const int qlo = cur.P0 + wid * QBLK, qm = qlo + r32 - 4 * hi;
    char* V_lds = lds; char* K_lds = lds + 2 * SHM_V;
    float* ws = (float*)(lds + 2 * SHM_V + 2 * SHM_K) + wid * 64; float* li_l = ws, * al_l = ws + 32;
    float m_reg = -1e30f, l_reg = 0; f32x16 o[4] = {};
    const int sr = tid >> 4, sc = (tid & 15) * 8, vst0 = v_st(sr, sc), vst1 = v_st(32 + sr, sc), kws = KSWZ(sr, sc * 2);
    const int vb0 = (int)(uintptr_t)V_lds + v_rd_base(lane);
    const bf16_t* Kh = cur.K; const bf16_t* Vh = cur.V; const int rs = cur.rs; const unsigned kvo = (unsigned)(sr * rs + sc) * 2u;
    const char* bb0 = (MODE == 0) ? (lds + LDS_BIAS + hi * 16) : (lds + cur.tab + (128 - qm) * 4);
#define RESC(a) do { if (__any((a) < 1.f)) { if (hi == 0) al_l[r32] = (a); asm volatile("s_waitcnt lgkmcnt(0)" ::: "memory");              \
                     for (int d_ = 0; d_ < 4; ++d_) for (int r = 0; r < 16; ++r) o[d_][r] *= al_l[crow(r, hi)]; } } while (0)
#define KBASE(t) ((j_lo + (t)) * KVBLK)
#define ACT(t) (KBASE(t) <= qlo + QBLK - 1 && KBASE(t) + KVBLK - 1 >= qlo - W + 1)
#define MASKT(P0_, P1_, t) do { if (MODE == 0) { const int kb_ = KBASE(t); if (kb_ + KVBLK - 1 > qlo) mask_tile(P0_, P1_, qm - kb_, (unsigned)W); } } while (0)
#define QKT(KB, PX0, PX1, t) qkt<KB, MODE>(PX0, PX1, K_lds, r32, hi, S.qr, ACT(t), bb0 + KBASE(t) * 4, qm - KBASE(t))
#define PSM(PX0, PX1, mnX, alX, t) do { if (!SK || ACT(t)) partialSM(PX0, PX1, m_reg, mnX, alX); else { mnX = m_reg; alX = 1.f; } } while (0)
#define FSM(PY0, PY1, alY, t) do { if (!SK || ACT(t)) finishSM(PY0, PY1, alY, l_reg, pa0, pa1, pa2, pa3); } while (0)
    constexpr int NQL = 8;
#define SEAM_K0() do { VMWN(NQL); SWRITE_HK(0); SBAR(); } while (0)
    f32x16 pA0, pA1, pB0, pB1; float mnA, mnB, alA, alB; bf16x8 pa0, pa1, pa2, pa3;
    SWRITE_HV(0); SBAR();
    if (NT > 1) { SLOAD_H(Kh, Vh, rs, KBASE(1), kvo); }
    SBAR(); QKT(0, pA0, pA1, 0);
    MASKT(pA0, pA1, 0); PSM(pA0, pA1, mnA, alA, 0);
    if (NT > 1) { VMW(); SWRITE_H(1); }
    __syncthreads();
#define HALF_STEP(PX0, PX1, mnX, alX, PY0, PY1, alY, t, KB, VB, SB) do {                                                      \
        SBAR(); QKT(KB, PX0, PX1, t);                                             \
        FSM(PY0, PY1, alY, (t) - 1); SBAR();                                                           \
        if ((t) + 1 < NT) { SLOAD_H(Kh, Vh, rs, KBASE((t) + 1), kvo); SBAR(); }                                               \
        pv_tile<VB, SK>(o, vb0, pa0, pa1, pa2, pa3, ACT((t) - 1)); MASKT(PX0, PX1, (t)); PSM(PX0, PX1, mnX, alX, (t));                                        \
        __syncthreads();                                                                                                      \
        if ((t) + 1 < NT) { VMW(); SWRITE_H(SB); }                                                                          \
        RESC(alX); __syncthreads(); } while (0)
    for (int t = 1; t + 1 < NT; t += 2) {
        HALF_STEP(pB0, pB1, mnB, alB, pA0, pA1, alA, t, 1, 0, 0);
        HALF_STEP(pA0, pA1, mnA, alA, pB0, pB1, alB, t + 1, 0, 1, 1);
    }
    const bool even = (NT & 1) == 0;
    if (even) { SBAR(); QKT(1, pB0, pB1, NT - 1); SBAR(); }
    { const unsigned vo_ = (unsigned)(sr * nxt.rs + sc) * 2u; SLOAD_H(nxt.K, nxt.V, nxt.rs, kbn, vo_); } SBAR();
    { const char* qb_ = (const char*)(nxt.Q + (size_t)(wid * QBLK) * nxt.rs); const unsigned qv_ = (unsigned)(r32 * nxt.rs + hi * 8) * 2u;
#pragma unroll
      for (int d0 = 0; d0 < 8; ++d0) S.qr[d0] = gld8(qb_ + d0 * 32, qv_); }
    SBAR();
    FSM(pA0, pA1, alA, (even ? NT - 2 : NT - 1)); SBAR();
    pv_tile<0, SK>(o, vb0, pa0, pa1, pa2, pa3, ACT(even ? NT - 2 : NT - 1));
    if (even) { MASKT(pB0, pB1, NT - 1); PSM(pB0, pB1, mnB, alB, NT - 1); __syncthreads(); RESC(alB);
        FSM(pB0, pB1, alB, NT - 1); SBAR(); pv_tile<1, SK>(o, vb0, pa0, pa1, pa2, pa3, ACT(NT - 1)); }
    SBAR(); SEAM_K0();
    if (hi == 0) li_l[r32] = l_reg; asm volatile("s_waitcnt lgkmcnt(0)" ::: "memory");
    float rli[16];
#pragma unroll
    for (int r = 0; r < 16; ++r) rli[r] = __builtin_amdgcn_rcpf(li_l[crow(r, hi)]);
    int os_ = __builtin_amdgcn_readfirstlane(cur.os); asm volatile("" : "+s"(os_));
    bf16_t* Ow = cur.O + (size_t)(wid * QBLK) * os_; const unsigned ovo = (unsigned)(4 * hi * os_ + r32) * 2u;
#pragma unroll
    for (int r = 0; r < 16; ++r) { char* ob_ = (char*)(Ow + (size_t)((r & 3) + 8 * (r >> 2)) * os_);
#pragma unroll
        for (int d0 = 0; d0 < 4; ++d0) { const float v = o[d0][r] * rli[r];
            const float vn = __shfl_xor(v, 1);
            if ((r32 & 1) == 0) *(unsigned*)(ob_ + d0 * 64 + ovo) = cvtpk(v, vn); } }
    if (MODE == 0) {
#pragma unroll
        for (int r = 0; r < 16; ++r) { float ss = 0.f;
#pragma unroll
            for (int d0 = 0; d0 < 4; ++d0) { const float v = o[d0][r] * rli[r]; ss += v * v; }
            ss += __shfl_xor(ss, 1); ss += __shfl_xor(ss, 2); ss += __shfl_xor(ss, 4); ss += __shfl_xor(ss, 8); ss += __shfl_xor(ss, 16);
            if (r32 == 0) atomicAdd(cur.lse + (wid * QBLK + crow(r, hi)), ss); }
    }
    if (MODE == 1) { constexpr float C2 = 1.4426950408889634f * SCALE;
        if (hi == 0) cur.lse[(size_t)(wid * QBLK + r32) * cur.ls] = m_reg * C2 + __builtin_amdgcn_logf(l_reg); }
    __syncthreads();
#undef RESC
#undef KBASE
#undef ACT
#undef MASKT
#undef QKT
#undef PSM
#undef FSM
#undef SEAM_K0
#undef HALF_STEP
}
#undef ROWP
#undef VMW
#undef VMWN
#undef SLOAD_H
#undef SWRITE_HK
#undef SWRITE_HV
#undef SWRITE_H
#undef KSWZ
#undef SBAR
}
constexpr int SEQ = 8192, DM = 4096, NH = 16, HD = 128, FW = 2048, NQKV = 12288, INW = 12304, DFF = 11008, NUP = 22016;
constexpr float RMS_EPS = 1e-6f;
constexpr float INV_SCALE = 11.313708498984761f;
constexpr int NWAVES = 8;
constexpr size_t MiB = 1u << 20;
constexpr size_t WS_WIN = 0, WS_WF = 96 * MiB, WS_WOUT = 97 * MiB, WS_WUP = 129 * MiB, WS_WDN = 301 * MiB, WS_XN = 387 * MiB, WS_X1 = 453 * MiB, WS_ACT = 581 * MiB;
constexpr size_t WS_MISC = 753 * MiB, WS_CTL = WS_MISC + 3 * MiB, CTL_NORM = 64, CTL_SSQ = 4096, CTL_SSQ2 = 4096 + 32768, CTL_BAR = 4096 + 2 * 32768, CTL_SSQA = CTL_BAR + 16384, CTL_BYTES = CTL_SSQA + 32768;
constexpr size_t WS_LOGF = WS_MISC, WS_CNEG = WS_MISC + 1 * MiB, WS_TAB = WS_MISC + 2 * MiB, WS_GB = WS_MISC + 4 * MiB, WS_GF = WS_MISC + 16 * MiB, WS_VF = WS_MISC + 28 * MiB;
constexpr size_t WS_QKV = 817 * MiB, WS_OA = WS_QKV + 192 * MiB, WS_OB = WS_OA + 32 * MiB, WS_LSE = WS_OB + 96 * MiB, WS_MIX = WS_LSE + 2 * MiB, WS_END = WS_MIX + 64 * MiB;
static_assert((size_t)(SEQ / 64) * 2 * DFF * 4 <= 12 * MiB, "side buffers");
constexpr int EPI_SLOTS = 11;
constexpr int LDS_BYTES = 131072 + 1024 + EPI_SLOTS * 2048 + 1024;
static_assert(att::LDS_END <= 131072 + 8192, "attention LDS");
static_assert(8 * 16640 <= LDS_BYTES, "P0 transpose scratch");

#define LAS __attribute__((address_space(3)))
typedef unsigned short bf16;
typedef unsigned v4u __attribute__((ext_vector_type(4)));
typedef unsigned v2u __attribute__((ext_vector_type(2)));
typedef float f32x4 __attribute__((ext_vector_type(4)));
typedef short bf16x8 __attribute__((ext_vector_type(8)));
#define LDS_WAIT() asm volatile("s_waitcnt lgkmcnt(0)" ::: "memory")
__device__ __forceinline__ unsigned pk2(float lo, float hi) { unsigned r; asm volatile("v_cvt_pk_bf16_f32 %0, %1, %2" : "=v"(r) : "v"(lo), "v"(hi)); return r; }
__device__ __forceinline__ float bflo(unsigned u) { return __uint_as_float(u << 16); }
__device__ __forceinline__ float bfhi(unsigned u) { return __uint_as_float(u & 0xffff0000u); }
__device__ __forceinline__ float wave_sum(float v) {
#pragma unroll
    for (int o = 1; o < 64; o <<= 1) v += __shfl_xor(v, o);
    return v;
}
typedef float f32x2 __attribute__((ext_vector_type(2)));
__device__ __forceinline__ void tr_item(const float* W, size_t ldw, int Kdim, bf16* WT, LAS float* scr, int k0, int lane, const float* gk = nullptr) {
    const float* wp = W + (size_t)(k0 + (lane >> 5)) * ldw + 2 * (lane & 31); f32x2 v[32];
#pragma unroll
    for (int i = 0; i < 32; ++i) v[i] = *(const f32x2*)(wp + (size_t)(2 * i) * ldw);
#pragma unroll
    for (int i = 0; i < 32; ++i) { LAS float* d = scr + (2 * i + (lane >> 5)) * 65 + 2 * (lane & 31); d[0] = v[i].x; d[1] = v[i].y; }
    const int c = lane & 7;
    f32x4 g0 = {1.f, 1.f, 1.f, 1.f}, g1 = g0; if (gk) { g0 = *(const f32x4*)(gk + k0 + 8 * c); g1 = *(const f32x4*)(gk + k0 + 8 * c + 4); }
    LDS_WAIT(); asm volatile("" ::: "memory");
#pragma unroll
    for (int j = 0; j < 8; ++j) { const int n = (lane >> 3) + 8 * j; const LAS float* s = scr + (8 * c) * 65 + n;
        v4u o; o.x = pk2(s[0 * 65] * g0.x, s[1 * 65] * g0.y); o.y = pk2(s[2 * 65] * g0.z, s[3 * 65] * g0.w); o.z = pk2(s[4 * 65] * g1.x, s[5 * 65] * g1.y); o.w = pk2(s[6 * 65] * g1.z, s[7 * 65] * g1.w);
        *(v4u*)(WT + (size_t)n * Kdim + k0 + 8 * c) = o; }
    LDS_WAIT(); asm volatile("" ::: "memory");
}
__device__ __forceinline__ void rms_row_bf16(const float* xrow, const float* g, bf16* orow, int lane) {
    const f32x4* xr = (const f32x4*)xrow + lane; f32x4 v[16]; float s = 0.f;
#pragma unroll
    for (int j = 0; j < 16; ++j) { v[j] = xr[64 * j]; s += (v[j].x * v[j].x + v[j].y * v[j].y) + (v[j].z * v[j].z + v[j].w * v[j].w); }
    const float r = rsqrtf(wave_sum(s) * (1.f / DM) + RMS_EPS);
    const f32x4* gr = (const f32x4*)g + lane; v2u* o8 = (v2u*)orow + lane;
#pragma unroll
    for (int j = 0; j < 16; ++j) { const f32x4 gg = gr[64 * j]; v2u w; w.x = pk2(v[j].x * r * gg.x, v[j].y * r * gg.y); w.y = pk2(v[j].z * r * gg.z, v[j].w * r * gg.w); o8[64 * j] = w; }
}
__device__ __forceinline__ void rms_row_f32(const float* xrow, const float* g, float* orow, int lane) {
    const f32x4* xr = (const f32x4*)xrow + lane; f32x4 v[16]; float s = 0.f;
#pragma unroll
    for (int j = 0; j < 16; ++j) { v[j] = xr[64 * j]; s += (v[j].x * v[j].x + v[j].y * v[j].y) + (v[j].z * v[j].z + v[j].w * v[j].w); }
    const float r = rsqrtf(wave_sum(s) * (1.f / DM) + RMS_EPS);
    const f32x4* gr = (const f32x4*)g + lane; f32x4* o = (f32x4*)orow + lane;
#pragma unroll
    for (int j = 0; j < 16; ++j) { const f32x4 gg = gr[64 * j]; o[64 * j] = v[j] * r * gg; }
}
__device__ __forceinline__ int t5_bucket(int dist) {
    if (dist < 16) return dist;
    const float df = (float)dist;
    int large = 16 + (int)(logf(df / 16.0f) / 4.852030263919617f * 16.0f);
    return large < 31 ? large : 31;
}

__device__ __forceinline__ int lane_id_v() { int l; asm volatile("v_mbcnt_lo_u32_b32 %0, -1, 0\n\tv_mbcnt_hi_u32_b32 %0, -1, %0" : "=v"(l)); return l; }
#define XB_CEN(j)  (64 * (j))
#define XB_ARR(j)  (64 * (16 + (j)))
#define XB_REL(j)  (64 * (32 + (j)))
#define XB_TOP     (64 * 48)
#define XB_TOPGEN  (64 * 49)
#define XB_WORDS   (64 * 50)
__device__ __forceinline__ unsigned xb_ld(unsigned* p) { return __hip_atomic_load(p, __ATOMIC_RELAXED, __HIP_MEMORY_SCOPE_AGENT); }
__device__ __forceinline__ unsigned xb_add(unsigned* p, unsigned v) { return __hip_atomic_fetch_add(p, v, __ATOMIC_RELAXED, __HIP_MEMORY_SCOPE_AGENT); }
__device__ __forceinline__ void xb_st(unsigned* p, unsigned v) { __hip_atomic_store(p, v, __ATOMIC_RELAXED, __HIP_MEMORY_SCOPE_AGENT); }
__device__ __forceinline__ unsigned xcc_id() { return (unsigned)__builtin_amdgcn_s_getreg((3 << 11) | 20) & 0xFu; }
__device__ __forceinline__ void grid_barrier(unsigned* bar, unsigned r, unsigned x, unsigned nloc, unsigned nx, int tid) {
    asm volatile("s_waitcnt vmcnt(0) lgkmcnt(0)" ::: "memory");
    __syncthreads();
    if (tid == 0) {
        const unsigned old = xb_add(bar + XB_ARR(x), 1u);
        if (old + 1u == nloc * r) {
            __builtin_amdgcn_fence(__ATOMIC_RELEASE, "agent");
            asm volatile("s_waitcnt vmcnt(0)" ::: "memory");
            const unsigned o2 = xb_add(bar + XB_TOP, 1u);
            if (o2 + 1u == nx * r) xb_st(bar + XB_TOPGEN, r);
            else while (xb_ld(bar + XB_TOPGEN) < r) __builtin_amdgcn_s_sleep(1);
            xb_st(bar + XB_REL(x), r);
        } else { while (xb_ld(bar + XB_REL(x)) < r) __builtin_amdgcn_s_sleep(1); }
        __builtin_amdgcn_fence(__ATOMIC_ACQUIRE, "agent");
        asm volatile("s_waitcnt vmcnt(0)" ::: "memory");
    }
    __syncthreads();
}
struct Args { const float* in[14]; float* out; unsigned char* ws; int ph_lo, ph_hi; };
enum { I_X = 0, I_ANG, I_WIN, I_FB, I_RBT, I_FOG, I_DOG, I_WOUT, I_FNG, I_WUP, I_CW, I_CB, I_WDN, I_FING };
constexpr int N_PHASES = 11;
constexpr int DN_KB_SPLIT = 129;
#define PROBE_FOX 1
#define PROBE_DIL 1
#ifndef PROBE_PH
#define PROBE_PH -1
#endif

__global__ void __launch_bounds__(NWAVES * 64, 2) hymba_fwd(Args args) {
    extern __shared__ __attribute__((aligned(16))) unsigned char lds[];
    cg::grid_group grid = cg::this_grid();
    const int wave = __builtin_amdgcn_readfirstlane((int)threadIdx.x >> 6);
    const int G = gridDim.x; const int bx = blockIdx.x; const int vcu = (G % 8 == 0) ? (bx % 8) * (G / 8) + bx / 8 : bx;
    const int gw = vcu * NWAVES + wave, NGW = G * NWAVES;
    unsigned char* ws = args.ws;
    bf16* WinT = (bf16*)(ws + WS_WIN); bf16* WfT = (bf16*)(ws + WS_WF); bf16* WoutT = (bf16*)(ws + WS_WOUT); bf16* WupT = (bf16*)(ws + WS_WUP); bf16* WdnT = (bf16*)(ws + WS_WDN);
    bf16* XN = (bf16*)(ws + WS_XN); float* X1 = (float*)(ws + WS_X1); bf16* ACT = (bf16*)(ws + WS_ACT);
    int* JLO = (int*)(ws + WS_TAB + 65536); float* LOGF = (float*)(ws + WS_LOGF); float* CNEG = (float*)(ws + WS_CNEG); float* TAB = (float*)(ws + WS_TAB);
    float* GB = (float*)(ws + WS_GB); float* GF = (float*)(ws + WS_GF); float* VF = (float*)(ws + WS_VF);
    bf16* QKV = (bf16*)(ws + WS_QKV); bf16* OA = (bf16*)(ws + WS_OA); bf16* OB = (bf16*)(ws + WS_OB); float* LSE = (float*)(ws + WS_LSE); bf16* MIX = (bf16*)(ws + WS_MIX);
    const int lo = args.ph_lo, hi_ph = args.ph_hi;
#define IN(k) (lo <= (k) && (k) < hi_ph)
#define REP(k) ((PROBE_PH == (k)) ? 2 : 1)
    unsigned* gbar = (unsigned*)(ws + WS_CTL + CTL_BAR);
    const unsigned xid = xcc_id(); if (threadIdx.x == 0) (void)xb_add(gbar + XB_CEN(xid), 1u);
    unsigned xb_nloc = 1u, xb_nx = 1u; unsigned* NORM = (unsigned*)(ws + WS_CTL + CTL_NORM); float* SSQ = (float*)(ws + WS_CTL + CTL_SSQ); float* SSQ2 = (float*)(ws + WS_CTL + CTL_SSQ2); float* SSQA = (float*)(ws + WS_CTL + CTL_SSQA);
    unsigned nbar = 0;
#define SEAM(k) do { if (IN(k) && IN((k) + 1)) { if ((k) == 0) { asm volatile("s_waitcnt vmcnt(0) lgkmcnt(0)" ::: "memory");     \
        grid.sync(); xb_nx = 0u; for (unsigned j_ = 0; j_ < 16u; ++j_) { const unsigned c_ = xb_ld(gbar + XB_CEN(j_)); xb_nx += c_ ? 1u : 0u; if (j_ == xid) xb_nloc = c_; } \
        xb_nloc = (unsigned)__builtin_amdgcn_readfirstlane((int)xb_nloc); xb_nx = (unsigned)__builtin_amdgcn_readfirstlane((int)xb_nx); \
        ++nbar; grid_barrier(gbar, nbar, xid, xb_nloc, xb_nx, (int)threadIdx.x); }   \
      else if ((k) != 2 && (k) != 5) { ++nbar; grid_barrier(gbar, nbar, xid, xb_nloc, xb_nx, wave * 64 + lane_id_v()); } } } while (0)

    if (IN(0)) for (int rep_ = 0; rep_ < REP(0); ++rep_) {
        const int tid = threadIdx.x, lane = tid & 63;
        LAS float* scr = (LAS float*)((LAS unsigned char*)lds + wave * 16640);
        constexpr int KB4 = DM / 64;
        constexpr int I_IN = KB4 * (NQKV / 64), I_OUT = KB4 * (DM / 64);
        constexpr int I_DNB = ((DFF / 64) - DN_KB_SPLIT) * (DM / 64); constexpr int NITEMS = I_IN + I_OUT + I_DNB;
        for (int it = gw; it < NITEMS; it += NGW) {
            int r = it;
            if (r < I_IN) { const int nblk = NQKV / 64, kb = r / nblk, nb = r % nblk; const int n0 = nb * 64; const int src = n0 < 6144 ? n0 : n0 + 16;
                tr_item(args.in[I_WIN] + src, INW, DM, WinT + (size_t)n0 * DM, scr, kb * 64, lane); continue; } r -= I_IN;
            if (r < I_OUT) { const int nblk = DM / 64, kb = r / nblk, nb = r % nblk;
                tr_item(args.in[I_WOUT] + nb * 64, DM, DM, WoutT + (size_t)(nb * 64) * DM, scr, kb * 64, lane, (kb * 64 < FW) ? args.in[I_FOG] : args.in[I_DOG] - FW); continue; } r -= I_OUT;
            { const int nblk = DM / 64, kb = DN_KB_SPLIT + r / nblk, nb = r % nblk;
                tr_item(args.in[I_WDN] + nb * 64, DM, DFF, WdnT + (size_t)(nb * 64) * DFF, scr, kb * 64, lane); }
        }
        for (int m = gw; m < SEQ; m += NGW) rms_row_bf16(args.in[I_X] + (size_t)m * DM, args.in[I_ANG], XN + (size_t)m * DM, lane);
        for (int item = gw; item < 16 * (DM / 64); item += NGW) { const int j = item & 15, k = (item >> 4) * 64 + lane;
            const float v = args.in[I_WIN][(size_t)k * INW + 6144 + j]; WfT[(size_t)j * DM + k] = (bf16)(pk2(v, v) & 0xffffu); }
        for (int idx = bx * (NWAVES * 64) + tid; idx < 48 * 132; idx += G * NWAVES * 64) { const int t = idx / 132, i = idx % 132, br = t / 16, h = t % 16;
            float v = 0.f; if (i <= 128) { const int dil = br == 0 ? 1 : (br == 1 ? 4 : 16); v = args.in[I_RBT][t5_bucket((128 - i) * dil) * 16 + h] * INV_SCALE; }
            TAB[idx] = v; }
    }
    SEAM(0);
    if (IN(1)) for (int rep_ = 0; rep_ < REP(1); ++rep_) {
        pg8::Gemm g{XN, WinT, SEQ, NQKV, DM}; pg8::StaticOrder S; S.init(SEQ, NQKV, G, bx);
        pg8::EpiQKV E{QKV, SEQ, NORM};
        const int lane = lane_id_v(), tid = wave * 64 + lane;
        pg8::gemm_phase<pg8::EpiQKV, pg8::StaticOrder, true, true>((LAS unsigned char*)lds, g, S, E, tid);
        for (int task = bx; task < SEQ / 32; task += G) {
            const int t0 = task * 32, row = lane & 15, quad = lane >> 4;
            const bf16* ap = XN + (size_t)(t0 + row) * DM + wave * 512 + quad * 8; const bf16* bp = WfT + (size_t)row * DM + wave * 512 + quad * 8;
            f32x4 acc0 = {0.f, 0.f, 0.f, 0.f}, acc1 = acc0;
#pragma unroll
            for (int k0 = 0; k0 < 512; k0 += 32) { const bf16x8 a0 = *(const bf16x8*)(ap + k0), a1 = *(const bf16x8*)(ap + (size_t)16 * DM + k0), b = *(const bf16x8*)(bp + k0);
                acc0 = __builtin_amdgcn_mfma_f32_16x16x32_bf16(a0, b, acc0, 0, 0, 0); acc1 = __builtin_amdgcn_mfma_f32_16x16x32_bf16(a1, b, acc1, 0, 0, 0); }
            LAS f32x4* red = (LAS f32x4*)lds;
            red[wave * 128 + lane] = acc0; red[wave * 128 + 64 + lane] = acc1;
            __syncthreads();
            if (wave == 0) {
#pragma unroll
                for (int w = 1; w < 8; ++w) { acc0 += red[w * 128 + lane]; acc1 += red[w * 128 + 64 + lane]; }
                const int h = lane & 15; const float fb = args.in[I_FB][h];
#pragma unroll
                for (int j = 0; j < 4; ++j) { const float x0 = acc0[j] + fb, x1 = acc1[j] + fb;
                    LOGF[(size_t)h * SEQ + t0 + quad * 4 + j] = fminf(x0, 0.f) - log1pf(expf(-fabsf(x0)));
                    LOGF[(size_t)h * SEQ + t0 + 16 + quad * 4 + j] = fminf(x1, 0.f) - log1pf(expf(-fabsf(x1))); }
            }
            __syncthreads();
        }
    }
    SEAM(1);
    SEAM(2);
    if (IN(3)) for (int rep_ = 0; rep_ < REP(3); ++rep_) {
        char* al = (char*)lds; const int tid = wave * 64 + lane_id_v();
        for (int i = tid; i < 48 * 132; i += NWAVES * 64) ((float*)(al + att::LDS_DTAB))[i] = TAB[i];
        __syncthreads();
        att::Seam S;
        if (vcu < 256) {
            const int L_ = vcu; const int h_ = L_ >> 4, pr_ = L_ & 15, lane_ = tid & 63;
            float* cbl = (float*)(al + att::LDS_BIAS); float* wsum = (float*)(al + 2 * att::SHM_V + 2 * att::SHM_K);
            { const f32x4* lf = (const f32x4*)(LOGF + (size_t)h_ * SEQ + tid * 16); f32x4 v[4]; float p[16]; float run = 0.f;
#pragma unroll
              for (int i = 0; i < 4; ++i) v[i] = lf[i];
#pragma unroll
              for (int i = 0; i < 4; ++i) { run += v[i].x; p[4 * i] = run; run += v[i].y; p[4 * i + 1] = run; run += v[i].z; p[4 * i + 2] = run; run += v[i].w; p[4 * i + 3] = run; }
              float inc = run;
#pragma unroll
              for (int o = 1; o < 64; o <<= 1) { const float t_ = __shfl_up(inc, o); if (lane_ >= o) inc += t_; }
              if (lane_ == 63) wsum[wave] = inc;
              __syncthreads();
              float off = inc - run;
              for (int w = 0; w < wave; ++w) off += wsum[w];
#pragma unroll
              for (int i = 0; i < 4; ++i) { f32x4 o; o.x = -(off + p[4 * i]) * INV_SCALE; o.y = -(off + p[4 * i + 1]) * INV_SCALE; o.z = -(off + p[4 * i + 2]) * INV_SCALE; o.w = -(off + p[4 * i + 3]) * INV_SCALE; ((f32x4*)cbl)[tid * 4 + i] = o; }
              __syncthreads(); }
            float qn2 = 0.f, kn2 = 0.f;
#pragma unroll
            for (int w = 0; w < 4; ++w) { qn2 += __uint_as_float(NORM[h_ * 4 + w]); kn2 += __uint_as_float(NORM[(16 + h_) * 4 + w]); }
            const float thr = (28.f + 2.02f * sqrtf(qn2 * kn2) * att::SCALE) * INV_SCALE;
#define FOX_REF(R, pass) do { const int qb_ = (pass) ? 31 - pr_ : pr_; \
            R.Q = QKV + ((size_t)(0 * 16 + h_) * SEQ + (size_t)qb_ * 256) * 128; R.K = QKV + (size_t)(1 * 16 + h_) * SEQ * 128; R.V = QKV + (size_t)(2 * 16 + h_) * SEQ * 128; \
            R.O = MIX + (size_t)qb_ * 256 * DM + h_ * 128; R.lse = SSQA + qb_ * 256; R.gb = nullptr; R.P0 = qb_ * 256; R.rs = 128; R.os = DM; R.ls = 1; R.tab = 0; \
            { const float lim_ = cbl[R.P0] - thr; const int nt_ = R.P0 >> 6; int cnt_ = 0; \
              for (int b_ = 0; b_ < nt_; b_ += 64) { const int j_ = b_ + lane_; const bool sk_ = (j_ < nt_) && (cbl[64 * (j_ < nt_ ? j_ : 0) + 63] <= lim_); cnt_ += __popcll(__ballot(sk_)); } R.jlo = cnt_; } } while (0)
            att::BlockRef cur, nxt; FOX_REF(cur, 0); att::attn_prime(cur, al, S, tid);
            FOX_REF(nxt, 1); att::attn_block<0>(cur, nxt, al, S, tid); cur = nxt;
            att::attn_block<0>(cur, cur, al, S, tid);
#undef FOX_REF
        }
        { const int per = (1536 + G - 1) / G; const int L0 = vcu * per; const int L1 = (L0 + per < 1536) ? L0 + per : 1536;
#define DIL_REF(R, L) do { const int h_ = (L) / 96, rem_ = (L) % 96, br_ = rem_ >> 5, idx_ = rem_ & 31; const int dil_ = br_ == 0 ? 1 : (br_ == 1 ? 4 : 16); const int nq_ = 32 / dil_; \
            const int cls_ = idx_ / nq_, qb_ = idx_ % nq_; const size_t tok0_ = (size_t)cls_ + (size_t)qb_ * 256 * dil_; \
            R.Q = QKV + ((size_t)(3 * 16 + h_) * SEQ + tok0_) * 128; R.K = QKV + ((size_t)(4 * 16 + h_) * SEQ + cls_) * 128; R.V = QKV + ((size_t)(5 * 16 + h_) * SEQ + cls_) * 128; \
            R.O = OB + ((size_t)br_ * SEQ + tok0_) * FW + h_ * 128; R.lse = LSE + (size_t)(br_ * 16 + h_) * SEQ + (size_t)cls_ * (SEQ / dil_) + (size_t)qb_ * 256; R.gb = nullptr; R.P0 = qb_ * 256; R.rs = 128 * dil_; R.os = FW * dil_; R.ls = 1;     \
            { const int lowk_ = qb_ * 256 - 128; R.jlo = lowk_ > 0 ? lowk_ / 64 : 0; } R.tab = att::LDS_DTAB + (br_ * 16 + h_) * att::DTAB_STRIDE; } while (0)
          if (L0 < L1) { att::BlockRef cur, nxt; DIL_REF(cur, L0); att::attn_prime(cur, al, S, tid);
            const int nd = (L1 - L0) * PROBE_DIL;
            for (int i = 0; i < nd; ++i) { if (i + 1 < nd) DIL_REF(nxt, L0 + (i + 1) % (L1 - L0)); else nxt = cur; att::attn_block<1>(cur, nxt, al, S, tid); cur = nxt; } }
#undef DIL_REF
        }
    }
    SEAM(3);
    if (IN(4)) for (int rep_ = 0; rep_ < REP(4); ++rep_) {
        const float* ga = args.in[I_FOG]; const float* gd = args.in[I_DOG]; const int lane = lane_id_v();
        for (int t = gw; t < SEQ; t += NGW) {
            { float v[4][8]; float ss = 0.f;
#pragma unroll
              for (int j = 0; j < 4; ++j) { const int col = 8 * (lane + 64 * j), h = col >> 7;
                  const float l0 = LSE[(size_t)(0 * 16 + h) * SEQ + t], l1 = LSE[(size_t)(1 * 16 + h) * SEQ + (size_t)(t & 3) * (SEQ / 4) + (t >> 2)], l2 = LSE[(size_t)(2 * 16 + h) * SEQ + (size_t)(t & 15) * (SEQ / 16) + (t >> 4)];
                  const float mx = fmaxf(l0, fmaxf(l1, l2)); float w0 = __builtin_amdgcn_exp2f(l0 - mx), w1 = __builtin_amdgcn_exp2f(l1 - mx), w2 = __builtin_amdgcn_exp2f(l2 - mx);
                  const float inv = 1.f / (w0 + w1 + w2); w0 *= inv; w1 *= inv; w2 *= inv;
                  const v4u a = *(const v4u*)(OB + ((size_t)0 * SEQ + t) * FW + col), b = *(const v4u*)(OB + ((size_t)1 * SEQ + t) * FW + col), c = *(const v4u*)(OB + ((size_t)2 * SEQ + t) * FW + col);
#pragma unroll
                  for (int e = 0; e < 4; ++e) { v[j][2 * e] = w0 * bflo(a[e]) + w1 * bflo(b[e]) + w2 * bflo(c[e]); v[j][2 * e + 1] = w0 * bfhi(a[e]) + w1 * bfhi(b[e]) + w2 * bfhi(c[e]);
                      ss += v[j][2 * e] * v[j][2 * e] + v[j][2 * e + 1] * v[j][2 * e + 1]; } }
              const float r = rsqrtf(wave_sum(ss) * (1.f / FW) + RMS_EPS) * sqrtf(SSQA[t] * (1.f / FW) + RMS_EPS);
#pragma unroll
              for (int j = 0; j < 4; ++j) { const int col = 8 * (lane + 64 * j); v4u w;
                  w.x = pk2(v[j][0] * r, v[j][1] * r); w.y = pk2(v[j][2] * r, v[j][3] * r); w.z = pk2(v[j][4] * r, v[j][5] * r); w.w = pk2(v[j][6] * r, v[j][7] * r);
                  *(v4u*)(MIX + (size_t)t * DM + FW + col) = w; } }
        }
    }
    SEAM(4);
    if (IN(5)) for (int rep_ = 0; rep_ < REP(5); ++rep_) {
        pg8::Gemm g{MIX, WoutT, SEQ, DM, DM}; pg8::StaticOrder S; S.init(SEQ, DM, G, bx);
        pg8::EpiX1 E{args.in[I_X], XN, SSQ, DM, SSQA};
        pg8::gemm_phase<pg8::EpiX1, pg8::StaticOrder, true, true>((LAS unsigned char*)lds, g, S, E, wave * 64 + lane_id_v());
    }
    SEAM(5);
    if (IN(6)) for (int rep_ = 0; rep_ < REP(6); ++rep_) {
        const int lane = lane_id_v(); LAS float* scr = (LAS float*)((LAS unsigned char*)lds + wave * 16640);
        constexpr int I_UP = (DM / 64) * (NUP / 64);
        for (int r = gw; r < I_UP; r += NGW) { const int nblk = NUP / 64, kb = r / nblk, nb = r % nblk; const int n0 = nb * 64;
            const int f = n0 < DFF ? n0 : n0 - DFF; const int drow = 256 * (f >> 7) + (f & 127) + (n0 < DFF ? 0 : 128);
            tr_item(args.in[I_WUP] + n0, NUP, DM, WupT + (size_t)drow * DM, scr, kb * 64, lane, args.in[I_FNG]); }
    }
    SEAM(6);
    if (IN(7)) for (int rep_ = 0; rep_ < REP(7); ++rep_) {
        pg8::Gemm g{XN, WupT, SEQ, NUP, DM}; pg8::StaticOrder S; S.init(SEQ, NUP, G, bx);
        LAS float* rsL = (LAS float*)((LAS unsigned char*)lds + 131072); LAS float* cwL = rsL + 256;
        int pm0 = -1, pn0 = 0, nslot = 0;
        { const int tid_ = wave * 64 + lane_id_v(); pg8::Unit u0, ui;
          if (S.next(0, u0)) { pm0 = u0.pm; pn0 = u0.pn; nslot = 1;
            for (int i = 1; i < EPI_SLOTS && S.next(i, ui); ++i) { if (ui.pm != pm0 || ui.pn != pn0 + 4 * i) break; nslot = i + 1; }
            if (tid_ < 256) rsL[tid_] = rsqrtf(SSQ[pm0 * 256 + tid_] * (1.0f / 4096.0f) + 1e-6f);
            const int arr = tid_ >> 7, c = tid_ & 127;
            for (int i = 0; i < nslot; ++i) { const int col = (pn0 + 4 * i) * 128 + c; cwL[i * 512 + tid_] = arr < 3 ? args.in[I_CW][(size_t)arr * DFF + col] : args.in[I_CB][col]; } }
          __syncthreads(); }
        pg8::EpiGate E{ACT, DFF, args.in[I_CW], args.in[I_CB], GB, GF, VF, SSQ, rsL, cwL, pm0, pn0, nslot};
        pg8::gemm_phase<pg8::EpiGate, pg8::StaticOrder, true, true>((LAS unsigned char*)lds, g, S, E, wave * 64 + lane_id_v());
        { const int nwg = (SEQ / 256) * (NUP / 256), rem = nwg % G, first = rem ? rem : 0, nconv = rem ? G - rem : G;
          if (bx >= first) { const int lane = lane_id_v(); LAS float* scr = (LAS float*)((LAS unsigned char*)lds + wave * 16640);
            constexpr int I_DN = DN_KB_SPLIT * (DM / 64);
            for (int r = (bx - first) * NWAVES + wave; r < I_DN; r += nconv * NWAVES) { const int nblk = DM / 64, kb = r / nblk, nb = r % nblk;
                tr_item(args.in[I_WDN] + nb * 64, DM, DFF, WdnT + (size_t)(nb * 64) * DFF, scr, kb * 64, lane); } } }
    }
    SEAM(7);
    if (IN(8)) for (int rep_ = 0; rep_ < REP(8); ++rep_) {
        const float* cw = args.in[I_CW]; const float* cb = args.in[I_CB];
        const int total = (SEQ / 64) * 2 * (DFF / 4); const int tid = wave * 64 + lane_id_v();
        for (int idx = bx * (NWAVES * 64) + tid; idx < total; idx += G * NWAVES * 64) {
            const int c4 = idx % (DFF / 4), rk = idx / (DFF / 4), g64 = rk >> 1, k = rk & 1, c = c4 * 4;
            const f32x4 cur = *(const f32x4*)(GF + ((size_t)g64 * 2 + k) * DFF + c), val = *(const f32x4*)(VF + ((size_t)g64 * 2 + k) * DFF + c);
            f32x4 p1 = {0.f, 0.f, 0.f, 0.f}, p2 = {0.f, 0.f, 0.f, 0.f};
            if (k == 1) { p1 = *(const f32x4*)(GF + ((size_t)g64 * 2) * DFF + c); if (g64 > 0) p2 = *(const f32x4*)(GB + ((size_t)(g64 - 1) * 2 + 1) * DFF + c); }
            else if (g64 > 0) { p1 = *(const f32x4*)(GB + ((size_t)(g64 - 1) * 2 + 1) * DFF + c); p2 = *(const f32x4*)(GB + ((size_t)(g64 - 1) * 2) * DFF + c); }
            const f32x4 w0 = *(const f32x4*)(cw + c), w1 = *(const f32x4*)(cw + DFF + c), w2 = *(const f32x4*)(cw + 2 * DFF + c), b = *(const f32x4*)(cb + c);
            float a[4];
#pragma unroll
            for (int j = 0; j < 4; ++j) { const float gg = w2[j] * cur[j] + w1[j] * p1[j] + w0[j] * p2[j] + b[j]; a[j] = pg8::silu_f(gg) * val[j]; }
            v2u w; w.x = pk2(a[0], a[1]); w.y = pk2(a[2], a[3]);
            *(v2u*)(ACT + (size_t)(g64 * 64 + k) * DFF + c) = w;
        }
    }
    SEAM(8);
    if (IN(9)) for (int rep_ = 0; rep_ < REP(9); ++rep_) {
        pg8::Gemm g{ACT, WdnT, SEQ, DM, DFF}; pg8::StaticOrder S; S.init(SEQ, DM, G, bx);
        pg8::EpiX2 E{XN, SSQ2, DM};
        pg8::gemm_phase<pg8::EpiX2, pg8::StaticOrder, true, true>((LAS unsigned char*)lds, g, S, E, wave * 64 + lane_id_v());
    }
    SEAM(9);
    if (IN(10)) for (int rep_ = 0; rep_ < REP(10); ++rep_) { const int lane = lane_id_v(); const float* gf = args.in[I_FING];
        for (int m = gw; m < SEQ; m += NGW) { const float r = rsqrtf(SSQ2[m] * (1.f / DM) + RMS_EPS); const v4u* xr = (const v4u*)(XN + (size_t)m * DM) + lane; float* orow = args.out + (size_t)m * DM;
            v4u raw[8];
#pragma unroll
            for (int j = 0; j < 8; ++j) raw[j] = xr[64 * j];
#pragma unroll
            for (int j = 0; j < 8; ++j) { const int col = 8 * (lane + 64 * j); const f32x4 g0 = *(const f32x4*)(gf + col), g1 = *(const f32x4*)(gf + col + 4);
                f32x4 o0, o1; o0.x = bflo(raw[j].x) * r * g0.x; o0.y = bfhi(raw[j].x) * r * g0.y; o0.z = bflo(raw[j].y) * r * g0.z; o0.w = bfhi(raw[j].y) * r * g0.w;
                o1.x = bflo(raw[j].z) * r * g1.x; o1.y = bfhi(raw[j].z) * r * g1.y; o1.z = bflo(raw[j].w) * r * g1.z; o1.w = bfhi(raw[j].w) * r * g1.w;
                *(f32x4*)(orow + col) = o0; *(f32x4*)(orow + col + 4) = o1; } }
    }
#undef IN
#undef SEAM
}

#ifndef MK_N_LAUNCHES
#define MK_N_LAUNCHES 1
#endif
extern "C" void kernel_launch(void* const* d_in, const int* in_sizes, int n_in, void* d_out, int out_size, void* d_ws, size_t ws_size, hipStream_t stream) {
    static int grid = 0;
    if (grid == 0) {
        if (n_in != 14 || in_sizes[0] != SEQ * DM || out_size != SEQ * DM || ws_size < WS_END) { fprintf(stderr, "kernel_launch: unexpected shapes (n_in %d, ws %zu < %zu)\n", n_in, ws_size, (size_t)WS_END); grid = -1; return; }
        int dev = 0, cus = 0, per_cu = 0;
        (void)hipGetDevice(&dev); (void)hipDeviceGetAttribute(&cus, hipDeviceAttributeMultiprocessorCount, dev);
        if (hipFuncSetAttribute((const void*)hymba_fwd, hipFuncAttributeMaxDynamicSharedMemorySize, LDS_BYTES) != hipSuccess) { fprintf(stderr, "kernel_launch: hipFuncSetAttribute failed\n"); grid = -1; return; }
        if (hipOccupancyMaxActiveBlocksPerMultiprocessor(&per_cu, (const void*)hymba_fwd, NWAVES * 64, LDS_BYTES) != hipSuccess || per_cu < 1) { fprintf(stderr, "kernel_launch: occupancy query says %d\n", per_cu); per_cu = 1; }
        (void)hipGetLastError();
        grid = cus * 1;
        if (grid <= 0) grid = 256;
        if (grid < 256) { fprintf(stderr, "kernel_launch: needs >= 256 workgroups (one FoX item each), device has %d CUs\n", grid); grid = -1; return; }
    }
    if (grid < 0) return;
    if (hipMemsetAsync((char*)d_ws + WS_CTL, 0, CTL_BYTES, stream) != hipSuccess) { fprintf(stderr, "kernel_launch: memset failed\n"); return; }
    Args a{};
    for (int i = 0; i < 14; ++i) a.in[i] = (const float*)d_in[i];
    a.out = (float*)d_out; a.ws = (unsigned char*)d_ws;
#if MK_N_LAUNCHES == 1
    a.ph_lo = 0; a.ph_hi = N_PHASES;
    { void* kargs[] = {&a}; hipError_t e = hipLaunchCooperativeKernel((const void*)hymba_fwd, dim3(grid), dim3(NWAVES * 64), kargs, LDS_BYTES, stream);
      if (e != hipSuccess) fprintf(stderr, "kernel_launch: cooperative launch failed: %s (grid %d)\n", hipGetErrorString(e), grid); }
#else
    for (int p = 0; p < N_PHASES; ++p) { a.ph_lo = p; a.ph_hi = p + 1; void* kargs[] = {&a};
        hipError_t e = hipLaunchCooperativeKernel((const void*)hymba_fwd, dim3(grid), dim3(NWAVES * 64), kargs, LDS_BYTES, stream);
        if (e != hipSuccess) { fprintf(stderr, "kernel_launch: launch %d failed: %s\n", p, hipGetErrorString(e)); break; } }
#endif
}
```

```cpp
#include <hip/hip_runtime.h>
#include <hip/hip_bf16.h>
#include <hip/hip_cooperative_groups.h>
#include <cstdio>
#include <cstdint>
namespace cg = cooperative_groups;
namespace pg8 {
#define PG8_LAS __attribute__((address_space(3)))
typedef unsigned short bf16_t;
typedef short bf16x8 __attribute__((ext_vector_type(8)));
typedef float f32x4 __attribute__((ext_vector_type(4)));
typedef unsigned u32x4 __attribute__((ext_vector_type(4)));
constexpr int BM = 256, BK = 64, HALF = 128, HTB = HALF * BK * 2  , STAGE_BYTES = 8 * HTB, NXCD = 8, WGM = 8;

__host__ __device__ __forceinline__ int lds_byte(int r, int c) { const int st = (r >> 4) * 2 + (c >> 5), rr = r & 15, cc = c & 31, ob = rr * 64 + cc * 2; return st * 1024 + (ob ^ (((ob >> 9) & 1) << 5)); }
__host__ __device__ __forceinline__ void stage_rc(int b, int& R, int& C) { const int st = b / 1024, sb = b % 1024, swz = sb ^ (((sb >> 9) & 1) << 5); R = (st >> 1) * 16 + swz / 64; C = (st & 1) * 32 + (swz % 64) / 2; }
__host__ __device__ __forceinline__ int perm32(int rho) { const int n = rho >> 4, i = rho & 15; return 8 * (i >> 2) + 4 * n + (i & 3); }

struct Unit { int pm, pn; };
struct Gemm { const bf16_t* A; const bf16_t* Bt; int M, N, K; };

struct StaticOrder {
    int nM, nN, nwg, G, c, wgm;
    __host__ __device__ void init(int M, int N, int G_, int c_, int wgm_ = WGM) { nM = M / BM; nN = N / BM; nwg = nM * nN; G = G_; c = c_; wgm = wgm_; }
    __host__ __device__ bool next(int i, Unit& u) const {
        const long L = (long)i * G + c; if (L >= nwg) return false;
        int wgid = (int)L; { const int q = nwg / NXCD, r = nwg % NXCD, xcd = wgid % NXCD, off = wgid / NXCD; wgid = (xcd < r ? xcd * (q + 1) : r * (q + 1) + (xcd - r) * q) + off; }
        const int nig = wgm * nN, gid = wgid / nig, fm = gid * wgm, gsz = (nM - fm) < wgm ? (nM - fm) : wgm;
        u.pm = fm + ((wgid % nig) % gsz); u.pn = (wgid % nig) / gsz; return true;
    }
    __device__ __forceinline__ void a_ready(const Unit&) const {}
    __device__ __forceinline__ void done(const Unit&) const {}
};

__device__ __forceinline__ unsigned cvt_pk_bf16(float lo, float hi) { unsigned r; asm volatile("v_cvt_pk_bf16_f32 %0, %1, %2" : "=v"(r) : "v"(lo), "v"(hi)); return r; }
typedef float f32x2 __attribute__((ext_vector_type(2)));
typedef unsigned u32x2 __attribute__((ext_vector_type(2)));
struct EpiQKV {
    static constexpr bool PERM = true, AFTER_DRAIN = false;
    bf16_t* O; int S; unsigned* norm4;
    __device__ __forceinline__ void operator()(const f32x4 (&acc)[2][2][4][2], const Unit& u, int wr, int wc, int fr, int fq) const {
        const int row0 = u.pm * BM + wr * 64 + fr, d0 = wc * 32 + 8 * fq;
#pragma unroll
        for (int bj = 0; bj < 2; ++bj) { bf16_t* hb = O + (size_t)(2 * u.pn + bj) * S * 128 + d0;
#pragma unroll
            for (int ai = 0; ai < 2; ++ai)
#pragma unroll
                for (int m = 0; m < 4; ++m) { const f32x4 v0 = acc[ai][bj][m][0], v1 = acc[ai][bj][m][1];
                    u32x4 w; w.x = cvt_pk_bf16(v0[0], v0[1]); w.y = cvt_pk_bf16(v0[2], v0[3]); w.z = cvt_pk_bf16(v1[0], v1[1]); w.w = cvt_pk_bf16(v1[2], v1[3]);
                    *(u32x4*)(hb + (size_t)(row0 + ai * HALF + m * 16) * 128) = w; } }
        if (u.pn < 16) {
#pragma unroll
            for (int bj = 0; bj < 2; ++bj) { float mx = 0.f;
#pragma unroll
                for (int ai = 0; ai < 2; ++ai)
#pragma unroll
                    for (int m = 0; m < 4; ++m) { const f32x4 v0 = acc[ai][bj][m][0], v1 = acc[ai][bj][m][1];
                        float ss = (v0[0] * v0[0] + v0[1] * v0[1]) + (v0[2] * v0[2] + v0[3] * v0[3]) + (v1[0] * v1[0] + v1[1] * v1[1]) + (v1[2] * v1[2] + v1[3] * v1[3]);
                        ss += __shfl_xor(ss, 16); ss += __shfl_xor(ss, 32); mx = fmaxf(mx, ss); }
                mx = fmaxf(mx, __shfl_xor(mx, 1)); mx = fmaxf(mx, __shfl_xor(mx, 2)); mx = fmaxf(mx, __shfl_xor(mx, 4)); mx = fmaxf(mx, __shfl_xor(mx, 8));
                if (fr == 0 && fq == 0) atomicMax(norm4 + (2 * u.pn + bj) * 4 + wc, __float_as_uint(mx)); }
        }
    }
};
struct EpiRes {
    static constexpr bool PERM = false, AFTER_DRAIN = false;
    const float* base; float* out; int ldc;
    __device__ __forceinline__ void operator()(const f32x4 (&acc)[2][2][4][2], const Unit& u, int wr, int wc, int fr, int fq) const {
        const int col0 = u.pn * BM + wc * 32 + 4 * fq;
#pragma unroll
        for (int ai = 0; ai < 2; ++ai)
#pragma unroll
            for (int m = 0; m < 4; ++m) { const size_t off = (size_t)(u.pm * BM + ai * HALF + wr * 64 + m * 16 + fr) * ldc + col0;
#pragma unroll
                for (int bj = 0; bj < 2; ++bj)
#pragma unroll
                    for (int n = 0; n < 2; ++n) { const f32x4 bs = *(const f32x4*)(base + off + bj * HALF + n * 16); *(f32x4*)(out + off + bj * HALF + n * 16) = bs + acc[ai][bj][m][n]; }
                if (m & 1) asm volatile("" ::: "memory"); }
    }
};
struct EpiX1 {
    static constexpr bool PERM = false, AFTER_DRAIN = false;
    const float* base; bf16_t* xb; float* ssq; int ldc; const float* ssqa;
    __device__ __forceinline__ void operator()(const f32x4 (&acc)[2][2][4][2], const Unit& u, int wr, int wc, int fr, int fq) const {
        const int col0 = u.pn * BM + wc * 32 + 4 * fq;
#pragma unroll
        for (int ai = 0; ai < 2; ++ai) {
#pragma unroll
            for (int m = 0; m < 4; ++m) { const int row = u.pm * BM + ai * HALF + wr * 64 + m * 16 + fr; const size_t off = (size_t)row * ldc + col0; float s = 0.f; const float ra = rsqrtf(ssqa[row] * (1.0f / 2048.0f) + 1e-6f);
#pragma unroll
                for (int bj = 0; bj < 2; ++bj)
#pragma unroll
                    for (int n = 0; n < 2; ++n) { const f32x4 v = *(const f32x4*)(base + off + bj * HALF + n * 16) + acc[ai][bj][m][n] * ra;
                        u32x2 w; w.x = cvt_pk_bf16(v[0], v[1]); w.y = cvt_pk_bf16(v[2], v[3]); *(u32x2*)(xb + off + bj * HALF + n * 16) = w; s += (v[0] * v[0] + v[1] * v[1]) + (v[2] * v[2] + v[3] * v[3]); }
                s += __shfl_xor(s, 16); s += __shfl_xor(s, 32);
                if (fq == 0) atomicAdd(ssq + row, s); }
            asm volatile("" ::: "memory"); }
    }
};
struct EpiX2 {
    static constexpr bool PERM = false, AFTER_DRAIN = false;
    bf16_t* xb; float* ssq; int ldc;
    __device__ __forceinline__ void operator()(const f32x4 (&acc)[2][2][4][2], const Unit& u, int wr, int wc, int fr, int fq) const {
        const int col0 = u.pn * BM + wc * 32 + 4 * fq;
#pragma unroll
        for (int ai = 0; ai < 2; ++ai) {
#pragma unroll
            for (int m = 0; m < 4; ++m) { const int row = u.pm * BM + ai * HALF + wr * 64 + m * 16 + fr; const size_t off = (size_t)row * ldc + col0; float s = 0.f;
#pragma unroll
                for (int bj = 0; bj < 2; ++bj)
#pragma unroll
                    for (int n = 0; n < 2; ++n) { bf16_t* p = xb + off + bj * HALF + n * 16; const u32x2 r = *(const u32x2*)p; f32x4 v;
                        v[0] = __uint_as_float(r.x << 16); v[1] = __uint_as_float(r.x & 0xffff0000u); v[2] = __uint_as_float(r.y << 16); v[3] = __uint_as_float(r.y & 0xffff0000u); v += acc[ai][bj][m][n];
                        u32x2 w; w.x = cvt_pk_bf16(v[0], v[1]); w.y = cvt_pk_bf16(v[2], v[3]); *(u32x2*)p = w; s += (v[0] * v[0] + v[1] * v[1]) + (v[2] * v[2] + v[3] * v[3]); }
                s += __shfl_xor(s, 16); s += __shfl_xor(s, 32);
                if (fq == 0) atomicAdd(ssq + row, s); }
            asm volatile("" ::: "memory"); }
    }
};
__device__ __forceinline__ float dpp_shr1(float cur, float prev) {
    const int o = __builtin_amdgcn_update_dpp(0, __builtin_bit_cast(int, prev), 0x121, 0xf, 0xf, false);
    return __builtin_bit_cast(float, __builtin_amdgcn_update_dpp(o, __builtin_bit_cast(int, cur), 0x111, 0xf, 0xf, false));
}
__device__ __forceinline__ float dpp_shr2(float cur, float prev) {
    const int o = __builtin_amdgcn_update_dpp(0, __builtin_bit_cast(int, prev), 0x122, 0xf, 0xf, false);
    return __builtin_bit_cast(float, __builtin_amdgcn_update_dpp(o, __builtin_bit_cast(int, cur), 0x112, 0xf, 0xf, false));
}
__device__ __forceinline__ float silu_f(float g) { return g * __builtin_amdgcn_rcpf(1.0f + __builtin_amdgcn_exp2f(-1.4426950408889634f * g)); }
struct EpiGate {
    static constexpr bool PERM = true, AFTER_DRAIN = false;
    bf16_t* ACT; int ldc;
    const float* cw; const float* cb;
    float* GB; float* GF; float* VF;
    const float* ssq;
    const PG8_LAS float* rsL; const PG8_LAS float* cwL; int pm0, pn0, nslot;
    __device__ __forceinline__ void operator()(const f32x4 (&acc)[2][2][4][2], const Unit& u, int wr, int wc, int fr, int fq) const {
        const int c0 = u.pn * HALF + wc * 32 + 8 * fq;
        const int dpn = u.pn - pn0; const bool fast = (u.pm == pm0) && dpn >= 0 && (dpn & 3) == 0 && (dpn >> 2) < nslot;
        f32x4 w0[2], w1[2], w2[2], bb[2];
        if (fast) { const PG8_LAS float* cp = cwL + (dpn >> 2) * 512 + wc * 32 + 8 * fq;
#pragma unroll
            for (int n = 0; n < 2; ++n) { w0[n] = *(const PG8_LAS f32x4*)(cp + 4 * n); w1[n] = *(const PG8_LAS f32x4*)(cp + 128 + 4 * n); w2[n] = *(const PG8_LAS f32x4*)(cp + 256 + 4 * n); bb[n] = *(const PG8_LAS f32x4*)(cp + 384 + 4 * n); }
        } else {
#pragma unroll
            for (int n = 0; n < 2; ++n) { w0[n] = *(const f32x4*)(cw + c0 + 4 * n); w1[n] = *(const f32x4*)(cw + ldc + c0 + 4 * n); w2[n] = *(const f32x4*)(cw + 2 * ldc + c0 + 4 * n); bb[n] = *(const f32x4*)(cb + c0 + 4 * n); }
        }
#pragma unroll
        for (int ai = 0; ai < 2; ++ai) {
            const int g64 = u.pm * 4 + ai * 2 + wr;
            float rs[4];
            if (fast) {
#pragma unroll
                for (int m = 0; m < 4; ++m) rs[m] = rsL[ai * HALF + wr * 64 + m * 16 + fr];
            } else {
#pragma unroll
                for (int m = 0; m < 4; ++m) rs[m] = rsqrtf(ssq[u.pm * BM + ai * HALF + wr * 64 + m * 16 + fr] * (1.0f / 4096.0f) + 1e-6f);
            }
#pragma unroll
            for (int m = 0; m < 4; ++m) {
                const int row = u.pm * BM + ai * HALF + wr * 64 + m * 16 + fr;
                f32x4 a[2];
#pragma unroll
                for (int n = 0; n < 2; ++n)
#pragma unroll
                    for (int j = 0; j < 4; ++j) {
                        const float cur = acc[ai][0][m][n][j] * rs[m], prev = acc[ai][0][m > 0 ? m - 1 : 0][n][j] * rs[m > 0 ? m - 1 : 0];
                        const float s1 = dpp_shr1(cur, prev), s2 = dpp_shr2(cur, prev);
                        const float g = w2[n][j] * cur + w1[n][j] * s1 + w0[n][j] * s2 + bb[n][j];
                        a[n][j] = silu_f(g) * (acc[ai][1][m][n][j] * rs[m]);
                    }
                if (m == 0 && fr < 2) {
                    float* gf = GF + ((size_t)g64 * 2 + fr) * ldc + c0; float* vf = VF + ((size_t)g64 * 2 + fr) * ldc + c0;
                    *(f32x4*)gf = acc[ai][0][0][0] * rs[0]; *(f32x4*)(gf + 4) = acc[ai][0][0][1] * rs[0]; *(f32x4*)vf = acc[ai][1][0][0] * rs[0]; *(f32x4*)(vf + 4) = acc[ai][1][0][1] * rs[0];
                } else {
                    u32x4 w; w.x = cvt_pk_bf16(a[0][0], a[0][1]); w.y = cvt_pk_bf16(a[0][2], a[0][3]); w.z = cvt_pk_bf16(a[1][0], a[1][1]); w.w = cvt_pk_bf16(a[1][2], a[1][3]);
                    *(u32x4*)(ACT + (size_t)row * ldc + c0) = w;
                }
                if (m == 3 && fr >= 14) { float* gb = GB + ((size_t)g64 * 2 + (fr - 14)) * ldc + c0; *(f32x4*)gb = acc[ai][0][3][0] * rs[3]; *(f32x4*)(gb + 4) = acc[ai][0][3][1] * rs[3]; }
            }
        }
    }
};
template <class Epi, class Sched, bool ALIGN_EPI = false, bool SP2 = false>
__device__ __forceinline__ void gemm_phase(PG8_LAS unsigned char* lds, const Gemm g, const Sched& S, const Epi& E, const int tid) {
    const int wid = __builtin_amdgcn_readfirstlane(tid >> 6), lane = tid & 63, wr = wid >> 2, wc = wid & 3, fr = lane & 15, fq = lane >> 4;
    const int K = g.K, nt = K / BK;
    unsigned voffA[2], voffB[2];
#pragma unroll
    for (int i = 0; i < 2; ++i) { int R, C; stage_rc(tid * 16 + i * 8192, R, C); const int Rb = Epi::PERM ? ((R & ~31) + perm32(R & 31)) : R;
        voffA[i] = (unsigned)(R * K + C) * 2u; voffB[i] = (unsigned)(Rb * K + C) * 2u; }
    const size_t kstep = (size_t)(BK * 2);
    const size_t hstep = (size_t)HALF * K * 2;
    const size_t tstep = 2 * hstep;
    const unsigned ldsw = (unsigned)wid * 1024u;
    const int aoff = lds_byte(wr * 64 + fr, fq * 8), boff = lds_byte(wc * 32 + fr, fq * 8);
#define PG8_SA(b, h) (((b) * 2 + (h)) * HTB)
#define PG8_SB(b, h) ((4 + (b) * 2 + (h)) * HTB)
#define PG8_STAGE(bufoff, gbase, voff) do { _Pragma("unroll") for (int _i = 0; _i < 2; ++_i) \
        __builtin_amdgcn_global_load_lds((const unsigned*)((const char*)(gbase) + (voff)[_i]), (PG8_LAS unsigned*)(lds + (bufoff) + ldsw + _i * 8192), 16, 0, 0); } while (0)
#define PG8_LDA(dst, b, h) do { _Pragma("unroll") for (int m = 0; m < 4; ++m) _Pragma("unroll") for (int k = 0; k < 2; ++k) dst[m][k] = *(const PG8_LAS bf16x8*)(lds + PG8_SA(b, h) + aoff + m * 2048 + k * 1024); } while (0)
#define PG8_LDB(dst, b, h) do { _Pragma("unroll") for (int n = 0; n < 2; ++n) _Pragma("unroll") for (int k = 0; k < 2; ++k) dst[n][k] = *(const PG8_LAS bf16x8*)(lds + PG8_SB(b, h) + boff + n * 2048 + k * 1024); } while (0)
#define PG8_MMA(ai, bj, At, Bt) do { __builtin_amdgcn_s_setprio(1); _Pragma("unroll") for (int m = 0; m < 4; ++m) _Pragma("unroll") for (int n = 0; n < 2; ++n) _Pragma("unroll") for (int k = 0; k < 2; ++k) \
        acc[ai][bj][m][n] = __builtin_amdgcn_mfma_f32_16x16x32_bf16(Bt[n][k], At[m][k], acc[ai][bj][m][n], 0, 0, 0); __builtin_amdgcn_s_setprio(0); } while (0)
#define PG8_WAIT_V(n) asm volatile("s_waitcnt vmcnt(" #n ")" ::: "memory")
#define PG8_WAIT_L(n) asm volatile("s_waitcnt lgkmcnt(" #n ")" ::: "memory")
#define PG8_BAR __builtin_amdgcn_s_barrier()
#define PG8_SCHED __builtin_amdgcn_sched_barrier(0)
    Unit cur, nxt; int ui = 0;
    if (!S.next(0, cur)) return;
    f32x4 acc[2][2][4][2];
#pragma unroll
    for (int a = 0; a < 2; ++a)
#pragma unroll
        for (int b = 0; b < 2; ++b)
#pragma unroll
            for (int m = 0; m < 4; ++m)
#pragma unroll
                for (int n = 0; n < 2; ++n) acc[a][b][m][n] = (f32x4){0.f, 0.f, 0.f, 0.f};
    bf16x8 At[4][2], B0[2][2], B1[2][2];
    const char* cA = (const char*)g.A + (size_t)cur.pm * tstep; const char* cB = (const char*)g.Bt + (size_t)cur.pn * tstep;
    S.a_ready(cur);
    if constexpr (SP2) {
        PG8_STAGE(PG8_SB(0, 0), cB, voffB); PG8_STAGE(PG8_SB(0, 1), cB + hstep, voffB); PG8_STAGE(PG8_SA(0, 0), cA, voffA); PG8_STAGE(PG8_SA(0, 1), cA + hstep, voffA);
        if (wr == 1) PG8_BAR;
        PG8_WAIT_V(2); PG8_BAR;
        PG8_STAGE(PG8_SB(1, 0), cB + kstep, voffB); PG8_STAGE(PG8_SA(1, 0), cA + kstep, voffA); PG8_STAGE(PG8_SB(1, 1), cB + hstep + kstep, voffB);
        PG8_WAIT_V(6); PG8_BAR;
    } else {
        PG8_STAGE(PG8_SB(0, 0), cB, voffB); PG8_STAGE(PG8_SA(0, 0), cA, voffA); PG8_STAGE(PG8_SB(0, 1), cB + hstep, voffB); PG8_STAGE(PG8_SA(0, 1), cA + hstep, voffA);
        if (wr == 1) PG8_BAR;
        PG8_WAIT_V(4); PG8_BAR;
        PG8_STAGE(PG8_SB(1, 0), cB + kstep, voffB); PG8_STAGE(PG8_SA(1, 0), cA + kstep, voffA); PG8_STAGE(PG8_SB(1, 1), cB + hstep + kstep, voffB);
        PG8_WAIT_V(6); PG8_BAR;
    }
    for (;;) {
        const bool has_next = S.next(ui + 1, nxt);
        const char* nA = has_next ? (const char*)g.A + (size_t)nxt.pm * tstep : cA; const char* nB = has_next ? (const char*)g.Bt + (size_t)nxt.pn * tstep : cB;
        for (int t = 0; t < nt; t += 2) {
            const bool last = (t == nt - 2);
            const char* a1 = cA + (size_t)(t + 1) * kstep;
            const char* a2 = last ? nA : cA + (size_t)(t + 2) * kstep; const char* b2 = last ? nB : cB + (size_t)(t + 2) * kstep;
            const char* a3 = a2 + kstep; const char* b3 = b2 + kstep;
            if (last && has_next) S.a_ready(nxt);
            if constexpr (SP2) {
            PG8_LDB(B0, 0, 0); PG8_LDB(B1, 0, 1); PG8_SCHED; PG8_LDA(At, 0, 0); PG8_STAGE(PG8_SA(1, 1), a1 + hstep, voffA);
            PG8_WAIT_V(8); PG8_WAIT_L(0); PG8_BAR; PG8_MMA(0, 0, At, B0); PG8_MMA(0, 1, At, B1); PG8_BAR; PG8_SCHED;
            PG8_LDA(At, 0, 1); PG8_STAGE(PG8_SB(0, 0), b2, voffB); PG8_STAGE(PG8_SB(0, 1), b2 + hstep, voffB); PG8_STAGE(PG8_SA(0, 0), a2, voffA);
            PG8_WAIT_V(8); PG8_WAIT_L(0); PG8_BAR; PG8_MMA(1, 0, At, B0); PG8_MMA(1, 1, At, B1); PG8_BAR; PG8_SCHED;
            PG8_LDB(B0, 1, 0); PG8_LDB(B1, 1, 1); PG8_SCHED; PG8_LDA(At, 1, 0); PG8_STAGE(PG8_SA(0, 1), a2 + hstep, voffA);
            PG8_WAIT_V(8); PG8_WAIT_L(0); PG8_BAR; PG8_MMA(0, 0, At, B0); PG8_MMA(0, 1, At, B1); PG8_BAR; PG8_SCHED;
            PG8_LDA(At, 1, 1); PG8_STAGE(PG8_SB(1, 0), b3, voffB); PG8_STAGE(PG8_SB(1, 1), b3 + hstep, voffB); PG8_STAGE(PG8_SA(1, 0), a3, voffA);
            PG8_WAIT_V(8); PG8_WAIT_L(0); PG8_BAR; PG8_MMA(1, 0, At, B0); PG8_MMA(1, 1, At, B1); PG8_BAR; PG8_SCHED;
            } else {
            PG8_LDB(B0, 0, 0); PG8_SCHED; PG8_LDA(At, 0, 0); PG8_STAGE(PG8_SA(1, 1), a1 + hstep, voffA);
            PG8_WAIT_L(8); PG8_BAR; PG8_WAIT_L(0); PG8_MMA(0, 0, At, B0); PG8_BAR; PG8_SCHED;
            PG8_LDB(B1, 0, 1); PG8_STAGE(PG8_SB(0, 0), b2, voffB);
            PG8_BAR; PG8_WAIT_L(0); PG8_MMA(0, 1, At, B1); PG8_BAR;
            PG8_LDA(At, 0, 1); PG8_STAGE(PG8_SA(0, 0), a2, voffA);
            PG8_BAR; PG8_WAIT_L(0); PG8_MMA(1, 0, At, B0); PG8_BAR; PG8_SCHED;
            PG8_STAGE(PG8_SB(0, 1), b2 + hstep, voffB);
            PG8_WAIT_V(6); PG8_BAR; PG8_MMA(1, 1, At, B1); PG8_BAR;
            PG8_LDB(B0, 1, 0); PG8_SCHED; PG8_LDA(At, 1, 0); PG8_STAGE(PG8_SA(0, 1), a2 + hstep, voffA);
            PG8_WAIT_L(8); PG8_BAR; PG8_WAIT_L(0); PG8_MMA(0, 0, At, B0); PG8_BAR; PG8_SCHED;
            PG8_LDB(B1, 1, 1); PG8_STAGE(PG8_SB(1, 0), b3, voffB);
            PG8_BAR; PG8_WAIT_L(0); PG8_MMA(0, 1, At, B1); PG8_BAR;
            PG8_LDA(At, 1, 1); PG8_STAGE(PG8_SA(1, 0), a3, voffA);
            PG8_BAR; PG8_WAIT_L(0); PG8_MMA(1, 0, At, B0); PG8_BAR; PG8_SCHED;
            PG8_STAGE(PG8_SB(1, 1), b3 + hstep, voffB);
            PG8_WAIT_V(6); PG8_BAR; PG8_MMA(1, 1, At, B1); PG8_BAR;
            }
        }
        if constexpr (ALIGN_EPI) { if (wr == 0) PG8_BAR; }
        if constexpr (!Epi::AFTER_DRAIN) { E(acc, cur, wr, wc, fr, fq); S.done(cur); }
        if (!has_next) break;
#pragma unroll
        for (int a = 0; a < 2; ++a)
#pragma unroll
            for (int b = 0; b < 2; ++b)
#pragma unroll
                for (int m = 0; m < 4; ++m)
#pragma unroll
                    for (int n = 0; n < 2; ++n) acc[a][b][m][n] = (f32x4){0.f, 0.f, 0.f, 0.f};
        cur = nxt; cA = nA; cB = nB; ++ui;
        if constexpr (ALIGN_EPI) { if (wr == 1) PG8_BAR; }
    }
    PG8_WAIT_V(0);
    if constexpr (!ALIGN_EPI) { if (wr == 0) PG8_BAR; }
    PG8_BAR;
    if constexpr (Epi::AFTER_DRAIN) { E.fused(acc, cur, wr, wc, fr, fq, lds, wid, lane); S.done(cur); }
#undef PG8_SA
#undef PG8_SB
#undef PG8_STAGE
#undef PG8_LDA
#undef PG8_LDB
#undef PG8_MMA
#undef PG8_WAIT_V
#undef PG8_WAIT_L
#undef PG8_BAR
#undef PG8_SCHED
}
}
namespace att {
typedef unsigned short bf16_t;
typedef short bf16x8 __attribute__((ext_vector_type(8)));
typedef short s16x4 __attribute__((ext_vector_type(4)));
typedef float f32x16 __attribute__((ext_vector_type(16)));
typedef float f32x4 __attribute__((ext_vector_type(4)));
typedef unsigned u32x4 __attribute__((ext_vector_type(4)));
constexpr int D = 128;
constexpr float SCALE = 0.08838834764831845f;
constexpr float THR = 8.f;
constexpr int NW = 8, QBLK = 32, KVBLK = 64, QB = NW * QBLK;
constexpr int SHM_V = KVBLK * D * 2, SHM_K = KVBLK * D * 2;
constexpr int LDS_TILES = 2 * SHM_V + 2 * SHM_K + NW * 64 * 4;
constexpr int LDS_BIAS = LDS_TILES;
constexpr int LDS_DTAB = LDS_BIAS + 32768 + 2048;
constexpr int DTAB_STRIDE = 132 * 4, DTAB_BYTES = 48 * DTAB_STRIDE;
constexpr int LDS_END = LDS_DTAB + DTAB_BYTES + 2048;
constexpr int DILW = 129;

#define KSWZ(row, colB) ((row) * 256 + ((colB) ^ (((row) & 7) << 4)))
#define SBAR() __builtin_amdgcn_sched_barrier(0)
__device__ __forceinline__ int v_st(int k, int c) { const int kk = (k & ~0xC) | ((k & 4) << 1) | ((k & 8) >> 1); return ((kk >> 3) * 4 + (c >> 5)) * 512 + ((kk & 7) * 32 + (c & 31)) * 2; }
__device__ __forceinline__ int v_rd_base(int lane) { return ((lane & 3) << 3) | (((lane >> 2) & 3) << 6) | (((lane >> 4) & 1) << 5) | (((lane >> 5) & 1) << 8); }
constexpr int v_rd_off(int d0, int ks, int half) { return d0 * 512 + ks * 4096 + half * 2048; }
__device__ __forceinline__ int crow(int r, int hi) { return (r & 3) + 8 * (r >> 2) + 4 * hi; }
__device__ __forceinline__ unsigned cvtpk(float lo, float hi) { unsigned r; asm volatile("v_cvt_pk_bf16_f32 %0, %1, %2" : "=v"(r) : "v"(lo), "v"(hi)); return r; }
__device__ __forceinline__ bf16x8 gld8(const void* ubase, unsigned voff) { return *reinterpret_cast<const bf16x8*>((const char*)ubase + voff); }
__device__ __forceinline__ void mask_tile(f32x16& p0, f32x16& p1, int dq, unsigned W) {
    const float NEG = -__builtin_inff();
#pragma unroll
    for (int r = 0; r < 16; ++r) {
        const int c = (r & 3) + 8 * (r >> 2);
        if ((unsigned)(dq - c) >= W) p0[r] = NEG;
        if ((unsigned)(dq - c - 32) >= W) p1[r] = NEG;
    }
}
__device__ __forceinline__ void partialSM(f32x16& p0, f32x16& p1, float& m_reg, float& mn, float& alpha) {
    float pmax = p0[0]; for (int r = 1; r < 16; ++r) pmax = fmaxf(pmax, p0[r]); for (int r = 0; r < 16; ++r) pmax = fmaxf(pmax, p1[r]);
    { auto rr = __builtin_amdgcn_permlane32_swap(__float_as_uint(pmax), __float_as_uint(pmax), false, false);
      pmax = fmaxf(__uint_as_float(rr[0]), __uint_as_float(rr[1])); }
    constexpr float C2 = 1.4426950408889634f * SCALE;
    if (__builtin_expect(__all((pmax - m_reg) * SCALE <= THR), 1)) { mn = m_reg; alpha = 1.f; }
    else { mn = fmaxf(m_reg, pmax); alpha = __builtin_amdgcn_exp2f((m_reg - mn) * C2); m_reg = mn; }
    const float mnL = -mn * C2;
    for (int r = 0; r < 16; ++r) p0[r] = fmaf(p0[r], C2, mnL); for (int r = 0; r < 16; ++r) p1[r] = fmaf(p1[r], C2, mnL);
    for (int r = 0; r < 16; ++r) p0[r] = __builtin_amdgcn_exp2f(p0[r]);
}
__device__ __forceinline__ void finishSM(f32x16& p0, f32x16& p1, float alpha, float& l_reg, bf16x8& pa0, bf16x8& pa1, bf16x8& pa2, bf16x8& pa3) {
    for (int r = 0; r < 16; ++r) p1[r] = __builtin_amdgcn_exp2f(p1[r]);
    float ps = 0; for (int r = 0; r < 16; ++r) ps += p0[r]; for (int r = 0; r < 16; ++r) ps += p1[r];
    { auto rr = __builtin_amdgcn_permlane32_swap(__float_as_uint(ps), __float_as_uint(ps), false, false);
      ps = __uint_as_float(rr[0]) + __uint_as_float(rr[1]); }
    l_reg = l_reg * alpha + ps;
#define PK4(P, B_, OUT) do { unsigned a0 = cvtpk(P[B_+0], P[B_+1]), a1 = cvtpk(P[B_+2], P[B_+3]);                          \
        unsigned b0 = cvtpk(P[B_+4], P[B_+5]), b1 = cvtpk(P[B_+6], P[B_+7]);                                             \
        auto r0 = __builtin_amdgcn_permlane32_swap(a0, b0, false, false); auto r1 = __builtin_amdgcn_permlane32_swap(a1, b1, false, false); \
        u32x4 w = {r0[0], r1[0], r0[1], r1[1]}; OUT = *reinterpret_cast<bf16x8*>(&w); } while (0)
    PK4(p0, 0, pa0); PK4(p0, 8, pa1); PK4(p1, 0, pa2); PK4(p1, 8, pa3);
#undef PK4
}
template <int KB, int MODE>
__device__ __forceinline__ void qkt(f32x16& p0, f32x16& p1, const char* K_lds, int r32, int hi, const bf16x8* qr, bool act, const char* bptr, int dq, bool interior) {
    constexpr bool SK = MODE == 1;
    const float NEG = -__builtin_inff();
    if (SK && !act) {
#pragma unroll
        for (int r = 0; r < 16; ++r) { p0[r] = NEG; p1[r] = NEG; } return; }
    if (MODE == 0) {
#pragma unroll
        for (int g = 0; g < 4; ++g) { const f32x4 v0 = *(const f32x4*)(bptr + 32 * g), v1 = *(const f32x4*)(bptr + 128 + 32 * g);
#pragma unroll
            for (int j = 0; j < 4; ++j) { p0[4 * g + j] = v0[j]; p1[4 * g + j] = v1[j]; } }
    } else if (interior) {
#pragma unroll
        for (int r = 0; r < 16; ++r) { const int c = (r & 3) + 8 * (r >> 2); p0[r] = *(const float*)(bptr + 4 * c); p1[r] = *(const float*)(bptr + 4 * c + 128); }
    } else {
#pragma unroll
        for (int r = 0; r < 16; ++r) { const int c = (r & 3) + 8 * (r >> 2);
            const float b0 = *(const float*)(bptr + 4 * c), b1 = *(const float*)(bptr + 4 * c + 128);
            p0[r] = ((unsigned)(dq - c) < (unsigned)DILW) ? b0 : NEG; p1[r] = ((unsigned)(dq - c - 32) < (unsigned)DILW) ? b1 : NEG; }
    }
    const char* kb[4];
#pragma unroll
    for (int dd = 0; dd < 4; ++dd) kb[dd] = K_lds + KB * SHM_K + KSWZ(r32, (dd * 16 + hi * 8) * 2);
#pragma unroll
    for (int d0 = 0; d0 < 8; ++d0) { const char* a = kb[d0 & 3] + (d0 >> 2) * 128;
        bf16x8 b0 = *reinterpret_cast<const bf16x8*>(a);
        bf16x8 b1 = *reinterpret_cast<const bf16x8*>(a + 32 * 256);
        p0 = __builtin_amdgcn_mfma_f32_32x32x16_bf16(b0, qr[d0], p0, 0, 0, 0);
        p1 = __builtin_amdgcn_mfma_f32_32x32x16_bf16(b1, qr[d0], p1, 0, 0, 0); }
}
template <int VB, bool SK>
__device__ __forceinline__ void pv_tile(f32x16* o, int vb0, bf16x8 pa0, bf16x8 pa1, bf16x8 pa2, bf16x8 pa3, bool act) {
    if (SK && !act) return;
#define TRRD(dst, off) asm volatile("ds_read_b64_tr_b16 %0, %1 offset:%2" : "=&v"(dst) : "v"(vb0), "i"(off) : "memory")
#define PV_D0(d0) do { s16x4 l0, l1, l2, l3, h0, h1, h2, h3; constexpr int b_ = VB * SHM_V + v_rd_off(d0, 0, 0);  \
        TRRD(l0, b_); TRRD(h0, b_ + 2048); TRRD(l1, b_ + 4096); TRRD(h1, b_ + 6144); TRRD(l2, b_ + 8192); TRRD(h2, b_ + 10240); TRRD(l3, b_ + 12288); TRRD(h3, b_ + 14336); \
        asm volatile("s_waitcnt lgkmcnt(0)" ::: "memory"); SBAR();   \
        o[d0] = __builtin_amdgcn_mfma_f32_32x32x16_bf16(pa0, (bf16x8){l0[0], l0[1], l0[2], l0[3], h0[0], h0[1], h0[2], h0[3]}, o[d0], 0, 0, 0);   \
        o[d0] = __builtin_amdgcn_mfma_f32_32x32x16_bf16(pa1, (bf16x8){l1[0], l1[1], l1[2], l1[3], h1[0], h1[1], h1[2], h1[3]}, o[d0], 0, 0, 0);   \
        o[d0] = __builtin_amdgcn_mfma_f32_32x32x16_bf16(pa2, (bf16x8){l2[0], l2[1], l2[2], l2[3], h2[0], h2[1], h2[2], h2[3]}, o[d0], 0, 0, 0);   \
        o[d0] = __builtin_amdgcn_mfma_f32_32x32x16_bf16(pa3, (bf16x8){l3[0], l3[1], l3[2], l3[3], h3[0], h3[1], h3[2], h3[3]}, o[d0], 0, 0, 0); } while (0)
    PV_D0(0); PV_D0(1); PV_D0(2); PV_D0(3);
#undef PV_D0
#undef TRRD
}

struct BlockRef { const bf16_t* Q; const bf16_t* K; const bf16_t* V; bf16_t* O; float* lse; const float* gb; int P0, rs, os, ls, jlo, tab; };
struct Seam { bf16x8 qr[8]; bf16x8 st_v0, st_v1, st_k0, st_k1; };
#define ROWP(p, rs_, k0, rr) ((p) + (size_t)((k0) + (rr)) * (rs_) + sc)
#define VMW() asm volatile("s_waitcnt vmcnt(0)" ::: "memory")
#define VMWN(n) asm volatile("s_waitcnt vmcnt(%0)" :: "i"(n) : "memory")
#define SLOAD_H(Kp, Vp, rs_, k0, vo) do { const char* kb_ = (const char*)((Kp) + (size_t)(k0) * (rs_)); const char* vb_ = (const char*)((Vp) + (size_t)(k0) * (rs_)); const size_t h_ = (size_t)64 * (rs_); \
                         S.st_v0 = gld8(vb_, vo); S.st_v1 = gld8(vb_ + h_, vo); S.st_k0 = gld8(kb_, vo); S.st_k1 = gld8(kb_ + h_, vo); } while (0)
#define SWRITE_HK(bf) do { *(bf16x8*)(K_lds + (bf) * SHM_K + kws) = S.st_k0; *(bf16x8*)(K_lds + (bf) * SHM_K + kws + 32 * 256) = S.st_k1; } while (0)
#define SWRITE_HV(bf) do { *(bf16x8*)(V_lds + (bf) * SHM_V + vst0) = S.st_v0; *(bf16x8*)(V_lds + (bf) * SHM_V + vst1) = S.st_v1; } while (0)
#define SWRITE_H(bf) do { SWRITE_HV(bf); SWRITE_HK(bf); } while (0)
__device__ __forceinline__ void attn_prime(const BlockRef& cur, char* lds, Seam& S, const int tid) {
    const int wid = __builtin_amdgcn_readfirstlane(tid >> 6), lane = tid & 63, r32 = lane & 31, hi = lane >> 5;
    const int sr = tid >> 4, sc = (tid & 15) * 8, kws = KSWZ(sr, sc * 2); char* K_lds = lds + 2 * SHM_V;
    const int kb0 = cur.jlo * KVBLK;
    { const char* qb_ = (const char*)(cur.Q + (size_t)(wid * QBLK) * cur.rs); const unsigned qv_ = (unsigned)(r32 * cur.rs + hi * 8) * 2u;
      for (int d0 = 0; d0 < 8; ++d0) S.qr[d0] = gld8(qb_ + d0 * 32, qv_); }
    { const unsigned vo_ = (unsigned)(sr * cur.rs + sc) * 2u; SLOAD_H(cur.K, cur.V, cur.rs, kb0, vo_); } VMW(); SWRITE_HK(0);
    __syncthreads();
}
template <int MODE>
__device__ __forceinline__ void attn_block(const BlockRef& cur, const BlockRef& nxt, char* lds, Seam& S, const int tid) {
    constexpr bool SK = MODE == 1;
    constexpr int W = MODE == 1 ? DILW : (1 << 30);
    const int wid = __builtin_amdgcn_readfirstlane(tid >> 6), lane = tid & 63, r32 = lane & 31, hi = lane >> 5;
    const int j_lo = cur.jlo;
    const int j_hi = (cur.P0 + QB - 1) / KVBLK + 1;
    const int NT = j_hi - j_lo;
    const int kbn = nxt.jlo * KVBLK;
    const int qlo = cur.P0 + wid * QBLK, qm = qlo + r32 - 4 * hi;
    char* V_lds = lds; char* K_lds = lds + 2 * SHM_V;
    float* ws = (float*)(lds + 2 * SHM_V + 2 * SHM_K) + wid * 64; float* li_l = ws, * al_l = ws + 32;
    float m_reg = -1e30f, l_reg = 0; f32x16 o[4] = {};
    const int sr = tid >> 4, sc = (tid & 15) * 8, vst0 = v_st(sr, sc), vst1 = v_st(32 + sr, sc), kws = KSWZ(sr, sc * 2);
    const int vb0 = (int)(uintptr_t)V_lds + v_rd_base(lane);
    const bf16_t* Kh = cur.K; const bf16_t* Vh = cur.V; const int rs = cur.rs; const unsigned kvo = (unsigned)(sr * rs + sc) * 2u;
    const char* bb0 = (MODE == 0) ? (lds + LDS_BIAS + hi * 16) : (lds + cur.tab + (128 - qm) * 4);
#define RESC(a) do { if (__any((a) < 1.f)) { if (hi == 0) al_l[r32] = (a); asm volatile("s_waitcnt lgkmcnt(0)" ::: "memory");              \
                     for (int d_ = 0; d_ < 4; ++d_) for (int r = 0; r < 16; ++r) o[d_][r] *= al_l[crow(r, hi)]; } } while (0)
#define KBASE(t) ((j_lo + (t)) * KVBLK)
#define ACT(t) (KBASE(t) <= qlo + QBLK - 1 && KBASE(t) + KVBLK - 1 >= qlo - W + 1)
#define MASKT(P0_, P1_, t) do { if (MODE == 0) { const int kb_ = KBASE(t); if (kb_ + KVBLK - 1 > qlo) mask_tile(P0_, P1_, qm - kb_, (unsigned)W); } } while (0)
#define QKT(KB, PX0, PX1, t) qkt<KB, MODE>(PX0, PX1, K_lds, r32, hi, S.qr, ACT(t), bb0 + KBASE(t) * 4, qm - KBASE(t), (KBASE(t) + KVBLK - 1 <= qlo && KBASE(t) >= qlo + QBLK - 1 - (DILW - 1)))
#define PSM(PX0, PX1, mnX, alX, t) do { if (!SK || ACT(t)) partialSM(PX0, PX1, m_reg, mnX, alX); else { mnX = m_reg; alX = 1.f; } } while (0)
#define FSM(PY0, PY1, alY, t) do { if (!SK || ACT(t)) finishSM(PY0, PY1, alY, l_reg, pa0, pa1, pa2, pa3); } while (0)
    constexpr int NQL = 8;
#define SEAM_K0() do { VMWN(NQL); SWRITE_HK(0); SBAR(); } while (0)
    f32x16 pA0, pA1, pB0, pB1; float mnA, mnB, alA, alB; bf16x8 pa0, pa1, pa2, pa3;
    SWRITE_HV(0); SBAR();
    if (NT > 1) { SLOAD_H(Kh, Vh, rs, KBASE(1), kvo); }
    SBAR(); QKT(0, pA0, pA1, 0);
    MASKT(pA0, pA1, 0); PSM(pA0, pA1, mnA, alA, 0);
    if (NT > 1) { VMW(); SWRITE_H(1); }
    __syncthreads();
#define HALF_STEP(PX0, PX1, mnX, alX, PY0, PY1, alY, t, KB, VB, SB) do {                                                      \
        SBAR(); QKT(KB, PX0, PX1, t);                                             \
        FSM(PY0, PY1, alY, (t) - 1); SBAR();                                                           \
        if ((t) + 1 < NT) { SLOAD_H(Kh, Vh, rs, KBASE((t) + 1), kvo); SBAR(); }                                               \
        pv_tile<VB, SK>(o, vb0, pa0, pa1, pa2, pa3, ACT((t) - 1)); MASKT(PX0, PX1, (t)); PSM(PX0, PX1, mnX, alX, (t));                                        \
        __syncthreads();                                                                                                      \
        if ((t) + 1 < NT) { VMW(); SWRITE_H(SB); }                                                                          \
        RESC(alX); __syncthreads(); } while (0)
    for (int t = 1; t + 1 < NT; t += 2) {
        HALF_STEP(pB0, pB1, mnB, alB, pA0, pA1, alA, t, 1, 0, 0);
        HALF_STEP(pA0, pA1, mnA, alA, pB0, pB1, alB, t + 1, 0, 1, 1);
    }
    const bool even = (NT & 1) == 0;
    if (even) { SBAR(); QKT(1, pB0, pB1, NT - 1); SBAR(); }
    { const unsigned vo_ = (unsigned)(sr * nxt.rs + sc) * 2u; SLOAD_H(nxt.K, nxt.V, nxt.rs, kbn, vo_); } SBAR();
    { const char* qb_ = (const char*)(nxt.Q + (size_t)(wid * QBLK) * nxt.rs); const unsigned qv_ = (unsigned)(r32 * nxt.rs + hi * 8) * 2u;
#pragma unroll
      for (int d0 = 0; d0 < 8; ++d0) S.qr[d0] = gld8(qb_ + d0 * 32, qv_); }
    SBAR();
    FSM(pA0, pA1, alA, (even ? NT - 2 : NT - 1)); SBAR();
    pv_tile<0, SK>(o, vb0, pa0, pa1, pa2, pa3, ACT(even ? NT - 2 : NT - 1));
    if (even) { MASKT(pB0, pB1, NT - 1); PSM(pB0, pB1, mnB, alB, NT - 1); __syncthreads(); RESC(alB);
        FSM(pB0, pB1, alB, NT - 1); SBAR(); pv_tile<1, SK>(o, vb0, pa0, pa1, pa2, pa3, ACT(NT - 1)); }
    SBAR(); SEAM_K0();
    if (hi == 0) li_l[r32] = l_reg; asm volatile("s_waitcnt lgkmcnt(0)" ::: "memory");
    float rli[16];
#pragma unroll
    for (int r = 0; r < 16; ++r) rli[r] = __builtin_amdgcn_rcpf(li_l[crow(r, hi)]);
    int os_ = __builtin_amdgcn_readfirstlane(cur.os); asm volatile("" : "+s"(os_));
    bf16_t* Ow = cur.O + (size_t)(wid * QBLK) * os_; const unsigned ovo = (unsigned)(4 * hi * os_ + r32) * 2u;
#pragma unroll
    for (int r = 0; r < 16; ++r) { char* ob_ = (char*)(Ow + (size_t)((r & 3) + 8 * (r >> 2)) * os_);
#pragma unroll
        for (int d0 = 0; d0 < 4; ++d0) { const float v = o[d0][r] * rli[r];
            const float vn = __shfl_xor(v, 1);
            if ((r32 & 1) == 0) *(unsigned*)(ob_ + d0 * 64 + ovo) = cvtpk(v, vn); } }
    if (MODE == 0) {
#pragma unroll
        for (int r = 0; r < 16; ++r) { float ss = 0.f;
#pragma unroll
            for (int d0 = 0; d0 < 4; ++d0) { const float v = o[d0][r] * rli[r]; ss += v * v; }
            ss += __shfl_xor(ss, 1); ss += __shfl_xor(ss, 2); ss += __shfl_xor(ss, 4); ss += __shfl_xor(ss, 8); ss += __shfl_xor(ss, 16);
            if (r32 == 0) atomicAdd(cur.lse + (wid * QBLK + crow(r, hi)), ss); }
    }
    if (MODE == 1) { constexpr float C2 = 1.4426950408889634f * SCALE;
        if (hi == 0) cur.lse[(size_t)(wid * QBLK + r32) * cur.ls] = m_reg * C2 + __builtin_amdgcn_logf(l_reg); }
    __syncthreads();
#undef RESC
#undef KBASE
#undef ACT
#undef MASKT
#undef QKT
#undef PSM
#undef FSM
#undef SEAM_K0
#undef HALF_STEP
}
#undef ROWP
#undef VMW
#undef VMWN
#undef SLOAD_H
#undef SWRITE_HK
#undef SWRITE_HV
#undef SWRITE_H
#undef KSWZ
#undef SBAR
}
constexpr int SEQ = 8192, DM = 4096, NH = 16, HD = 128, FW = 2048, NQKV = 12288, INW = 12304, DFF = 11008, NUP = 22016;
constexpr float RMS_EPS = 1e-6f;
constexpr float INV_SCALE = 11.313708498984761f;
constexpr int NWAVES = 8;
constexpr size_t MiB = 1u << 20;
constexpr size_t WS_WIN = 0, WS_WF = 96 * MiB, WS_WOUT = 97 * MiB, WS_WUP = 129 * MiB, WS_WDN = 301 * MiB, WS_XN = 387 * MiB, WS_X1 = 453 * MiB, WS_ACT = 581 * MiB;
constexpr size_t WS_MISC = 753 * MiB, WS_CTL = WS_MISC + 3 * MiB, CTL_NORM = 64, CTL_SSQ = 4096, CTL_SSQ2 = 4096 + 32768, CTL_BAR = 4096 + 2 * 32768, CTL_SSQA = CTL_BAR + 16384, CTL_BYTES = CTL_SSQA + 32768;
constexpr size_t WS_LOGF = WS_MISC, WS_CNEG = WS_MISC + 1 * MiB, WS_TAB = WS_MISC + 2 * MiB, WS_GB = WS_MISC + 4 * MiB, WS_GF = WS_MISC + 16 * MiB, WS_VF = WS_MISC + 28 * MiB;
constexpr size_t WS_QKV = 817 * MiB, WS_OA = WS_QKV + 192 * MiB, WS_OB = WS_OA + 32 * MiB, WS_LSE = WS_OB + 96 * MiB, WS_MIX = WS_LSE + 2 * MiB, WS_END = WS_MIX + 64 * MiB;
static_assert((size_t)(SEQ / 64) * 2 * DFF * 4 <= 12 * MiB, "side buffers");
constexpr int EPI_SLOTS = 11;
constexpr int LDS_BYTES = 131072 + 1024 + EPI_SLOTS * 2048 + 1024;
static_assert(att::LDS_END <= 131072 + 8192, "attention LDS");
static_assert(8 * 16640 <= LDS_BYTES, "P0 transpose scratch");

#define LAS __attribute__((address_space(3)))
typedef unsigned short bf16;
typedef unsigned v4u __attribute__((ext_vector_type(4)));
typedef unsigned v2u __attribute__((ext_vector_type(2)));
typedef float f32x4 __attribute__((ext_vector_type(4)));
typedef short bf16x8 __attribute__((ext_vector_type(8)));
#define LDS_WAIT() asm volatile("s_waitcnt lgkmcnt(0)" ::: "memory")
__device__ __forceinline__ unsigned pk2(float lo, float hi) { unsigned r; asm volatile("v_cvt_pk_bf16_f32 %0, %1, %2" : "=v"(r) : "v"(lo), "v"(hi)); return r; }
__device__ __forceinline__ float bflo(unsigned u) { return __uint_as_float(u << 16); }
__device__ __forceinline__ float bfhi(unsigned u) { return __uint_as_float(u & 0xffff0000u); }
__device__ __forceinline__ float wave_sum(float v) {
#pragma unroll
    for (int o = 1; o < 64; o <<= 1) v += __shfl_xor(v, o);
    return v;
}
typedef float f32x2 __attribute__((ext_vector_type(2)));
__device__ __forceinline__ void tr_item(const float* W, size_t ldw, int Kdim, bf16* WT, LAS float* scr, int k0, int lane, const float* gk = nullptr) {
    const float* wp = W + (size_t)(k0 + (lane >> 5)) * ldw + 2 * (lane & 31); f32x2 v[32];
#pragma unroll
    for (int i = 0; i < 32; ++i) v[i] = *(const f32x2*)(wp + (size_t)(2 * i) * ldw);
#pragma unroll
    for (int i = 0; i < 32; ++i) { LAS float* d = scr + (2 * i + (lane >> 5)) * 65 + 2 * (lane & 31); d[0] = v[i].x; d[1] = v[i].y; }
    const int c = lane & 7;
    f32x4 g0 = {1.f, 1.f, 1.f, 1.f}, g1 = g0; if (gk) { g0 = *(const f32x4*)(gk + k0 + 8 * c); g1 = *(const f32x4*)(gk + k0 + 8 * c + 4); }
    LDS_WAIT(); asm volatile("" ::: "memory");
#pragma unroll
    for (int j = 0; j < 8; ++j) { const int n = (lane >> 3) + 8 * j; const LAS float* s = scr + (8 * c) * 65 + n;
        v4u o; o.x = pk2(s[0 * 65] * g0.x, s[1 * 65] * g0.y); o.y = pk2(s[2 * 65] * g0.z, s[3 * 65] * g0.w); o.z = pk2(s[4 * 65] * g1.x, s[5 * 65] * g1.y); o.w = pk2(s[6 * 65] * g1.z, s[7 * 65] * g1.w);
        *(v4u*)(WT + (size_t)n * Kdim + k0 + 8 * c) = o; }
    LDS_WAIT(); asm volatile("" ::: "memory");
}
__device__ __forceinline__ void rms_row_bf16(const float* xrow, const float* g, bf16* orow, int lane) {
    const f32x4* xr = (const f32x4*)xrow + lane; f32x4 v[16]; float s = 0.f;
#pragma unroll
    for (int j = 0; j < 16; ++j) { v[j] = xr[64 * j]; s += (v[j].x * v[j].x + v[j].y * v[j].y) + (v[j].z * v[j].z + v[j].w * v[j].w); }
    const float r = rsqrtf(wave_sum(s) * (1.f / DM) + RMS_EPS);
    const f32x4* gr = (const f32x4*)g + lane; v2u* o8 = (v2u*)orow + lane;
#pragma unroll
    for (int j = 0; j < 16; ++j) { const f32x4 gg = gr[64 * j]; v2u w; w.x = pk2(v[j].x * r * gg.x, v[j].y * r * gg.y); w.y = pk2(v[j].z * r * gg.z, v[j].w * r * gg.w); o8[64 * j] = w; }
}
__device__ __forceinline__ void rms_row_f32(const float* xrow, const float* g, float* orow, int lane) {
    const f32x4* xr = (const f32x4*)xrow + lane; f32x4 v[16]; float s = 0.f;
#pragma unroll
    for (int j = 0; j < 16; ++j) { v[j] = xr[64 * j]; s += (v[j].x * v[j].x + v[j].y * v[j].y) + (v[j].z * v[j].z + v[j].w * v[j].w); }
    const float r = rsqrtf(wave_sum(s) * (1.f / DM) + RMS_EPS);
    const f32x4* gr = (const f32x4*)g + lane; f32x4* o = (f32x4*)orow + lane;
#pragma unroll
    for (int j = 0; j < 16; ++j) { const f32x4 gg = gr[64 * j]; o[64 * j] = v[j] * r * gg; }
}
__device__ __forceinline__ int t5_bucket(int dist) {
    if (dist < 16) return dist;
    const float df = (float)dist;
    int large = 16 + (int)(logf(df / 16.0f) / 4.852030263919617f * 16.0f);
    return large < 31 ? large : 31;
}

__device__ __forceinline__ int lane_id_v() { int l; asm volatile("v_mbcnt_lo_u32_b32 %0, -1, 0\n\tv_mbcnt_hi_u32_b32 %0, -1, %0" : "=v"(l)); return l; }
#define XB_CEN(j)  (64 * (j))
#define XB_ARR(j)  (64 * (16 + (j)))
#define XB_REL(j)  (64 * (32 + (j)))
#define XB_TOP     (64 * 48)
#define XB_TOPGEN  (64 * 49)
#define XB_WORDS   (64 * 50)
__device__ __forceinline__ unsigned xb_ld(unsigned* p) { return __hip_atomic_load(p, __ATOMIC_RELAXED, __HIP_MEMORY_SCOPE_AGENT); }
__device__ __forceinline__ unsigned xb_add(unsigned* p, unsigned v) { return __hip_atomic_fetch_add(p, v, __ATOMIC_RELAXED, __HIP_MEMORY_SCOPE_AGENT); }
__device__ __forceinline__ void xb_st(unsigned* p, unsigned v) { __hip_atomic_store(p, v, __ATOMIC_RELAXED, __HIP_MEMORY_SCOPE_AGENT); }
__device__ __forceinline__ unsigned xcc_id() { return (unsigned)__builtin_amdgcn_s_getreg((3 << 11) | 20) & 0xFu; }
__device__ __forceinline__ void grid_barrier(unsigned* bar, unsigned r, unsigned x, unsigned nloc, unsigned nx, int tid) {
    asm volatile("s_waitcnt vmcnt(0) lgkmcnt(0)" ::: "memory");
    __syncthreads();
    if (tid == 0) {
        const unsigned old = xb_add(bar + XB_ARR(x), 1u);
        if (old + 1u == nloc * r) {
            __builtin_amdgcn_fence(__ATOMIC_RELEASE, "agent");
            asm volatile("s_waitcnt vmcnt(0)" ::: "memory");
            const unsigned o2 = xb_add(bar + XB_TOP, 1u);
            if (o2 + 1u == nx * r) xb_st(bar + XB_TOPGEN, r);
            else while (xb_ld(bar + XB_TOPGEN) < r) __builtin_amdgcn_s_sleep(1);
            xb_st(bar + XB_REL(x), r);
        } else { while (xb_ld(bar + XB_REL(x)) < r) __builtin_amdgcn_s_sleep(1); }
        __builtin_amdgcn_fence(__ATOMIC_ACQUIRE, "agent");
        asm volatile("s_waitcnt vmcnt(0)" ::: "memory");
    }
    __syncthreads();
}
struct Args { const float* in[14]; float* out; unsigned char* ws; int ph_lo, ph_hi; };
enum { I_X = 0, I_ANG, I_WIN, I_FB, I_RBT, I_FOG, I_DOG, I_WOUT, I_FNG, I_WUP, I_CW, I_CB, I_WDN, I_FING };
constexpr int N_PHASES = 11;
constexpr int DN_KB_SPLIT = 129;
#define PROBE_FOX 1
#define PROBE_DIL 1
#ifndef PROBE_PH
#define PROBE_PH -1
#endif

__global__ void __launch_bounds__(NWAVES * 64, 2) hymba_fwd(Args args) {
    extern __shared__ __attribute__((aligned(16))) unsigned char lds[];
    cg::grid_group grid = cg::this_grid();
    const int wave = __builtin_amdgcn_readfirstlane((int)threadIdx.x >> 6);
    const int G = gridDim.x; const int bx = blockIdx.x; const int vcu = (G % 8 == 0) ? (bx % 8) * (G / 8) + bx / 8 : bx;
    const int gw = vcu * NWAVES + wave, NGW = G * NWAVES;
    unsigned char* ws = args.ws;
    bf16* WinT = (bf16*)(ws + WS_WIN); bf16* WfT = (bf16*)(ws + WS_WF); bf16* WoutT = (bf16*)(ws + WS_WOUT); bf16* WupT = (bf16*)(ws + WS_WUP); bf16* WdnT = (bf16*)(ws + WS_WDN);
    bf16* XN = (bf16*)(ws + WS_XN); float* X1 = (float*)(ws + WS_X1); bf16* ACT = (bf16*)(ws + WS_ACT);
    int* JLO = (int*)(ws + WS_TAB + 65536); float* LOGF = (float*)(ws + WS_LOGF); float* CNEG = (float*)(ws + WS_CNEG); float* TAB = (float*)(ws + WS_TAB);
    float* GB = (float*)(ws + WS_GB); float* GF = (float*)(ws + WS_GF); float* VF = (float*)(ws + WS_VF);
    bf16* QKV = (bf16*)(ws + WS_QKV); bf16* OA = (bf16*)(ws + WS_OA); bf16* OB = (bf16*)(ws + WS_OB); float* LSE = (float*)(ws + WS_LSE); bf16* MIX = (bf16*)(ws + WS_MIX);
    const int lo = args.ph_lo, hi_ph = args.ph_hi;
#define IN(k) (lo <= (k) && (k) < hi_ph)
#define REP(k) ((PROBE_PH == (k)) ? 2 : 1)
    unsigned* gbar = (unsigned*)(ws + WS_CTL + CTL_BAR);
    const unsigned xid = xcc_id(); if (threadIdx.x == 0) (void)xb_add(gbar + XB_CEN(xid), 1u);
    unsigned xb_nloc = 1u, xb_nx = 1u; unsigned* NORM = (unsigned*)(ws + WS_CTL + CTL_NORM); float* SSQ = (float*)(ws + WS_CTL + CTL_SSQ); float* SSQ2 = (float*)(ws + WS_CTL + CTL_SSQ2); float* SSQA = (float*)(ws + WS_CTL + CTL_SSQA);
    unsigned nbar = 0;
#define SEAM(k) do { if (IN(k) && IN((k) + 1)) { if ((k) == 0) { asm volatile("s_waitcnt vmcnt(0) lgkmcnt(0)" ::: "memory");     \
        grid.sync(); xb_nx = 0u; for (unsigned j_ = 0; j_ < 16u; ++j_) { const unsigned c_ = xb_ld(gbar + XB_CEN(j_)); xb_nx += c_ ? 1u : 0u; if (j_ == xid) xb_nloc = c_; } \
        xb_nloc = (unsigned)__builtin_amdgcn_readfirstlane((int)xb_nloc); xb_nx = (unsigned)__builtin_amdgcn_readfirstlane((int)xb_nx); \
        ++nbar; grid_barrier(gbar, nbar, xid, xb_nloc, xb_nx, (int)threadIdx.x); }   \
      else if ((k) != 2 && (k) != 5) { ++nbar; grid_barrier(gbar, nbar, xid, xb_nloc, xb_nx, wave * 64 + lane_id_v()); } } } while (0)

    if (IN(0)) for (int rep_ = 0; rep_ < REP(0); ++rep_) {
        const int tid = threadIdx.x, lane = tid & 63;
        LAS float* scr = (LAS float*)((LAS unsigned char*)lds + wave * 16640);
        constexpr int KB4 = DM / 64;
        constexpr int I_IN = KB4 * (NQKV / 64), I_OUT = KB4 * (DM / 64);
        constexpr int I_DNB = ((DFF / 64) - DN_KB_SPLIT) * (DM / 64); constexpr int NITEMS = I_IN + I_OUT + I_DNB;
        for (int it = gw; it < NITEMS; it += NGW) {
            int r = it;
            if (r < I_IN) { const int nblk = NQKV / 64, kb = r / nblk, nb = r % nblk; const int n0 = nb * 64; const int src = n0 < 6144 ? n0 : n0 + 16;
                tr_item(args.in[I_WIN] + src, INW, DM, WinT + (size_t)n0 * DM, scr, kb * 64, lane); continue; } r -= I_IN;
            if (r < I_OUT) { const int nblk = DM / 64, kb = r / nblk, nb = r % nblk;
                tr_item(args.in[I_WOUT] + nb * 64, DM, DM, WoutT + (size_t)(nb * 64) * DM, scr, kb * 64, lane, (kb * 64 < FW) ? args.in[I_FOG] : args.in[I_DOG] - FW); continue; } r -= I_OUT;
            { const int nblk = DM / 64, kb = DN_KB_SPLIT + r / nblk, nb = r % nblk;
                tr_item(args.in[I_WDN] + nb * 64, DM, DFF, WdnT + (size_t)(nb * 64) * DFF, scr, kb * 64, lane); }
        }
        for (int m = gw; m < SEQ; m += NGW) rms_row_bf16(args.in[I_X] + (size_t)m * DM, args.in[I_ANG], XN + (size_t)m * DM, lane);
        for (int item = gw; item < 16 * (DM / 64); item += NGW) { const int j = item & 15, k = (item >> 4) * 64 + lane;
            const float v = args.in[I_WIN][(size_t)k * INW + 6144 + j]; WfT[(size_t)j * DM + k] = (bf16)(pk2(v, v) & 0xffffu); }
        for (int idx = bx * (NWAVES * 64) + tid; idx < 48 * 132; idx += G * NWAVES * 64) { const int t = idx / 132, i = idx % 132, br = t / 16, h = t % 16;
            float v = 0.f; if (i <= 128) { const int dil = br == 0 ? 1 : (br == 1 ? 4 : 16); v = args.in[I_RBT][t5_bucket((128 - i) * dil) * 16 + h] * INV_SCALE; }
            TAB[idx] = v; }
    }
    SEAM(0);
    if (IN(1)) for (int rep_ = 0; rep_ < REP(1); ++rep_) {
        pg8::Gemm g{XN, WinT, SEQ, NQKV, DM}; pg8::StaticOrder S; S.init(SEQ, NQKV, G, bx);
        pg8::EpiQKV E{QKV, SEQ, NORM};
        const int lane = lane_id_v(), tid = wave * 64 + lane;
        pg8::gemm_phase<pg8::EpiQKV, pg8::StaticOrder, true, true>((LAS unsigned char*)lds, g, S, E, tid);
        for (int task = bx; task < SEQ / 32; task += G) {
            const int t0 = task * 32, row = lane & 15, quad = lane >> 4;
            const bf16* ap = XN + (size_t)(t0 + row) * DM + wave * 512 + quad * 8; const bf16* bp = WfT + (size_t)row * DM + wave * 512 + quad * 8;
            f32x4 acc0 = {0.f, 0.f, 0.f, 0.f}, acc1 = acc0;
#pragma unroll
            for (int k0 = 0; k0 < 512; k0 += 32) { const bf16x8 a0 = *(const bf16x8*)(ap + k0), a1 = *(const bf16x8*)(ap + (size_t)16 * DM + k0), b = *(const bf16x8*)(bp + k0);
                acc0 = __builtin_amdgcn_mfma_f32_16x16x32_bf16(a0, b, acc0, 0, 0, 0); acc1 = __builtin_amdgcn_mfma_f32_16x16x32_bf16(a1, b, acc1, 0, 0, 0); }
            LAS f32x4* red = (LAS f32x4*)lds;
            red[wave * 128 + lane] = acc0; red[wave * 128 + 64 + lane] = acc1;
            __syncthreads();
            if (wave == 0) {
#pragma unroll
                for (int w = 1; w < 8; ++w) { acc0 += red[w * 128 + lane]; acc1 += red[w * 128 + 64 + lane]; }
                const int h = lane & 15; const float fb = args.in[I_FB][h];
#pragma unroll
                for (int j = 0; j < 4; ++j) { const float x0 = acc0[j] + fb, x1 = acc1[j] + fb;
                    LOGF[(size_t)h * SEQ + t0 + quad * 4 + j] = fminf(x0, 0.f) - log1pf(expf(-fabsf(x0)));
                    LOGF[(size_t)h * SEQ + t0 + 16 + quad * 4 + j] = fminf(x1, 0.f) - log1pf(expf(-fabsf(x1))); }
            }
            __syncthreads();
        }
    }
    SEAM(1);
    SEAM(2);
    if (IN(3)) for (int rep_ = 0; rep_ < REP(3); ++rep_) {
        char* al = (char*)lds; const int tid = wave * 64 + lane_id_v();
        for (int i = tid; i < 48 * 132; i += NWAVES * 64) ((float*)(al + att::LDS_DTAB))[i] = TAB[i];
        __syncthreads();
        att::Seam S;
        if (vcu < 256) {
            const int L_ = vcu; const int h_ = L_ >> 4, pr_ = L_ & 15, lane_ = tid & 63;
            float* cbl = (float*)(al + att::LDS_BIAS); float* wsum = (float*)(al + 2 * att::SHM_V + 2 * att::SHM_K);
            { const f32x4* lf = (const f32x4*)(LOGF + (size_t)h_ * SEQ + tid * 16); f32x4 v[4]; float p[16]; float run = 0.f;
#pragma unroll
              for (int i = 0; i < 4; ++i) v[i] = lf[i];
#pragma unroll
              for (int i = 0; i < 4; ++i) { run += v[i].x; p[4 * i] = run; run += v[i].y; p[4 * i + 1] = run; run += v[i].z; p[4 * i + 2] = run; run += v[i].w; p[4 * i + 3] = run; }
              float inc = run;
#pragma unroll
              for (int o = 1; o < 64; o <<= 1) { const float t_ = __shfl_up(inc, o); if (lane_ >= o) inc += t_; }
              if (lane_ == 63) wsum[wave] = inc;
              __syncthreads();
              float off = inc - run;
              for (int w = 0; w < wave; ++w) off += wsum[w];
#pragma unroll
              for (int i = 0; i < 4; ++i) { f32x4 o; o.x = -(off + p[4 * i]) * INV_SCALE; o.y = -(off + p[4 * i + 1]) * INV_SCALE; o.z = -(off + p[4 * i + 2]) * INV_SCALE; o.w = -(off + p[4 * i + 3]) * INV_SCALE; ((f32x4*)cbl)[tid * 4 + i] = o; }
              __syncthreads(); }
            float qn2 = 0.f, kn2 = 0.f;
#pragma unroll
            for (int w = 0; w < 4; ++w) { qn2 += __uint_as_float(NORM[h_ * 4 + w]); kn2 += __uint_as_float(NORM[(16 + h_) * 4 + w]); }
            const float thr = (28.f + 2.02f * sqrtf(qn2 * kn2) * att::SCALE) * INV_SCALE;
#define FOX_REF(R, pass) do { const int qb_ = (pass) ? 31 - pr_ : pr_; \
            R.Q = QKV + ((size_t)(0 * 16 + h_) * SEQ + (size_t)qb_ * 256) * 128; R.K = QKV + (size_t)(1 * 16 + h_) * SEQ * 128; R.V = QKV + (size_t)(2 * 16 + h_) * SEQ * 128; \
            R.O = MIX + (size_t)qb_ * 256 * DM + h_ * 128; R.lse = SSQA + qb_ * 256; R.gb = nullptr; R.P0 = qb_ * 256; R.rs = 128; R.os = DM; R.ls = 1; R.tab = 0; \
            { const float lim_ = cbl[R.P0] - thr; const int nt_ = R.P0 >> 6; int cnt_ = 0; \
              for (int b_ = 0; b_ < nt_; b_ += 64) { const int j_ = b_ + lane_; const bool sk_ = (j_ < nt_) && (cbl[64 * (j_ < nt_ ? j_ : 0) + 63] <= lim_); cnt_ += __popcll(__ballot(sk_)); } R.jlo = cnt_; } } while (0)
            att::BlockRef cur, nxt; FOX_REF(cur, 0); att::attn_prime(cur, al, S, tid);
            FOX_REF(nxt, 1); att::attn_block<0>(cur, nxt, al, S, tid); cur = nxt;
            att::attn_block<0>(cur, cur, al, S, tid);
#undef FOX_REF
        }
        { const int per = (1536 + G - 1) / G; const int L0 = vcu * per; const int L1 = (L0 + per < 1536) ? L0 + per : 1536;
#define DIL_REF(R, L) do { const int h_ = (L) / 96, rem_ = (L) % 96, br_ = rem_ >> 5, idx_ = rem_ & 31; const int dil_ = br_ == 0 ? 1 : (br_ == 1 ? 4 : 16); const int nq_ = 32 / dil_; \
            const int cls_ = idx_ / nq_, qb_ = idx_ % nq_; const size_t tok0_ = (size_t)cls_ + (size_t)qb_ * 256 * dil_; \
            R.Q = QKV + ((size_t)(3 * 16 + h_) * SEQ + tok0_) * 128; R.K = QKV + ((size_t)(4 * 16 + h_) * SEQ + cls_) * 128; R.V = QKV + ((size_t)(5 * 16 + h_) * SEQ + cls_) * 128; \
            R.O = OB + ((size_t)br_ * SEQ + tok0_) * FW + h_ * 128; R.lse = LSE + (size_t)(br_ * 16 + h_) * SEQ + (size_t)cls_ * (SEQ / dil_) + (size_t)qb_ * 256; R.gb = nullptr; R.P0 = qb_ * 256; R.rs = 128 * dil_; R.os = FW * dil_; R.ls = 1;     \
            { const int lowk_ = qb_ * 256 - 128; R.jlo = lowk_ > 0 ? lowk_ / 64 : 0; } R.tab = att::LDS_DTAB + (br_ * 16 + h_) * att::DTAB_STRIDE; } while (0)
          if (L0 < L1) { att::BlockRef cur, nxt; DIL_REF(cur, L0); att::attn_prime(cur, al, S, tid);
            const int nd = (L1 - L0) * PROBE_DIL;
            for (int i = 0; i < nd; ++i) { if (i + 1 < nd) DIL_REF(nxt, L0 + (i + 1) % (L1 - L0)); else nxt = cur; att::attn_block<1>(cur, nxt, al, S, tid); cur = nxt; } }
#undef DIL_REF
        }
    }
    SEAM(3);
    if (IN(4)) for (int rep_ = 0; rep_ < REP(4); ++rep_) {
        const float* ga = args.in[I_FOG]; const float* gd = args.in[I_DOG]; const int lane = lane_id_v();
        for (int t = gw; t < SEQ; t += NGW) {
            { float v[4][8]; float ss = 0.f;
#pragma unroll
              for (int j = 0; j < 4; ++j) { const int col = 8 * (lane + 64 * j), h = col >> 7;
                  const float l0 = LSE[(size_t)(0 * 16 + h) * SEQ + t], l1 = LSE[(size_t)(1 * 16 + h) * SEQ + (size_t)(t & 3) * (SEQ / 4) + (t >> 2)], l2 = LSE[(size_t)(2 * 16 + h) * SEQ + (size_t)(t & 15) * (SEQ / 16) + (t >> 4)];
                  const float mx = fmaxf(l0, fmaxf(l1, l2)); float w0 = __builtin_amdgcn_exp2f(l0 - mx), w1 = __builtin_amdgcn_exp2f(l1 - mx), w2 = __builtin_amdgcn_exp2f(l2 - mx);
                  const float inv = 1.f / (w0 + w1 + w2); w0 *= inv; w1 *= inv; w2 *= inv;
                  const v4u a = *(const v4u*)(OB + ((size_t)0 * SEQ + t) * FW + col), b = *(const v4u*)(OB + ((size_t)1 * SEQ + t) * FW + col), c = *(const v4u*)(OB + ((size_t)2 * SEQ + t) * FW + col);
#pragma unroll
                  for (int e = 0; e < 4; ++e) { v[j][2 * e] = w0 * bflo(a[e]) + w1 * bflo(b[e]) + w2 * bflo(c[e]); v[j][2 * e + 1] = w0 * bfhi(a[e]) + w1 * bfhi(b[e]) + w2 * bfhi(c[e]);
                      ss += v[j][2 * e] * v[j][2 * e] + v[j][2 * e + 1] * v[j][2 * e + 1]; } }
              const float r = rsqrtf(wave_sum(ss) * (1.f / FW) + RMS_EPS) * sqrtf(SSQA[t] * (1.f / FW) + RMS_EPS);
#pragma unroll
              for (int j = 0; j < 4; ++j) { const int col = 8 * (lane + 64 * j); v4u w;
                  w.x = pk2(v[j][0] * r, v[j][1] * r); w.y = pk2(v[j][2] * r, v[j][3] * r); w.z = pk2(v[j][4] * r, v[j][5] * r); w.w = pk2(v[j][6] * r, v[j][7] * r);
                  *(v4u*)(MIX + (size_t)t * DM + FW + col) = w; } }
        }
    }
    SEAM(4);
    if (IN(5)) for (int rep_ = 0; rep_ < REP(5); ++rep_) {
        pg8::Gemm g{MIX, WoutT, SEQ, DM, DM}; pg8::StaticOrder S; S.init(SEQ, DM, G, bx);
        pg8::EpiX1 E{args.in[I_X], XN, SSQ, DM, SSQA};
        pg8::gemm_phase<pg8::EpiX1, pg8::StaticOrder, true, true>((LAS unsigned char*)lds, g, S, E, wave * 64 + lane_id_v());
    }
    SEAM(5);
    if (IN(6)) for (int rep_ = 0; rep_ < REP(6); ++rep_) {
        const int lane = lane_id_v(); LAS float* scr = (LAS float*)((LAS unsigned char*)lds + wave * 16640);
        constexpr int I_UP = (DM / 64) * (NUP / 64);
        for (int r = gw; r < I_UP; r += NGW) { const int nblk = NUP / 64, kb = r / nblk, nb = r % nblk; const int n0 = nb * 64;
            const int f = n0 < DFF ? n0 : n0 - DFF; const int drow = 256 * (f >> 7) + (f & 127) + (n0 < DFF ? 0 : 128);
            tr_item(args.in[I_WUP] + n0, NUP, DM, WupT + (size_t)drow * DM, scr, kb * 64, lane, args.in[I_FNG]); }
    }
    SEAM(6);
    if (IN(7)) for (int rep_ = 0; rep_ < REP(7); ++rep_) {
        pg8::Gemm g{XN, WupT, SEQ, NUP, DM}; pg8::StaticOrder S; S.init(SEQ, NUP, G, bx);
        LAS float* rsL = (LAS float*)((LAS unsigned char*)lds + 131072); LAS float* cwL = rsL + 256;
        int pm0 = -1, pn0 = 0, nslot = 0;
        { const int tid_ = wave * 64 + lane_id_v(); pg8::Unit u0, ui;
          if (S.next(0, u0)) { pm0 = u0.pm; pn0 = u0.pn; nslot = 1;
            for (int i = 1; i < EPI_SLOTS && S.next(i, ui); ++i) { if (ui.pm != pm0 || ui.pn != pn0 + 4 * i) break; nslot = i + 1; }
            if (tid_ < 256) rsL[tid_] = rsqrtf(SSQ[pm0 * 256 + tid_] * (1.0f / 4096.0f) + 1e-6f);
            const int arr = tid_ >> 7, c = tid_ & 127;
            for (int i = 0; i < nslot; ++i) { const int col = (pn0 + 4 * i) * 128 + c; cwL[i * 512 + tid_] = arr < 3 ? args.in[I_CW][(size_t)arr * DFF + col] : args.in[I_CB][col]; } }
          __syncthreads(); }
        pg8::EpiGate E{ACT, DFF, args.in[I_CW], args.in[I_CB], GB, GF, VF, SSQ, rsL, cwL, pm0, pn0, nslot};
        pg8::gemm_phase<pg8::EpiGate, pg8::StaticOrder, true, true>((LAS unsigned char*)lds, g, S, E, wave * 64 + lane_id_v());
        { const int nwg = (SEQ / 256) * (NUP / 256), rem = nwg % G, first = rem ? rem : 0, nconv = rem ? G - rem : G;
          if (bx >= first) { const int lane = lane_id_v(); LAS float* scr = (LAS float*)((LAS unsigned char*)lds + wave * 16640);
            constexpr int I_DN = DN_KB_SPLIT * (DM / 64);
            for (int r = (bx - first) * NWAVES + wave; r < I_DN; r += nconv * NWAVES) { const int nblk = DM / 64, kb = r / nblk, nb = r % nblk;
                tr_item(args.in[I_WDN] + nb * 64, DM, DFF, WdnT + (size_t)(nb * 64) * DFF, scr, kb * 64, lane); } } }
    }
    SEAM(7);
    if (IN(8)) for (int rep_ = 0; rep_ < REP(8); ++rep_) {
        const float* cw = args.in[I_CW]; const float* cb = args.in[I_CB];
        const int total = (SEQ / 64) * 2 * (DFF / 4); const int tid = wave * 64 + lane_id_v();
        for (int idx = bx * (NWAVES * 64) + tid; idx < total; idx += G * NWAVES * 64) {
            const int c4 = idx % (DFF / 4), rk = idx / (DFF / 4), g64 = rk >> 1, k = rk & 1, c = c4 * 4;
            const f32x4 cur = *(const f32x4*)(GF + ((size_t)g64 * 2 + k) * DFF + c), val = *(const f32x4*)(VF + ((size_t)g64 * 2 + k) * DFF + c);
            f32x4 p1 = {0.f, 0.f, 0.f, 0.f}, p2 = {0.f, 0.f, 0.f, 0.f};
            if (k == 1) { p1 = *(const f32x4*)(GF + ((size_t)g64 * 2) * DFF + c); if (g64 > 0) p2 = *(const f32x4*)(GB + ((size_t)(g64 - 1) * 2 + 1) * DFF + c); }
            else if (g64 > 0) { p1 = *(const f32x4*)(GB + ((size_t)(g64 - 1) * 2 + 1) * DFF + c); p2 = *(const f32x4*)(GB + ((size_t)(g64 - 1) * 2) * DFF + c); }
            const f32x4 w0 = *(const f32x4*)(cw + c), w1 = *(const f32x4*)(cw + DFF + c), w2 = *(const f32x4*)(cw + 2 * DFF + c), b = *(const f32x4*)(cb + c);
            float a[4];
#pragma unroll
            for (int j = 0; j < 4; ++j) { const float gg = w2[j] * cur[j] + w1[j] * p1[j] + w0[j] * p2[j] + b[j]; a[j] = pg8::silu_f(gg) * val[j]; }
            v2u w; w.x = pk2(a[0], a[1]); w.y = pk2(a[2], a[3]);
            *(v2u*)(ACT + (size_t)(g64 * 64 + k) * DFF + c) = w;
        }
    }
    SEAM(8);
    if (IN(9)) for (int rep_ = 0; rep_ < REP(9); ++rep_) {
        pg8::Gemm g{ACT, WdnT, SEQ, DM, DFF}; pg8::StaticOrder S; S.init(SEQ, DM, G, bx);
        pg8::EpiX2 E{XN, SSQ2, DM};
        pg8::gemm_phase<pg8::EpiX2, pg8::StaticOrder, true, true>((LAS unsigned char*)lds, g, S, E, wave * 64 + lane_id_v());
    }
    SEAM(9);
    if (IN(10)) for (int rep_ = 0; rep_ < REP(10); ++rep_) { const int lane = lane_id_v(); const float* gf = args.in[I_FING];
        for (int m = gw; m < SEQ; m += NGW) { const float r = rsqrtf(SSQ2[m] * (1.f / DM) + RMS_EPS); const v4u* xr = (const v4u*)(XN + (size_t)m * DM) + lane; float* orow = args.out + (size_t)m * DM;
            v4u raw[8];
#pragma unroll
            for (int j = 0; j < 8; ++j) raw[j] = xr[64 * j];
#pragma unroll
            for (int j = 0; j < 8; ++j) { const int col = 8 * (lane + 64 * j); const f32x4 g0 = *(const f32x4*)(gf + col), g1 = *(const f32x4*)(gf + col + 4);
                f32x4 o0, o1; o0.x = bflo(raw[j].x) * r * g0.x; o0.y = bfhi(raw[j].x) * r * g0.y; o0.z = bflo(raw[j].y) * r * g0.z; o0.w = bfhi(raw[j].y) * r * g0.w;
                o1.x = bflo(raw[j].z) * r * g1.x; o1.y = bfhi(raw[j].z) * r * g1.y; o1.z = bflo(raw[j].w) * r * g1.z; o1.w = bfhi(raw[j].w) * r * g1.w;
                *(f32x4*)(orow + col) = o0; *(f32x4*)(orow + col + 4) = o1; } }
    }
#undef IN
#undef SEAM
}

#ifndef MK_N_LAUNCHES
#define MK_N_LAUNCHES 1
#endif
extern "C" void kernel_launch(void* const* d_in, const int* in_sizes, int n_in, void* d_out, int out_size, void* d_ws, size_t ws_size, hipStream_t stream) {
    static int grid = 0;
    if (grid == 0) {
        if (n_in != 14 || in_sizes[0] != SEQ * DM || out_size != SEQ * DM || ws_size < WS_END) { fprintf(stderr, "kernel_launch: unexpected shapes (n_in %d, ws %zu < %zu)\n", n_in, ws_size, (size_t)WS_END); grid = -1; return; }
        int dev = 0, cus = 0, per_cu = 0;
        (void)hipGetDevice(&dev); (void)hipDeviceGetAttribute(&cus, hipDeviceAttributeMultiprocessorCount, dev);
        if (hipFuncSetAttribute((const void*)hymba_fwd, hipFuncAttributeMaxDynamicSharedMemorySize, LDS_BYTES) != hipSuccess) { fprintf(stderr, "kernel_launch: hipFuncSetAttribute failed\n"); grid = -1; return; }
        if (hipOccupancyMaxActiveBlocksPerMultiprocessor(&per_cu, (const void*)hymba_fwd, NWAVES * 64, LDS_BYTES) != hipSuccess || per_cu < 1) { fprintf(stderr, "kernel_launch: occupancy query says %d\n", per_cu); per_cu = 1; }
        (void)hipGetLastError();
        grid = cus * 1;
        if (grid <= 0) grid = 256;
        if (grid < 256) { fprintf(stderr, "kernel_launch: needs >= 256 workgroups (one FoX item each), device has %d CUs\n", grid); grid = -1; return; }
    }
    if (grid < 0) return;
    if (hipMemsetAsync((char*)d_ws + WS_CTL, 0, CTL_BYTES, stream) != hipSuccess) { fprintf(stderr, "kernel_launch: memset failed\n"); return; }
    Args a{};
    for (int i = 0; i < 14; ++i) a.in[i] = (const float*)d_in[i];
    a.out = (float*)d_out; a.ws = (unsigned char*)d_ws;
#if MK_N_LAUNCHES == 1
    a.ph_lo = 0; a.ph_hi = N_PHASES;
    { void* kargs[] = {&a}; hipError_t e = hipLaunchCooperativeKernel((const void*)hymba_fwd, dim3(grid), dim3(NWAVES * 64), kargs, LDS_BYTES, stream);
      if (e != hipSuccess) fprintf(stderr, "kernel_launch: cooperative launch failed: %s (grid %d)\n", hipGetErrorString(e), grid); }
#else
    for (int p = 0; p < N_PHASES; ++p) { a.ph_lo = p; a.ph_hi = p + 1; void* kargs[] = {&a};
        hipError_t e = hipLaunchCooperativeKernel((const void*)hymba_fwd, dim3(grid), dim3(NWAVES * 64), kargs, LDS_BYTES, stream);
        if (e != hipSuccess) { fprintf(stderr, "kernel_launch: launch %d failed: %s\n", p, hipGetErrorString(e)); break; } }
#endif
}
```
